# Optimizing an MI355X kernel written in HIP

```python
import math
import jax, jax.numpy as jnp
from jax import lax
import numpy as np

D_MODEL = 1024
BATCH = 2
SEQ = 8192
DEPTH = 2
DEC_BATCH = 1
DEC_SEQ = 16384
PAST_LEN = 128

N_EVEN = (DEPTH + 1) // 2
N_ODD = DEPTH // 2
EPS = 1e-6

CONV_WIDTH = D_MODEL // 2
CONV_K = 3
MLA_HEADS = 8
QK_NOPE = 64
QK_ROPE = 32
V_DIM = 64
QK_DIM = QK_NOPE + QK_ROPE
Q_LORA = 256
KV_LORA = 128
ROPE_THETA = 10000.0
Q_BLOCK = 128
IN_A_WIDTH = 3 * CONV_WIDTH + Q_LORA + KV_LORA + QK_ROPE
MIX_A_WIDTH = CONV_WIDTH + MLA_HEADS * V_DIM
HYENA_WIDTH = D_MODEL
FILTER_BANDS = 16
FILTER_EMB = 1 + 2 * FILTER_BANDS
FILTER_HIDDEN = 64
DECAY_TARGET = 1e-2
FAST_DECAY_PCT = 0.3
SLOW_DECAY_PCT = 1.5
D_FF = ((8 * D_MODEL + 3 * 256 - 1) // (3 * 256)) * 256

kernel_name = "hybrid_conv_mla_hyena_encoder"


def _rmsnorm(x, g):
    xf = x.astype(jnp.float32)
    y = xf * lax.rsqrt(jnp.mean(xf * xf, axis=-1, keepdims=True) + EPS) * g.astype(jnp.float32)
    return y.astype(x.dtype)


def _dwconv3(x, w):
    xp = jnp.pad(x, ((0, 0), (1, 1), (0, 0)))
    return xp[:, :-2] * w[:, 0] + xp[:, 1:-1] * w[:, 1] + xp[:, 2:] * w[:, 2]


def _rope(x):
    L = x.shape[1]
    half = x.shape[-1] // 2
    inv = ROPE_THETA ** (-jnp.arange(half, dtype=jnp.float32) / half)
    ang = jnp.arange(L, dtype=jnp.float32)[:, None] * inv[None, :]
    cos = jnp.cos(ang)[None, :, None, :]
    sin = jnp.sin(ang)[None, :, None, :]
    x1 = x[..., :half].astype(jnp.float32)
    x2 = x[..., half:].astype(jnp.float32)
    return jnp.concatenate([x1 * cos - x2 * sin, x1 * sin + x2 * cos], axis=-1).astype(x.dtype)


def _block_attention(q, k, v):
    B, L = q.shape[0], q.shape[1]
    nblk = L // Q_BLOCK
    qb = q.reshape(B, nblk, Q_BLOCK, MLA_HEADS, QK_DIM).transpose(1, 0, 2, 3, 4)
    scale = QK_DIM ** -0.5

    def one_block(qi):
        s = jnp.einsum('bqhd,bkhd->bhqk', qi, k).astype(jnp.float32) * scale
        p = jax.nn.softmax(s, axis=-1)
        return jnp.einsum('bhqk,bkhd->bqhd', p.astype(v.dtype), v)

    out = lax.map(one_block, qb)
    return out.transpose(1, 0, 2, 3, 4).reshape(B, L, MLA_HEADS * V_DIM)


def _mixer_conv_mla(h, w_in, conv_w, q_a_norm, kv_a_norm, w_q_up, w_kv_up, q_norm, k_norm, w_out):
    B, L, _ = h.shape
    proj = h @ w_in
    c0 = CONV_WIDTH
    gate_b, gate_c, hv, c_q, c_kv, k_pe = jnp.split(
        proj, [c0, 2 * c0, 3 * c0, 3 * c0 + Q_LORA, 3 * c0 + Q_LORA + KV_LORA], axis=-1)
    y_conv = gate_b * _dwconv3(gate_c * hv, conv_w)
    q = (_rmsnorm(c_q, q_a_norm) @ w_q_up).reshape(B, L, MLA_HEADS, QK_DIM)
    kv = (_rmsnorm(c_kv, kv_a_norm) @ w_kv_up).reshape(B, L, MLA_HEADS, QK_NOPE + V_DIM)
    k_nope, v = kv[..., :QK_NOPE], kv[..., QK_NOPE:]
    k_pe_h = jnp.broadcast_to(k_pe[:, :, None, :], (B, L, MLA_HEADS, QK_ROPE))
    k = jnp.concatenate([k_nope, k_pe_h], axis=-1)
    q = _rmsnorm(q, q_norm)
    k = _rmsnorm(k, k_norm)
    q = jnp.concatenate([q[..., :QK_NOPE], _rope(q[..., QK_NOPE:])], axis=-1)
    k = jnp.concatenate([k[..., :QK_NOPE], _rope(k[..., QK_NOPE:])], axis=-1)
    y_att = _block_attention(q, k, v)
    return jnp.concatenate([y_conv, y_att], axis=-1) @ w_out


def _hyena_filters(L, f_w1, f_b1, f_w2, f_b2, f_w3, f_b3, f_freq, f_w4):
    t = jnp.linspace(0.0, 1.0, L, dtype=jnp.float32)[:, None]
    n = jnp.arange(L, dtype=jnp.float32)[:, None]
    bands = jnp.linspace(1e-4, FILTER_BANDS - 1, FILTER_BANDS, dtype=jnp.float32)[None, :]
    w = 2.0 * math.pi * n / L
    feats = jnp.concatenate([t, jnp.cos(w * bands), -jnp.sin(w * bands)], axis=-1)
    z = jnp.sin(f_freq[0] * (feats @ f_w1 + f_b1))
    z = jnp.sin(f_freq[1] * (z @ f_w2 + f_b2))
    z = jnp.sin(f_freq[2] * (z @ f_w3 + f_b3))
    hfil = (z @ f_w4).astype(jnp.float32).reshape(L, 2, HYENA_WIDTH)
    max_decay = math.log(DECAY_TARGET) / FAST_DECAY_PCT
    min_decay = math.log(DECAY_TARGET) / SLOW_DECAY_PCT
    deltas = jnp.linspace(min_decay, max_decay, HYENA_WIDTH, dtype=jnp.float32)
    window = jnp.exp(-t * jnp.abs(deltas)[None, :])
    hfil = hfil * window[:, None, :]
    return hfil[:, 0], hfil[:, 1]


def _bidir_fftconv(z, h_f, h_b, bias):
    L, C = z.shape[1], z.shape[2]
    kern = jnp.concatenate([h_f, jnp.zeros((1, C), jnp.float32), h_b[1:][::-1]], axis=0)
    k_f = jnp.fft.rfft(kern, n=2 * L, axis=0)
    zf32 = z.astype(jnp.float32)
    z_f = jnp.fft.rfft(zf32, n=2 * L, axis=1)
    y = jnp.fft.irfft(z_f * k_f[None], n=2 * L, axis=1)[:, :L]
    return (y + zf32 * bias.astype(jnp.float32)).astype(z.dtype)


def _mixer_hyena(h, w_in, short_w, f_w1, f_b1, f_w2, f_b2, f_w3, f_b3, f_freq, f_w4, bias, w_out):
    L = h.shape[1]
    u = _dwconv3(h @ w_in, short_w)
    x0, x1, v = jnp.split(u, [HYENA_WIDTH, 2 * HYENA_WIDTH], axis=-1)
    h_f, h_b = _hyena_filters(L, f_w1, f_b1, f_w2, f_b2, f_w3, f_b3, f_freq, f_w4)
    v = _bidir_fftconv(v * x1, h_f, h_b, bias)
    return (v * x0) @ w_out


def _swiglu(h, w_gate, w_up, w_down):
    return (jax.nn.silu(h @ w_gate) * (h @ w_up)) @ w_down


def _trunk(x, mix_norm, ffn_norm, ffn_w_gate, ffn_w_up, ffn_w_down,
           a_w_in, a_conv_w, a_q_a_norm, a_kv_a_norm, a_w_q_up, a_w_kv_up, a_q_norm, a_k_norm, a_w_out,
           c_w_in, c_short_w, c_f_w1, c_f_b1, c_f_w2, c_f_b2, c_f_w3, c_f_b3, c_f_freq, c_f_w4,
           c_bias, c_w_out):
    for layer in range(DEPTH):
        i = layer // 2
        h = _rmsnorm(x, mix_norm[layer])
        if layer % 2 == 0:
            x = x + _mixer_conv_mla(h, a_w_in[i], a_conv_w[i], a_q_a_norm[i], a_kv_a_norm[i],
                                    a_w_q_up[i], a_w_kv_up[i], a_q_norm[i], a_k_norm[i], a_w_out[i])
        else:
            x = x + _mixer_hyena(h, c_w_in[i], c_short_w[i], c_f_w1[i], c_f_b1[i], c_f_w2[i], c_f_b2[i],
                                 c_f_w3[i], c_f_b3[i], c_f_freq[i], c_f_w4[i], c_bias[i], c_w_out[i])
        h = _rmsnorm(x, ffn_norm[layer])
        x = x + _swiglu(h, ffn_w_gate[layer], ffn_w_up[layer], ffn_w_down[layer])
    return x


def setup_inputs(seed: int = 0) -> dict:
    key = jax.random.key(seed)
    ks = jax.random.split(key, 32)
    f32 = jnp.float32

    def w(k, shape, fan_in, scale=1.0):
        return jax.random.normal(k, shape, f32) * (scale * fan_in ** -0.5)

    def gain(k, shape):
        return 1.0 + 0.05 * jax.random.normal(k, shape, f32)

    def small(k, shape, s=0.02):
        return s * jax.random.normal(k, shape, f32)

    D = D_MODEL
    return {
        "x_prompt": jax.random.normal(ks[0], (BATCH, SEQ, D), f32),
        "x_sample": jax.random.normal(ks[1], (DEC_BATCH, DEC_SEQ, D), f32),
        "mix_norm": gain(ks[2], (DEPTH, D)),
        "ffn_norm": gain(ks[3], (DEPTH, D)),
        "ffn_w_gate": w(ks[4], (DEPTH, D, D_FF), D),
        "ffn_w_up": w(ks[5], (DEPTH, D, D_FF), D),
        "ffn_w_down": w(ks[6], (DEPTH, D_FF, D), D_FF),
        "a_w_in": w(ks[7], (N_EVEN, D, IN_A_WIDTH), D),
        "a_conv_w": w(ks[8], (N_EVEN, CONV_WIDTH, CONV_K), CONV_K),
        "a_q_a_norm": gain(ks[9], (N_EVEN, Q_LORA)),
        "a_kv_a_norm": gain(ks[10], (N_EVEN, KV_LORA)),
        "a_w_q_up": w(ks[11], (N_EVEN, Q_LORA, MLA_HEADS * QK_DIM), Q_LORA),
        "a_w_kv_up": w(ks[12], (N_EVEN, KV_LORA, MLA_HEADS * (QK_NOPE + V_DIM)), KV_LORA),
        "a_q_norm": gain(ks[13], (N_EVEN, QK_DIM)),
        "a_k_norm": gain(ks[14], (N_EVEN, QK_DIM)),
        "a_w_out": w(ks[15], (N_EVEN, MIX_A_WIDTH, D), MIX_A_WIDTH),
        "c_w_in": w(ks[16], (N_ODD, D, 3 * HYENA_WIDTH), D),
        "c_short_w": w(ks[17], (N_ODD, 3 * HYENA_WIDTH, CONV_K), CONV_K),
        "c_f_w1": w(ks[18], (N_ODD, FILTER_EMB, FILTER_HIDDEN), FILTER_EMB),
        "c_f_b1": small(ks[19], (N_ODD, FILTER_HIDDEN)),
        "c_f_w2": w(ks[20], (N_ODD, FILTER_HIDDEN, FILTER_HIDDEN), FILTER_HIDDEN),
        "c_f_b2": small(ks[21], (N_ODD, FILTER_HIDDEN)),
        "c_f_w3": w(ks[22], (N_ODD, FILTER_HIDDEN, FILTER_HIDDEN), FILTER_HIDDEN),
        "c_f_b3": small(ks[23], (N_ODD, FILTER_HIDDEN)),
        "c_f_freq": gain(ks[24], (N_ODD, 3, FILTER_HIDDEN)),
        "c_f_w4": w(ks[25], (N_ODD, FILTER_HIDDEN, 2 * HYENA_WIDTH), FILTER_HIDDEN, scale=0.02),
        "c_bias": 1.0 + 0.1 * jax.random.normal(ks[26], (N_ODD, HYENA_WIDTH), f32),
        "c_w_out": w(ks[27], (N_ODD, HYENA_WIDTH, D), HYENA_WIDTH),
    }


def reference(x_prompt, x_sample, mix_norm, ffn_norm, ffn_w_gate, ffn_w_up, ffn_w_down,
              a_w_in, a_conv_w, a_q_a_norm, a_kv_a_norm, a_w_q_up, a_w_kv_up, a_q_norm, a_k_norm, a_w_out,
              c_w_in, c_short_w, c_f_w1, c_f_b1, c_f_w2, c_f_b2, c_f_w3, c_f_b3, c_f_freq, c_f_w4,
              c_bias, c_w_out):
    y_prompt = _trunk(x_prompt, mix_norm, ffn_norm, ffn_w_gate, ffn_w_up, ffn_w_down,
                      a_w_in, a_conv_w, a_q_a_norm, a_kv_a_norm, a_w_q_up, a_w_kv_up, a_q_norm, a_k_norm,
                      a_w_out, c_w_in, c_short_w, c_f_w1, c_f_b1, c_f_w2, c_f_b2, c_f_w3, c_f_b3, c_f_freq,
                      c_f_w4, c_bias, c_w_out)
    y_sample = _trunk(x_sample, mix_norm, ffn_norm, ffn_w_gate, ffn_w_up, ffn_w_down,
                      a_w_in, a_conv_w, a_q_a_norm, a_kv_a_norm, a_w_q_up, a_w_kv_up, a_q_norm, a_k_norm,
                      a_w_out, c_w_in, c_short_w, c_f_w1, c_f_b1, c_f_w2, c_f_b2, c_f_w3, c_f_b3, c_f_freq,
                      c_f_w4, c_bias, c_w_out)
    return (y_prompt, y_sample)
```

```cpp
#include <hip/hip_runtime.h>
#include <hip/hip_cooperative_groups.h>
#include <cstdio>
#include <cstdint>
namespace cg = cooperative_groups;

typedef unsigned short u16;
typedef __attribute__((ext_vector_type(8))) short bf16x8;
typedef __attribute__((ext_vector_type(4))) short s16x4;
typedef __attribute__((ext_vector_type(4))) float f32x4;
typedef __attribute__((ext_vector_type(16))) float f32x16;
typedef __attribute__((ext_vector_type(4))) unsigned u32x4;
typedef __attribute__((ext_vector_type(2))) unsigned u32x2;

#define DI __device__ __forceinline__
#define NTHR 512
#ifndef FFTP
#define FFTP 3
#endif
#ifndef PHM
#define PHM 0xffff
#endif

constexpr int T_TOK = 32768;
constexpr int DM = 1024;
constexpr int DFF = 2816;
constexpr float EPSN = 1e-6f;

constexpr size_t SM_ROWSS = 4096;
constexpr size_t SM_Z3    = 1048576;
constexpr size_t OFF_W1   = 4194304;
constexpr size_t W1_CIN   = OFF_W1;
constexpr size_t W1_COUT  = W1_CIN + 6291456;
constexpr size_t W1_W4    = W1_COUT + 2097152;
constexpr size_t W1_GU    = W1_W4 + 262144;
constexpr size_t W1_D     = W1_GU + 11534336;
constexpr size_t OFF_XB   = W1_D + 5767168;
constexpr size_t OFF_C    = OFF_XB + 67108864;
constexpr size_t W0_IN    = OFF_C;
constexpr size_t W0_Q     = W0_IN + 4194304;
constexpr size_t W0_K     = W0_Q + 393216;
constexpr size_t W0_V     = W0_K + 131072;
constexpr size_t W0_OUT   = W0_V + 131072;
constexpr size_t W0_GU    = W0_OUT + 2097152;
constexpr size_t W0_D     = W0_GU + 11534336;
constexpr size_t OFF_R    = W0_D + 5767168;
constexpr size_t WS_NEED  = 268435456;
static_assert(OFF_R == 121503744, "map");
constexpr size_t R_CQN  = OFF_R;
constexpr size_t R_CKVN = R_CQN + 16777216;
constexpr size_t R_KPE  = R_CKVN + 8388608;
constexpr size_t R_MIX  = R_KPE + 2097152;
constexpr size_t R_K    = R_MIX + 67108864;
static_assert(R_K + 50331648 <= WS_NEED, "map");
constexpr size_t D_QRAW = 0;
constexpr size_t D_KN   = 50331648;
constexpr size_t D_VT   = D_KN + 33554432;
constexpr size_t D_ROPE = D_VT + 33554432;
static_assert(D_ROPE + 2097152 <= 134217728, "map");
constexpr size_t C_X0T  = OFF_C;
constexpr size_t C_KP   = C_X0T + 67108864;
constexpr size_t C_KS   = C_KP + 33554432;
constexpr size_t C_YG   = C_KS;
static_assert(C_KS + 67108864 <= WS_NEED, "map");

struct Params {
  const float* in[28];
  float* out;
  char* ws;
};

DI u16 f2bf(float x) { unsigned u = __float_as_uint(x); u += 0x7fffu + ((u >> 16) & 1u); return (u16)(u >> 16); }
DI float bf2f(u16 v) { return __uint_as_float(((unsigned)v) << 16); }
DI unsigned pack2(float a, float b) { return (unsigned)f2bf(a) | ((unsigned)f2bf(b) << 16); }
DI float lo_bf(unsigned w) { return __uint_as_float(w << 16); }
DI float hi_bf(unsigned w) { return __uint_as_float(w & 0xffff0000u); }
DI void unpack8(const u32x4& v, float* f) {
  f[0] = lo_bf(v[0]); f[1] = hi_bf(v[0]); f[2] = lo_bf(v[1]); f[3] = hi_bf(v[1]);
  f[4] = lo_bf(v[2]); f[5] = hi_bf(v[2]); f[6] = lo_bf(v[3]); f[7] = hi_bf(v[3]);
}
DI u32x4 pack8(const float* f) {
  u32x4 v; v[0] = pack2(f[0], f[1]); v[1] = pack2(f[2], f[3]); v[2] = pack2(f[4], f[5]); v[3] = pack2(f[6], f[7]); return v;
}
DI float wave_sum(float v) {
  v += __shfl_xor(v, 32); v += __shfl_xor(v, 16); v += __shfl_xor(v, 8);
  v += __shfl_xor(v, 4); v += __shfl_xor(v, 2); v += __shfl_xor(v, 1); return v;
}
DI void seq_of(int t, int& t0, int& L) {
  if (t < 8192) { t0 = 0; L = 8192; } else if (t < 16384) { t0 = 8192; L = 8192; } else { t0 = 16384; L = 16384; }
}

DI int swz(int row, int chunk) { return row * 128 + ((chunk ^ (row & 7)) << 4); }

template <class Epi>
DI void gemm_tile(const u16* __restrict__ A, long lda, const u16* __restrict__ B, long ldb, int K, char* smem, Epi&& epi) {
  const int tid = threadIdx.x, lane = tid & 63, wid = tid >> 6;
  const int wr = wid >> 1, wc = wid & 1;
  const int fr = lane & 15, fq = lane >> 4;
  f32x4 acc[4][4];
#pragma unroll
  for (int i = 0; i < 4; ++i)
#pragma unroll
    for (int j = 0; j < 4; ++j) acc[i][j] = (f32x4){0.f, 0.f, 0.f, 0.f};
  const int lrow = tid >> 3, lch = tid & 7;
  const u16* Ap = A + (long)lrow * lda + lch * 8;
  const u16* Bp = B + (long)lrow * ldb + lch * 8;
  u32x4 ra[4], rb[2];
  const int nk = K >> 6;
#pragma unroll
  for (int i = 0; i < 4; ++i) ra[i] = *(const u32x4*)(Ap + (long)(i * 64) * lda);
#pragma unroll
  for (int i = 0; i < 2; ++i) rb[i] = *(const u32x4*)(Bp + (long)(i * 64) * ldb);
#pragma unroll
  for (int i = 0; i < 4; ++i) *(u32x4*)(smem + swz(lrow + i * 64, lch)) = ra[i];
#pragma unroll
  for (int i = 0; i < 2; ++i) *(u32x4*)(smem + 32768 + swz(lrow + i * 64, lch)) = rb[i];
  __syncthreads();
  for (int kt = 0; kt < nk; ++kt) {
    if (kt + 1 < nk) {
#pragma unroll
      for (int i = 0; i < 4; ++i) ra[i] = *(const u32x4*)(Ap + (long)(i * 64) * lda + (kt + 1) * 64);
#pragma unroll
      for (int i = 0; i < 2; ++i) rb[i] = *(const u32x4*)(Bp + (long)(i * 64) * ldb + (kt + 1) * 64);
    }
    const char* sa = smem + (kt & 1) * 49152;
    const char* sb = sa + 32768;
#pragma unroll
    for (int ks = 0; ks < 2; ++ks) {
      bf16x8 af[4], bfr[4];
#pragma unroll
      for (int mi = 0; mi < 4; ++mi) af[mi] = *(const bf16x8*)(sa + swz(wr * 64 + mi * 16 + fr, ks * 4 + fq));
#pragma unroll
      for (int ni = 0; ni < 4; ++ni) bfr[ni] = *(const bf16x8*)(sb + swz(wc * 64 + ni * 16 + fr, ks * 4 + fq));
#pragma unroll
      for (int mi = 0; mi < 4; ++mi)
#pragma unroll
        for (int ni = 0; ni < 4; ++ni)
          acc[mi][ni] = __builtin_amdgcn_mfma_f32_16x16x32_bf16(af[mi], bfr[ni], acc[mi][ni], 0, 0, 0);
    }
    if (kt + 1 < nk) {
      char* da = smem + ((kt + 1) & 1) * 49152;
#pragma unroll
      for (int i = 0; i < 4; ++i) *(u32x4*)(da + swz(lrow + i * 64, lch)) = ra[i];
#pragma unroll
      for (int i = 0; i < 2; ++i) *(u32x4*)(da + 32768 + swz(lrow + i * 64, lch)) = rb[i];
    }
    __syncthreads();
  }
  epi(acc, wr * 64 + fq * 4, wc * 64 + fr);
}

template <int KIND>
DI void convert_w(const float* __restrict__ src, const float* __restrict__ src2, int Nsrc, int K, int Np,
                  u16* __restrict__ dst, const float* __restrict__ gain, char* smem, int vb, int G) {
  float* tl = (float*)smem;
  const int tid = threadIdx.x;
  const int tn_n = Np >> 6, nt = (K >> 6) * tn_n;
  for (int tile = vb; tile < nt; tile += G) {
    const int tn = tile % tn_n, tk = tile / tn_n;
#pragma unroll
    for (int i = 0; i < 8; ++i) {
      const int e = tid + 512 * i, kk = e >> 6, nn = e & 63;
      const int np = tn * 64 + nn, k = tk * 64 + kk;
      const float* s = src; int n;
      bool valid = true;
      if (KIND == 0) { n = np; valid = np < Nsrc; }
      else if (KIND == 1) { n = (np >> 6) * 128 + (np & 63); }
      else if (KIND == 2) { n = (np >> 6) * 128 + 64 + (np & 63); }
      else { const int g = np >> 5, w = np & 31; s = (w < 16) ? src : src2; n = g * 16 + (w & 15); }
      float v = 0.f;
      if (valid) { v = s[(long)k * Nsrc + n]; if (gain) v *= gain[k]; }
      tl[kk * 65 + nn] = v;
    }
    __syncthreads();
    {
      const int nn = tid >> 3, kc = tid & 7;
      float f[8];
#pragma unroll
      for (int j = 0; j < 8; ++j) f[j] = tl[(kc * 8 + j) * 65 + nn];
      *(u32x4*)(dst + (long)(tn * 64 + nn) * K + tk * 64 + kc * 8) = pack8(f);
    }
    __syncthreads();
  }
}

DI float2 cadd(float2 a, float2 b) { return make_float2(a.x + b.x, a.y + b.y); }
DI float2 csub(float2 a, float2 b) { return make_float2(a.x - b.x, a.y - b.y); }
DI float2 cmul(float2 a, float2 b) { return make_float2(a.x * b.x - a.y * b.y, a.x * b.y + a.y * b.x); }
DI float2 cmulc(float2 a, float2 b) { return make_float2(a.x * b.x + a.y * b.y, a.y * b.x - a.x * b.y); }
DI float2 cconj(float2 a) { return make_float2(a.x, -a.y); }
DI float2 twid(float rev) {
  return make_float2(__builtin_amdgcn_cosf(rev), -__builtin_amdgcn_sinf(rev));
}
DI void r4f(float2& a0, float2& a1, float2& a2, float2& a3) {
  const float2 s02 = cadd(a0, a2), d02 = csub(a0, a2), s13 = cadd(a1, a3), d13 = csub(a1, a3);
  a0 = cadd(s02, s13); a2 = csub(s02, s13);
  a1 = make_float2(d02.x + d13.y, d02.y - d13.x);
  a3 = make_float2(d02.x - d13.y, d02.y + d13.x);
}
DI void r4i(float2& a0, float2& a1, float2& a2, float2& a3) {
  const float2 s02 = cadd(a0, a2), d02 = csub(a0, a2), s13 = cadd(a1, a3), d13 = csub(a1, a3);
  a0 = cadd(s02, s13); a2 = csub(s02, s13);
  a1 = make_float2(d02.x - d13.y, d02.y + d13.x);
  a3 = make_float2(d02.x + d13.y, d02.y - d13.x);
}
#define C8 0.9238795325112867f
#define S8 0.3826834323650898f
#define R2 0.7071067811865476f
DI void fft16_fwd(float2 (&v)[16]) {
#pragma unroll
  for (int r0 = 0; r0 < 4; ++r0) r4f(v[r0], v[r0 + 4], v[r0 + 8], v[r0 + 12]);
  v[5]  = cmul(v[5],  make_float2(C8, -S8));
  v[9]  = cmul(v[9],  make_float2(R2, -R2));
  v[13] = cmul(v[13], make_float2(S8, -C8));
  v[6]  = cmul(v[6],  make_float2(R2, -R2));
  v[10] = make_float2(v[10].y, -v[10].x);
  v[14] = cmul(v[14], make_float2(-R2, -R2));
  v[7]  = cmul(v[7],  make_float2(S8, -C8));
  v[11] = cmul(v[11], make_float2(-R2, -R2));
  v[15] = cmul(v[15], make_float2(-C8, S8));
#pragma unroll
  for (int q1 = 0; q1 < 4; ++q1) r4f(v[4 * q1], v[4 * q1 + 1], v[4 * q1 + 2], v[4 * q1 + 3]);
}
DI void fft16_inv(float2 (&v)[16]) {
#pragma unroll
  for (int q1 = 0; q1 < 4; ++q1) r4i(v[4 * q1], v[4 * q1 + 1], v[4 * q1 + 2], v[4 * q1 + 3]);
  v[5]  = cmulc(v[5],  make_float2(C8, -S8));
  v[9]  = cmulc(v[9],  make_float2(R2, -R2));
  v[13] = cmulc(v[13], make_float2(S8, -C8));
  v[6]  = cmulc(v[6],  make_float2(R2, -R2));
  v[10] = make_float2(-v[10].y, v[10].x);
  v[14] = cmulc(v[14], make_float2(-R2, -R2));
  v[7]  = cmulc(v[7],  make_float2(S8, -C8));
  v[11] = cmulc(v[11], make_float2(-R2, -R2));
  v[15] = cmulc(v[15], make_float2(-C8, S8));
#pragma unroll
  for (int r0 = 0; r0 < 4; ++r0) r4i(v[r0], v[r0 + 4], v[r0 + 8], v[r0 + 12]);
}
template <int M, bool INV>
DI void fft_pass16(float2* X) {
  constexpr int S = M / 16;
  const int tid = threadIdx.x;
#pragma unroll 1
  for (int u = 0; u < 2; ++u) {
    const int bf = tid + 512 * u;
    int j = bf % S; const int b = (bf / S) * M;
    asm volatile("" : "+v"(j));
    float2* p = X + b + j;
    float2 v[16];
#pragma unroll
    for (int r = 0; r < 16; ++r) v[r] = p[r * S];
    const float2 w1 = twid((float)j * (1.0f / (float)M));
    if (!INV) {
      fft16_fwd(v);
      float2 cur = w1;
#pragma unroll
      for (int f = 1; f < 16; ++f) {
        const int slot = ((f & 3) << 2) | (f >> 2);
        v[slot] = cmul(v[slot], cur);
        cur = cmul(cur, w1);
      }
    } else {
      float2 cur = w1;
#pragma unroll
      for (int f = 1; f < 16; ++f) {
        const int slot = ((f & 3) << 2) | (f >> 2);
        v[slot] = cmulc(v[slot], cur);
        cur = cmul(cur, w1);
      }
      fft16_inv(v);
    }
#pragma unroll
    for (int r = 0; r < 16; ++r) p[r * S] = v[r];
  }
}
template <bool INV>
DI void fft_pass4_64(float2* X) {
  const int tid = threadIdx.x;
#pragma unroll 1
  for (int u = 0; u < 8; ++u) {
    const int bf = tid + 512 * u;
    int j = bf & 15; const int b = (bf >> 4) * 64;
    asm volatile("" : "+v"(j));
    float2* p = X + b + j;
    float2 a0 = p[0], a1 = p[16], a2 = p[32], a3 = p[48];
    const float2 w1 = twid((float)j * (1.0f / 64.f));
    const float2 w2 = cmul(w1, w1), w3 = cmul(w2, w1);
    if (!INV) {
      r4f(a0, a1, a2, a3);
      a1 = cmul(a1, w1); a2 = cmul(a2, w2); a3 = cmul(a3, w3);
    } else {
      a1 = cmulc(a1, w1); a2 = cmulc(a2, w2); a3 = cmulc(a3, w3);
      r4i(a0, a1, a2, a3);
    }
    p[0] = a0; p[16] = a1; p[32] = a2; p[48] = a3;
  }
}
DI void fft_fwd_head(float2* X) {
  __syncthreads();
  fft_pass16<16384, false>(X); __syncthreads();
  fft_pass16<1024, false>(X);  __syncthreads();
  fft_pass4_64<false>(X);      __syncthreads();
}
DI void fft_inv_tail(float2* X) {
  __syncthreads();
  fft_pass4_64<true>(X);       __syncthreads();
  fft_pass16<1024, true>(X);   __syncthreads();
  fft_pass16<16384, true>(X);  __syncthreads();
}
DI int pos14(int k) {
  unsigned r = __brev((unsigned)k) >> 18;
  return (int)(((r & 0x1555u) << 1) | ((r >> 1) & 0x1555u));
}
DI void conv3_8(const u16* row, int tl, int L, float w0, float w1, float w2, float* out) {
  const u32x4 c = *(const u32x4*)(row + tl);
  float f[10];
  unpack8(c, f + 1);
  f[0] = (tl > 0) ? bf2f(row[tl - 1]) : 0.f;
  f[9] = (tl + 8 < L) ? bf2f(row[tl + 8]) : 0.f;
#pragma unroll
  for (int i = 0; i < 8; ++i) out[i] = w0 * f[i] + w1 * f[i + 1] + w2 * f[i + 2];
}

__global__ void __launch_bounds__(NTHR) fwd_kernel(Params p) {
  __shared__ __attribute__((aligned(16))) char smem[163840];
  cg::grid_group grid = cg::this_grid();
  const int tid = threadIdx.x, lane = tid & 63, wid = tid >> 6;
  const int G = gridDim.x, bid = blockIdx.x;
  const int vb = (bid & 7) * (G >> 3) + (bid >> 3);
  const int gw = bid * 8 + wid, NW = G * 8;
  const long gtid = (long)bid * NTHR + tid; const long GT = (long)G * NTHR;
  char* ws = p.ws;
  char* dsc = (char*)p.out;
  float* rowss = (float*)(ws + SM_ROWSS);
  u16* XB = (u16*)(ws + OFF_XB);

  if (PHM & (1 << 0)) {
    convert_w<0>(p.in[7], nullptr, 1952, 1024, 2048, (u16*)(ws + W0_IN), p.in[2], smem, vb, G);
    convert_w<0>(p.in[11], nullptr, 768, 256, 768, (u16*)(ws + W0_Q), nullptr, smem, vb, G);
    convert_w<1>(p.in[12], nullptr, 1024, 128, 512, (u16*)(ws + W0_K), nullptr, smem, vb, G);
    convert_w<2>(p.in[12], nullptr, 1024, 128, 512, (u16*)(ws + W0_V), nullptr, smem, vb, G);
    convert_w<0>(p.in[15], nullptr, 1024, 1024, 1024, (u16*)(ws + W0_OUT), nullptr, smem, vb, G);
    convert_w<3>(p.in[4], p.in[5], 2816, 1024, 5632, (u16*)(ws + W0_GU), p.in[3], smem, vb, G);
    convert_w<0>(p.in[6], nullptr, 1024, 2816, 1024, (u16*)(ws + W0_D), nullptr, smem, vb, G);
    convert_w<0>(p.in[16], nullptr, 3072, 1024, 3072, (u16*)(ws + W1_CIN), p.in[2] + 1024, smem, vb, G);
    convert_w<0>(p.in[27], nullptr, 1024, 1024, 1024, (u16*)(ws + W1_COUT), nullptr, smem, vb, G);
    convert_w<0>(p.in[25], nullptr, 2048, 64, 2048, (u16*)(ws + W1_W4), nullptr, smem, vb, G);
    convert_w<3>(p.in[4] + 1024 * 2816, p.in[5] + 1024 * 2816, 2816, 1024, 5632, (u16*)(ws + W1_GU), p.in[3] + 1024, smem, vb, G);
    convert_w<0>(p.in[6] + 2816 * 1024, nullptr, 1024, 2816, 1024, (u16*)(ws + W1_D), nullptr, smem, vb, G);
    for (int row = gw; row < T_TOK; row += NW) {
      const float* xr = (row < 16384) ? (p.in[0] + (long)row * DM) : (p.in[1] + (long)(row - 16384) * DM);
      float ss = 0.f;
#pragma unroll
      for (int hb = 0; hb < 2; ++hb) {
        const float4 a = *(const float4*)(xr + hb * 512 + lane * 8);
        const float4 b = *(const float4*)(xr + hb * 512 + lane * 8 + 4);
        ss += a.x * a.x + a.y * a.y + a.z * a.z + a.w * a.w + b.x * b.x + b.y * b.y + b.z * b.z + b.w * b.w;
        u32x4 o; o[0] = pack2(a.x, a.y); o[1] = pack2(a.z, a.w); o[2] = pack2(b.x, b.y); o[3] = pack2(b.z, b.w);
        *(u32x4*)(XB + (long)row * DM + hb * 512 + lane * 8) = o;
      }
      ss = wave_sum(ss);
      if (lane == 0) rowss[row] = ss;
    }
    for (long i = gtid; i < 3 * T_TOK; i += GT) rowss[T_TOK + i] = 0.f;
    {
      const float* w1 = p.in[18]; const float* b1 = p.in[19];
      const float* w2 = p.in[20]; const float* b2 = p.in[21];
      const float* w3 = p.in[22]; const float* b3 = p.in[23];
      const float* fq = p.in[24];
      const float INV2PI = 0.15915494309189535f;
#pragma unroll 1
      for (int rg = 0; rg < 3; ++rg) {
        const int rbase = gw * 12 + rg * 4;
        if (rbase < 24576) {
          float zr[4], acc[4];
#pragma unroll
          for (int r = 0; r < 4; ++r) {
            const int rr = rbase + r;
            const int Lf = (rr < 8192) ? 8192 : 16384;
            const int l = (rr < 8192) ? rr : (rr - 8192);
            const float tpos = (float)l / (float)(Lf - 1);
            const float frac = (float)l / (float)Lf;
            const int bi = (lane >= 17) ? (lane - 17) : (lane - 1);
            const float band = 1e-4f + (float)bi * ((15.f - 1e-4f) / 15.f);
            const float rev = frac * band;
            float fv = (lane == 0) ? tpos : ((lane <= 16) ? __builtin_amdgcn_cosf(rev) : -__builtin_amdgcn_sinf(rev));
            zr[r] = fv;
            acc[r] = b1[lane];
          }
#pragma unroll 3
          for (int k = 0; k < 33; ++k) {
            const float wk = w1[k * 64 + lane];
#pragma unroll
            for (int r = 0; r < 4; ++r) acc[r] += __int_as_float(__builtin_amdgcn_readlane(__float_as_int(zr[r]), k)) * wk;
          }
          {
            const float f = fq[lane] * INV2PI;
#pragma unroll
            for (int r = 0; r < 4; ++r) { zr[r] = __builtin_amdgcn_sinf(f * acc[r]); acc[r] = b2[lane]; }
          }
#pragma unroll 8
          for (int k = 0; k < 64; ++k) {
            const float wk = w2[k * 64 + lane];
#pragma unroll
            for (int r = 0; r < 4; ++r) acc[r] += __int_as_float(__builtin_amdgcn_readlane(__float_as_int(zr[r]), k)) * wk;
          }
          {
            const float f = fq[64 + lane] * INV2PI;
#pragma unroll
            for (int r = 0; r < 4; ++r) { zr[r] = __builtin_amdgcn_sinf(f * acc[r]); acc[r] = b3[lane]; }
          }
#pragma unroll 8
          for (int k = 0; k < 64; ++k) {
            const float wk = w3[k * 64 + lane];
#pragma unroll
            for (int r = 0; r < 4; ++r) acc[r] += __int_as_float(__builtin_amdgcn_readlane(__float_as_int(zr[r]), k)) * wk;
          }
          {
            const float f = fq[128 + lane] * INV2PI;
            u16* z3 = (u16*)(ws + SM_Z3);
#pragma unroll
            for (int r = 0; r < 4; ++r) z3[(long)(rbase + r) * 64 + lane] = f2bf(__builtin_amdgcn_sinf(f * acc[r]));
          }
        }
      }
    }
  }
  grid.sync();

  if (PHM & (1 << 1)) {
    u16* proj = (u16*)dsc;
    const u16* Wt = (const u16*)(ws + W0_IN);
    for (int tile = vb; tile < 128 * 16; tile += G) {
      const int tm = tile >> 4, tn = tile & 15;
      gemm_tile(XB + (long)tm * 256 * DM, DM, Wt + (long)tn * 128 * DM, DM, DM, smem,
        [&](f32x4 (&acc)[4][4], int r0, int c0) {
#pragma unroll
          for (int mi = 0; mi < 4; ++mi)
#pragma unroll
            for (int j = 0; j < 4; ++j) {
              const int row = tm * 256 + r0 + mi * 16 + j;
              const float rs = rsqrtf(rowss[row] * (1.f / 1024.f) + EPSN);
#pragma unroll
              for (int ni = 0; ni < 4; ++ni)
                proj[(long)row * 2048 + tn * 128 + c0 + ni * 16] = f2bf(acc[mi][ni][j] * rs);
            }
        });
    }
  }
  grid.sync();

  if (PHM & (1 << 2)) {
    const u16* proj = (const u16*)dsc;
    u16* mix = (u16*)(ws + R_MIX);
    u16* cqn = (u16*)(ws + R_CQN);
    u16* ckvn = (u16*)(ws + R_CKVN);
    u16* kpe = (u16*)(ws + R_KPE);
    const float* cw = p.in[8];
    float w0[8], w1[8], w2[8];
#pragma unroll
    for (int i = 0; i < 8; ++i) { w0[i] = cw[(lane * 8 + i) * 3]; w1[i] = cw[(lane * 8 + i) * 3 + 1]; w2[i] = cw[(lane * 8 + i) * 3 + 2]; }
    float gq[4], gk[2];
#pragma unroll
    for (int i = 0; i < 4; ++i) gq[i] = p.in[9][lane * 4 + i];
    gk[0] = p.in[10][lane * 2]; gk[1] = p.in[10][lane * 2 + 1];
    for (int t = gw; t < T_TOK; t += NW) {
      int t0, L; seq_of(t, t0, L);
      const u16* pr = proj + (long)t * 2048;
      const int c = lane * 8;
      float gb[8], mc[8], mp[8], mn[8], a[8], b[8];
      unpack8(*(const u32x4*)(pr + c), gb);
      unpack8(*(const u32x4*)(pr + 512 + c), a); unpack8(*(const u32x4*)(pr + 1024 + c), b);
#pragma unroll
      for (int i = 0; i < 8; ++i) mc[i] = a[i] * b[i];
      if (t > t0) {
        unpack8(*(const u32x4*)(pr - 2048 + 512 + c), a); unpack8(*(const u32x4*)(pr - 2048 + 1024 + c), b);
#pragma unroll
        for (int i = 0; i < 8; ++i) mp[i] = a[i] * b[i];
      } else {
#pragma unroll
        for (int i = 0; i < 8; ++i) mp[i] = 0.f;
      }
      if (t < t0 + L - 1) {
        unpack8(*(const u32x4*)(pr + 2048 + 512 + c), a); unpack8(*(const u32x4*)(pr + 2048 + 1024 + c), b);
#pragma unroll
        for (int i = 0; i < 8; ++i) mn[i] = a[i] * b[i];
      } else {
#pragma unroll
        for (int i = 0; i < 8; ++i) mn[i] = 0.f;
      }
      float y[8];
#pragma unroll
      for (int i = 0; i < 8; ++i) y[i] = gb[i] * (w0[i] * mp[i] + w1[i] * mc[i] + w2[i] * mn[i]);
      *(u32x4*)(mix + (long)t * 1024 + c) = pack8(y);
      {
        const u32x2 v = *(const u32x2*)(pr + 1536 + lane * 4);
        float f0 = lo_bf(v[0]), f1 = hi_bf(v[0]), f2 = lo_bf(v[1]), f3 = hi_bf(v[1]);
        const float ss = wave_sum(f0 * f0 + f1 * f1 + f2 * f2 + f3 * f3);
        const float rs = rsqrtf(ss * (1.f / 256.f) + EPSN);
        u32x2 o; o[0] = pack2(f0 * rs * gq[0], f1 * rs * gq[1]); o[1] = pack2(f2 * rs * gq[2], f3 * rs * gq[3]);
        *(u32x2*)(cqn + (long)t * 256 + lane * 4) = o;
      }
      {
        const unsigned v = *(const unsigned*)(pr + 1792 + lane * 2);
        float f0 = lo_bf(v), f1 = hi_bf(v);
        const float ss = wave_sum(f0 * f0 + f1 * f1);
        const float rs = rsqrtf(ss * (1.f / 128.f) + EPSN);
        *(unsigned*)(ckvn + (long)t * 128 + lane * 2) = pack2(f0 * rs * gk[0], f1 * rs * gk[1]);
      }
      if (lane < 16) *(unsigned*)(kpe + (long)t * 32 + lane * 2) = *(const unsigned*)(pr + 1920 + lane * 2);
    }
  }
  grid.sync();

  if (PHM & (1 << 3)) {
    const u16* cqn = (const u16*)(ws + R_CQN);
    const u16* ckvn = (const u16*)(ws + R_CKVN);
    u16* qraw = (u16*)(dsc + D_QRAW);
    u16* knraw = (u16*)(dsc + D_KN);
    u16* Vt = (u16*)(dsc + D_VT);
    for (int tile = vb; tile < 1792; tile += G) {
      if (tile < 768) {
        const int tm = tile / 6, tn = tile % 6;
        gemm_tile(cqn + (long)tm * 256 * 256, 256, (const u16*)(ws + W0_Q) + (long)tn * 128 * 256, 256, 256, smem,
          [&](f32x4 (&acc)[4][4], int r0, int c0) {
#pragma unroll
            for (int mi = 0; mi < 4; ++mi)
#pragma unroll
              for (int j = 0; j < 4; ++j)
#pragma unroll
                for (int ni = 0; ni < 4; ++ni)
                  qraw[(long)(tm * 256 + r0 + mi * 16 + j) * 768 + tn * 128 + c0 + ni * 16] = f2bf(acc[mi][ni][j]);
          });
      } else if (tile < 1280) {
        const int tt = tile - 768, tm = tt >> 2, tn = tt & 3;
        gemm_tile(ckvn + (long)tm * 256 * 128, 128, (const u16*)(ws + W0_K) + (long)tn * 128 * 128, 128, 128, smem,
          [&](f32x4 (&acc)[4][4], int r0, int c0) {
#pragma unroll
            for (int mi = 0; mi < 4; ++mi)
#pragma unroll
              for (int j = 0; j < 4; ++j)
#pragma unroll
                for (int ni = 0; ni < 4; ++ni)
                  knraw[(long)(tm * 256 + r0 + mi * 16 + j) * 512 + tn * 128 + c0 + ni * 16] = f2bf(acc[mi][ni][j]);
          });
      } else {
        const int tt = tile - 1280, tm = tt & 1, tn = tt >> 1;
        gemm_tile((const u16*)(ws + W0_V) + (long)tm * 256 * 128, 128, ckvn + (long)tn * 128 * 128, 128, 128, smem,
          [&](f32x4 (&acc)[4][4], int r0, int c0) {
#pragma unroll
            for (int mi = 0; mi < 4; ++mi)
#pragma unroll
              for (int j = 0; j < 4; ++j)
#pragma unroll
                for (int ni = 0; ni < 4; ++ni)
                  Vt[(long)(tm * 256 + r0 + mi * 16 + j) * T_TOK + tn * 128 + c0 + ni * 16] = f2bf(acc[mi][ni][j]);
          });
      }
    }
    float2* rope = (float2*)(dsc + D_ROPE);
    for (long e = gtid; e < 16384 * 16; e += GT) {
      const int pos = (int)(e >> 4), i = (int)(e & 15);
      const int lo = i & 3, hi = i >> 2;
      const double base = (lo == 0) ? 1.0 : (lo == 1) ? 0.5623413251903491 : (lo == 2) ? 0.31622776601683794 : 0.1778279410038923;
      const double sc = (hi == 0) ? 1.0 : (hi == 1) ? 0.1 : (hi == 2) ? 0.01 : 0.001;
      double rev = (double)pos * (base * sc) * 0.15915494309189535;
      rev -= floor(rev);
      const float rf = (float)rev;
      rope[e] = make_float2(__builtin_amdgcn_cosf(rf), __builtin_amdgcn_sinf(rf));
    }
  }
  grid.sync();

  if (PHM & (1 << 4)) {
    u16* qraw = (u16*)(dsc + D_QRAW);
    const u16* knraw = (const u16*)(dsc + D_KN);
    const u16* kpe = (const u16*)(ws + R_KPE);
    u16* Kb = (u16*)(ws + R_K);
    const float2* rope = (const float2*)(dsc + D_ROPE);
    const float* qn = p.in[13]; const float* kn = p.in[14];
    const float qscale = 0.10206207261596577f * 1.4426950408889634f;
    for (long pr = gtid; pr < (long)T_TOK * 8; pr += GT) {
      const int t = (int)(pr >> 3), h = (int)(pr & 7);
      int t0, L; seq_of(t, t0, L);
      const float2* rt = rope + (long)(t - t0) * 16;
      {
        u16* qp = qraw + (long)t * 768 + h * 96;
        float ss = 0.f;
#pragma unroll 1
        for (int i = 0; i < 12; ++i) { float f[8]; unpack8(*(const u32x4*)(qp + i * 8), f);
#pragma unroll
          for (int j = 0; j < 8; ++j) ss += f[j] * f[j]; }
        const float rs = rsqrtf(ss * (1.f / 96.f) + EPSN) * qscale;
#pragma unroll 1
        for (int i = 0; i < 8; ++i) { float f[8]; unpack8(*(const u32x4*)(qp + i * 8), f);
#pragma unroll
          for (int j = 0; j < 8; ++j) f[j] = f[j] * rs * qn[i * 8 + j];
          *(u32x4*)(qp + i * 8) = pack8(f); }
#pragma unroll 1
        for (int i = 0; i < 2; ++i) {
          float a[8], b[8];
          unpack8(*(const u32x4*)(qp + 64 + i * 8), a); unpack8(*(const u32x4*)(qp + 80 + i * 8), b);
#pragma unroll
          for (int j = 0; j < 8; ++j) {
            const float2 cs = rt[i * 8 + j];
            const float x1 = a[j] * rs * qn[64 + i * 8 + j], x2 = b[j] * rs * qn[80 + i * 8 + j];
            a[j] = x1 * cs.x - x2 * cs.y; b[j] = x1 * cs.y + x2 * cs.x;
          }
          *(u32x4*)(qp + 64 + i * 8) = pack8(a); *(u32x4*)(qp + 80 + i * 8) = pack8(b);
        }
      }
      {
        const u16* kp = knraw + (long)t * 512 + h * 64;
        const u16* pp = kpe + (long)t * 32;
        u16* ko = Kb + (long)t * 768 + h * 96;
        float ss = 0.f;
#pragma unroll 1
        for (int i = 0; i < 8; ++i) { float f[8]; unpack8(*(const u32x4*)(kp + i * 8), f);
#pragma unroll
          for (int j = 0; j < 8; ++j) ss += f[j] * f[j]; }
#pragma unroll 1
        for (int i = 0; i < 4; ++i) { float f[8]; unpack8(*(const u32x4*)(pp + i * 8), f);
#pragma unroll
          for (int j = 0; j < 8; ++j) ss += f[j] * f[j]; }
        const float rs = rsqrtf(ss * (1.f / 96.f) + EPSN);
#pragma unroll 1
        for (int i = 0; i < 8; ++i) { float f[8]; unpack8(*(const u32x4*)(kp + i * 8), f);
#pragma unroll
          for (int j = 0; j < 8; ++j) f[j] = f[j] * rs * kn[i * 8 + j];
          *(u32x4*)(ko + i * 8) = pack8(f); }
#pragma unroll 1
        for (int i = 0; i < 2; ++i) {
          float a[8], b[8];
          unpack8(*(const u32x4*)(pp + i * 8), a); unpack8(*(const u32x4*)(pp + 16 + i * 8), b);
#pragma unroll
          for (int j = 0; j < 8; ++j) {
            const float2 cs = rt[i * 8 + j];
            const float x1 = a[j] * rs * kn[64 + i * 8 + j], x2 = b[j] * rs * kn[80 + i * 8 + j];
            a[j] = x1 * cs.x - x2 * cs.y; b[j] = x1 * cs.y + x2 * cs.x;
          }
          *(u32x4*)(ko + 64 + i * 8) = pack8(a); *(u32x4*)(ko + 80 + i * 8) = pack8(b);
        }
      }
    }
  }
  grid.sync();

  if (PHM & (1 << 5)) {
    const u16* Q = (const u16*)(dsc + D_QRAW);
    const u16* Kb = (const u16*)(ws + R_K);
    const u16* Vt = (const u16*)(dsc + D_VT);
    u16* mix = (u16*)(ws + R_MIX);
    const int l31 = lane & 31, hh = lane >> 5;
    for (int item = vb; item < 1024; item += G) {
      int t0, L, h, qb;
      if (item < 512) { t0 = 16384; L = 16384; h = item >> 6; qb = item & 63; }
      else { const int it = item - 512; const int s = it >> 8; t0 = s * 8192; L = 8192; h = (it >> 5) & 7; qb = it & 31; }
      const int tq = t0 + qb * 256 + wid * 32 + l31;
      bf16x8 qf[6];
#pragma unroll
      for (int ks = 0; ks < 6; ++ks) qf[ks] = *(const bf16x8*)(Q + (long)tq * 768 + h * 96 + ks * 16 + hh * 8);
      f32x16 o[2];
#pragma unroll
      for (int i = 0; i < 16; ++i) { o[0][i] = 0.f; o[1][i] = 0.f; }
      float m_run = -1e30f, l_run = 0.f;
      u32x4 rk[3], rv[2];
      const u16* gK[3]; int sK[3];
#pragma unroll
      for (int i = 0; i < 3; ++i) {
        const int id = tid + 512 * i, row = id / 12, c = id % 12;
        gK[i] = Kb + (long)(t0 + row) * 768 + h * 96 + c * 8;
        sK[i] = row * 208 + c * 16;
      }
      const u16* gV[2]; int sV[2];
#pragma unroll
      for (int i = 0; i < 2; ++i) {
        const int id = tid + 512 * i, dv = id >> 4, c = id & 15;
        gV[i] = Vt + (long)(h * 64 + dv) * T_TOK + t0 + c * 8;
        sV[i] = 26624 + dv * 264 + c * 16;
      }
      const int ntile = L >> 7;
#pragma unroll
      for (int i = 0; i < 3; ++i) rk[i] = *(const u32x4*)(gK[i]);
#pragma unroll
      for (int i = 0; i < 2; ++i) rv[i] = *(const u32x4*)(gV[i]);
#pragma unroll
      for (int i = 0; i < 3; ++i) *(u32x4*)(smem + sK[i]) = rk[i];
#pragma unroll
      for (int i = 0; i < 2; ++i) { u32x2 a, b; a[0] = rv[i][0]; a[1] = rv[i][1]; b[0] = rv[i][2]; b[1] = rv[i][3];
        *(u32x2*)(smem + sV[i]) = a; *(u32x2*)(smem + sV[i] + 8) = b; }
      __syncthreads();
      for (int kt = 0; kt < ntile; ++kt) {
        if (kt + 1 < ntile) {
#pragma unroll
          for (int i = 0; i < 3; ++i) rk[i] = *(const u32x4*)(gK[i] + (long)(kt + 1) * 128 * 768);
#pragma unroll
          for (int i = 0; i < 2; ++i) rv[i] = *(const u32x4*)(gV[i] + (kt + 1) * 128);
        }
        const char* Ks = smem + (kt & 1) * 43520;
        const char* Vs = Ks + 26624;
#pragma unroll
        for (int half = 0; half < 2; ++half) {
          f32x16 s[2];
#pragma unroll
          for (int k2 = 0; k2 < 2; ++k2) {
#pragma unroll
            for (int i = 0; i < 16; ++i) s[k2][i] = 0.f;
#pragma unroll
            for (int ks = 0; ks < 6; ++ks) {
              const bf16x8 a = *(const bf16x8*)(Ks + (half * 64 + k2 * 32 + l31) * 208 + (ks * 2 + hh) * 16);
              s[k2] = __builtin_amdgcn_mfma_f32_32x32x16_bf16(a, qf[ks], s[k2], 0, 0, 0);
            }
          }
          float mloc = s[0][0];
#pragma unroll
          for (int i = 1; i < 16; ++i) mloc = fmaxf(mloc, s[0][i]);
#pragma unroll
          for (int i = 0; i < 16; ++i) mloc = fmaxf(mloc, s[1][i]);
          mloc = fmaxf(mloc, __shfl_xor(mloc, 32));
          const float mnew = fmaxf(m_run, mloc);
          const float alpha = __builtin_amdgcn_exp2f(m_run - mnew);
          m_run = mnew;
          float rsum = 0.f;
#pragma unroll
          for (int k2 = 0; k2 < 2; ++k2)
#pragma unroll
            for (int i = 0; i < 16; ++i) { const float pv = __builtin_amdgcn_exp2f(s[k2][i] - mnew); s[k2][i] = pv; rsum += pv; }
          l_run = l_run * alpha + rsum;
#pragma unroll
          for (int i = 0; i < 16; ++i) { o[0][i] *= alpha; o[1][i] *= alpha; }
#pragma unroll
          for (int k2 = 0; k2 < 2; ++k2)
#pragma unroll
            for (int st = 0; st < 2; ++st) {
              u32x4 pk;
              pk[0] = pack2(s[k2][8 * st + 0], s[k2][8 * st + 1]); pk[1] = pack2(s[k2][8 * st + 2], s[k2][8 * st + 3]);
              pk[2] = pack2(s[k2][8 * st + 4], s[k2][8 * st + 5]); pk[3] = pack2(s[k2][8 * st + 6], s[k2][8 * st + 7]);
              const bf16x8 pb = __builtin_bit_cast(bf16x8, pk);
#pragma unroll
              for (int dvt = 0; dvt < 2; ++dvt) {
                const char* ad = Vs + (dvt * 32 + l31) * 264 + (half * 64 + k2 * 32 + st * 16 + hh * 4) * 2;
                const s16x4 lo = *(const s16x4*)(ad);
                const s16x4 hi = *(const s16x4*)(ad + 16);
                const bf16x8 va = __builtin_shufflevector(lo, hi, 0, 1, 2, 3, 4, 5, 6, 7);
                o[dvt] = __builtin_amdgcn_mfma_f32_32x32x16_bf16(va, pb, o[dvt], 0, 0, 0);
              }
            }
        }
        if (kt + 1 < ntile) {
          char* d = smem + ((kt + 1) & 1) * 43520;
#pragma unroll
          for (int i = 0; i < 3; ++i) *(u32x4*)(d + sK[i]) = rk[i];
#pragma unroll
          for (int i = 0; i < 2; ++i) { u32x2 a, b; a[0] = rv[i][0]; a[1] = rv[i][1]; b[0] = rv[i][2]; b[1] = rv[i][3];
            *(u32x2*)(d + sV[i]) = a; *(u32x2*)(d + sV[i] + 8) = b; }
        }
        __syncthreads();
      }
      const float ltot = l_run + __shfl_xor(l_run, 32);
      const float inv = 1.f / ltot;
#pragma unroll
      for (int dvt = 0; dvt < 2; ++dvt)
#pragma unroll
        for (int g = 0; g < 4; ++g) {
          u32x2 w;
          w[0] = pack2(o[dvt][4 * g] * inv, o[dvt][4 * g + 1] * inv);
          w[1] = pack2(o[dvt][4 * g + 2] * inv, o[dvt][4 * g + 3] * inv);
          *(u32x2*)(mix + (long)tq * 1024 + 512 + h * 64 + dvt * 32 + 8 * g + 4 * hh) = w;
        }
    }
  }
  grid.sync();

  auto resid_epi = [&](f32x4 (&acc)[4][4], int r0, int c0, int tm, int tn, float* ssq) {
#pragma unroll
    for (int mi = 0; mi < 4; ++mi)
#pragma unroll
      for (int j = 0; j < 4; ++j) {
        const int row = tm * 256 + r0 + mi * 16 + j;
        float part = 0.f;
#pragma unroll
        for (int ni = 0; ni < 4; ++ni) {
          u16* xp = XB + (long)row * DM + tn * 128 + c0 + ni * 16;
          const float xn = bf2f(*xp) + acc[mi][ni][j];
          *xp = f2bf(xn);
          part += xn * xn;
        }
        part += __shfl_xor(part, 8); part += __shfl_xor(part, 4); part += __shfl_xor(part, 2); part += __shfl_xor(part, 1);
        if ((lane & 15) == 0) atomicAdd(ssq + row, part);
      }
  };
  auto ffn_up = [&](const u16* Wgu, const float* ssq, u16* actA, u16* actB, int rt_lo, int nrt) {
    for (int tile = vb; tile < nrt * 44; tile += G) {
      const int tm = rt_lo + tile / 44, tn = tile % 44;
      u16* act = (tm < 64) ? (actA + (long)tm * 256 * DFF) : (actB + (long)(tm - 64) * 256 * DFF);
      gemm_tile(XB + (long)tm * 256 * DM, DM, Wgu + (long)tn * 128 * DM, DM, DM, smem,
        [&](f32x4 (&acc)[4][4], int r0, int c0) {
#pragma unroll
          for (int mi = 0; mi < 4; ++mi)
#pragma unroll
            for (int j = 0; j < 4; ++j) {
              const int rl = r0 + mi * 16 + j;
              const float rs = rsqrtf(ssq[tm * 256 + rl] * (1.f / 1024.f) + EPSN);
#pragma unroll
              for (int pq = 0; pq < 2; ++pq) {
                const float gv = acc[mi][2 * pq][j] * rs, uv = acc[mi][2 * pq + 1][j] * rs;
                const float sg = gv / (1.f + __expf(-gv));
                const int cb = tn * 128 + (c0 & 64) + pq * 32;
                act[(long)rl * DFF + (cb >> 1) + (c0 & 15)] = f2bf(sg * uv);
              }
            }
        });
    }
  };
  auto ffn_down = [&](const u16* Wd, float* ssq, const u16* actA, const u16* actB, int rt_lo, int nrt, bool fin) {
    for (int tile = vb; tile < nrt * 8; tile += G) {
      const int tm = rt_lo + (tile >> 3), tn = tile & 7;
      const u16* act = (tm < 64) ? (actA + (long)tm * 256 * DFF) : (actB + (long)(tm - 64) * 256 * DFF);
      if (!fin) {
        gemm_tile(act, DFF, Wd + (long)tn * 128 * DFF, DFF, DFF, smem,
          [&](f32x4 (&acc)[4][4], int r0, int c0) { resid_epi(acc, r0, c0, tm, tn, ssq); });
      } else {
        gemm_tile(act, DFF, Wd + (long)tn * 128 * DFF, DFF, DFF, smem,
          [&](f32x4 (&acc)[4][4], int r0, int c0) {
#pragma unroll
            for (int mi = 0; mi < 4; ++mi)
#pragma unroll
              for (int j = 0; j < 4; ++j)
#pragma unroll
                for (int ni = 0; ni < 4; ++ni) {
                  const long idx = (long)(tm * 256 + r0 + mi * 16 + j) * DM + tn * 128 + c0 + ni * 16;
                  p.out[idx] = bf2f(XB[idx]) + acc[mi][ni][j];
                }
          });
      }
    }
  };

  if (PHM & (1 << 6)) {
    const u16* mix = (const u16*)(ws + R_MIX);
    const u16* Wt = (const u16*)(ws + W0_OUT);
    for (int tile = vb; tile < 1024; tile += G) {
      const int tm = tile >> 3, tn = tile & 7;
      gemm_tile(mix + (long)tm * 256 * DM, DM, Wt + (long)tn * 128 * DM, DM, DM, smem,
        [&](f32x4 (&acc)[4][4], int r0, int c0) { resid_epi(acc, r0, c0, tm, tn, rowss + T_TOK); });
    }
  }
  grid.sync();
  if (PHM & (1 << 7)) ffn_up((const u16*)(ws + W0_GU), rowss + T_TOK, (u16*)(ws + OFF_R), (u16*)dsc, 0, 128);
  grid.sync();
  if (PHM & (1 << 7)) ffn_down((const u16*)(ws + W0_D), rowss + 2 * T_TOK, (const u16*)(ws + OFF_R), (const u16*)dsc, 0, 128, false);
  grid.sync();

  if (PHM & (1 << 8)) {
    const u16* Wt = (const u16*)(ws + W1_CIN);
    u16* x0t = (u16*)(ws + C_X0T);
    u16* x1vt = (u16*)dsc;
    const float* ssq = rowss + 2 * T_TOK;
    for (int tile = vb; tile < 3072 + 1536; tile += G) {
      if (tile < 3072) {
        const int tm = tile % 12, tn = tile / 12;
        gemm_tile(Wt + (long)tm * 256 * DM, DM, XB + (long)tn * 128 * DM, DM, DM, smem,
          [&](f32x4 (&acc)[4][4], int r0, int c0) {
            float rs[4];
#pragma unroll
            for (int ni = 0; ni < 4; ++ni) rs[ni] = rsqrtf(ssq[tn * 128 + c0 + ni * 16] * (1.f / 1024.f) + EPSN);
#pragma unroll
            for (int mi = 0; mi < 4; ++mi)
#pragma unroll
              for (int j = 0; j < 4; ++j) {
                const int ch = tm * 256 + r0 + mi * 16 + j;
                u16* dst = (ch < 1024) ? (x0t + (long)ch * T_TOK) : (x1vt + (long)(ch - 1024) * T_TOK);
#pragma unroll
                for (int ni = 0; ni < 4; ++ni) dst[tn * 128 + c0 + ni * 16] = f2bf(acc[mi][ni][j] * rs[ni]);
              }
          });
      } else {
        const int tt = tile - 3072;
        const bool smp = tt >= 512;
        const int t2 = smp ? tt - 512 : tt;
        const int tm = t2 & 7, tn = t2 >> 3;
        const int Lf = smp ? 16384 : 8192;
        const u16* z3 = (const u16*)(ws + SM_Z3) + (smp ? (long)8192 * 64 : 0);
        u16* kern = smp ? (u16*)(ws + C_KS) : (u16*)(ws + C_KP);
        gemm_tile((const u16*)(ws + W1_W4) + (long)tm * 256 * 64, 64, z3 + (long)tn * 128 * 64, 64, 64, smem,
          [&](f32x4 (&acc)[4][4], int r0, int c0) {
            const float invLm1 = 1.f / (float)(Lf - 1);
#pragma unroll
            for (int mi = 0; mi < 4; ++mi)
#pragma unroll
              for (int j = 0; j < 4; ++j) {
                const int cp = tm * 256 + r0 + mi * 16 + j;
                const int ch = cp & 1023;
                const bool bwd = cp >= 1024;
                const float ad = 3.0701134573253945f + (float)ch * (12.280453829301578f / 1023.f);
                u16* kr = kern + (long)ch * (2 * Lf);
#pragma unroll
                for (int ni = 0; ni < 4; ++ni) {
                  const int l = tn * 128 + c0 + ni * 16;
                  const float wv = __expf(-(float)l * invLm1 * ad);
                  const float val = acc[mi][ni][j] * wv;
                  if (!bwd) kr[l] = f2bf(val);
                  else if (l > 0) kr[2 * Lf - l] = f2bf(val);
                  else kr[Lf] = 0;
                }
              }
          });
      }
    }
  }
  grid.sync();

  if (PHM & (1 << 9)) {
    float2* X = (float2*)smem;
    u16* zs = (u16*)(smem + 131072);
    const u16* x0t = (const u16*)(ws + C_X0T);
    u16* x1vt = (u16*)dsc;
    const float* sw = p.in[17];
    const float SCL = 1.f / 16384.f;
    for (int job = vb; job < 2048; job += G) {
      const bool smp = job >= 1024;
      const int ch = job & 1023;
      const float w00 = sw[ch * 3], w01 = sw[ch * 3 + 1], w02 = sw[ch * 3 + 2];
      const float w10 = sw[(1024 + ch) * 3], w11 = sw[(1024 + ch) * 3 + 1], w12 = sw[(1024 + ch) * 3 + 2];
      const float w20 = sw[(2048 + ch) * 3], w21 = sw[(2048 + ch) * 3 + 1], w22 = sw[(2048 + ch) * 3 + 2];
      const float bias = p.in[26][ch];
      u16* x1row = x1vt + (long)ch * T_TOK;
      const u16* vrow = x1vt + (long)(1024 + ch) * T_TOK;
      const u16* x0row = x0t + (long)ch * T_TOK;
      __syncthreads();
      if (!smp && (FFTP & 1)) {
        const u16* kr = (const u16*)(ws + C_KP) + (long)ch * 16384;
#pragma unroll
        for (int u = 0; u < 4; ++u) {
          const int n = 8 * (tid + 512 * u);
          float f[8]; unpack8(*(const u32x4*)(kr + n), f);
#pragma unroll
          for (int i = 0; i < 8; ++i) X[n + i] = make_float2(f[i], 0.f);
        }
        fft_fwd_head(X);
        unsigned Kf[2][16];
#pragma unroll
        for (int u = 0; u < 2; ++u) {
          const int g = tid + 512 * u;
          float2 v[16];
#pragma unroll
          for (int r = 0; r < 16; ++r) v[r] = X[16 * g + r];
          fft16_fwd(v);
#pragma unroll
          for (int r = 0; r < 16; ++r) Kf[u][r] = pack2(v[r].x, v[r].y);
          asm volatile("" ::: "memory");
        }
        __syncthreads();
#pragma unroll 1
        for (int u = 0; u < 2; ++u) {
          const int n = 8 * (tid + 512 * u);
          float z0[8], z1[8];
          {
            float a[8], c[8];
            conv3_8(x1row, n, 8192, w10, w11, w12, a);
            conv3_8(vrow, n, 8192, w20, w21, w22, c);
#pragma unroll
            for (int i = 0; i < 8; ++i) z0[i] = a[i] * c[i];
            conv3_8(x1row + 8192, n, 8192, w10, w11, w12, a);
            conv3_8(vrow + 8192, n, 8192, w20, w21, w22, c);
#pragma unroll
            for (int i = 0; i < 8; ++i) z1[i] = a[i] * c[i];
          }
          *(u32x4*)(zs + n) = pack8(z0);
          *(u32x4*)(zs + 8192 + n) = pack8(z1);
#pragma unroll
          for (int i = 0; i < 8; ++i) { X[n + i] = make_float2(z0[i], z1[i]); X[8192 + n + i] = make_float2(0.f, 0.f); }
        }
        fft_fwd_head(X);
#pragma unroll
        for (int u = 0; u < 2; ++u) {
          const int g = tid + 512 * u;
          float2 v[16];
#pragma unroll
          for (int r = 0; r < 16; ++r) v[r] = X[16 * g + r];
          fft16_fwd(v);
#pragma unroll
          for (int r = 0; r < 16; ++r) v[r] = cmul(v[r], make_float2(lo_bf(Kf[u][r]), hi_bf(Kf[u][r])));
          fft16_inv(v);
#pragma unroll
          for (int r = 0; r < 16; ++r) X[16 * g + r] = v[r];
          asm volatile("" ::: "memory");
        }
        fft_inv_tail(X);
#pragma unroll 1
        for (int u = 0; u < 2; ++u) {
          const int n = 8 * (tid + 512 * u);
          float yr[8], yi[8], z0[8], z1[8];
          unpack8(*(const u32x4*)(zs + n), z0);
          unpack8(*(const u32x4*)(zs + 8192 + n), z1);
#pragma unroll
          for (int i = 0; i < 8; ++i) { const float2 xv = X[n + i]; yr[i] = xv.x * SCL + bias * z0[i]; yi[i] = xv.y * SCL + bias * z1[i]; }
          float g0[8];
          conv3_8(x0row, n, 8192, w00, w01, w02, g0);
#pragma unroll
          for (int i = 0; i < 8; ++i) yr[i] *= g0[i];
          conv3_8(x0row + 8192, n, 8192, w00, w01, w02, g0);
#pragma unroll
          for (int i = 0; i < 8; ++i) yi[i] *= g0[i];
          *(u32x4*)(x1row + n) = pack8(yr);
          *(u32x4*)(x1row + 8192 + n) = pack8(yi);
        }
      } else if (smp && (FFTP & 2)) {
        const u16* kr = (const u16*)(ws + C_KS) + (long)ch * 32768;
#pragma unroll
        for (int u = 0; u < 8; ++u) {
          const int n = 4 * (tid + 512 * u);
          float f[8]; unpack8(*(const u32x4*)(kr + 2 * n), f);
#pragma unroll
          for (int i = 0; i < 4; ++i) X[n + i] = make_float2(f[2 * i], f[2 * i + 1]);
        }
        fft_fwd_head(X);
#pragma unroll 1
        for (int u = 0; u < 2; ++u) {
          const int g = tid + 512 * u;
          float2 v[16];
#pragma unroll
          for (int r = 0; r < 16; ++r) v[r] = X[16 * g + r];
          fft16_fwd(v);
#pragma unroll
          for (int r = 0; r < 16; ++r) X[16 * g + r] = v[r];
        }
        __syncthreads();
        unsigned KA[17], KB[17];
#pragma unroll
        for (int m = 0; m < 17; ++m) {
          int k = (m < 16) ? (tid + 512 * m) : 8192;
          asm volatile("" : "+v"(k) :: "memory");
          if (m < 16 || tid == 0) {
            const float2 c1 = X[pos14(k)], c2 = X[pos14((16384 - k) & 16383)];
            const float2 ae = make_float2(0.5f * (c1.x + c2.x), 0.5f * (c1.y - c2.y));
            const float2 ao = make_float2(0.5f * (c1.y + c2.y), -0.5f * (c1.x - c2.x));
            const float2 tw = twid((float)k * (1.f / 32768.f));
            const float2 tao = cmul(tw, ao);
            const float2 ka = cadd(ae, tao), kb = cconj(csub(ae, tao));
            KA[m] = pack2(ka.x, ka.y);
            KB[m] = pack2(kb.x, kb.y);
          } else { KA[m] = 0u; KB[m] = 0u; }
        }
        __syncthreads();
        const u16* x1s = x1row + 16384; const u16* vs = vrow + 16384;
#pragma unroll 1
        for (int u = 0; u < 4; ++u) {
          const int tl = 8 * (tid + 512 * u);
          float a[8], c[8];
          conv3_8(x1s, tl, 16384, w10, w11, w12, a);
          conv3_8(vs, tl, 16384, w20, w21, w22, c);
#pragma unroll
          for (int i = 0; i < 8; ++i) a[i] *= c[i];
          *(u32x4*)(zs + tl) = pack8(a);
          const int n = tl >> 1;
#pragma unroll
          for (int i = 0; i < 4; ++i) { X[n + i] = make_float2(a[2 * i], a[2 * i + 1]); X[8192 + n + i] = make_float2(0.f, 0.f); }
        }
        fft_fwd_head(X);
#pragma unroll 1
        for (int u = 0; u < 2; ++u) {
          const int g = tid + 512 * u;
          float2 v[16];
#pragma unroll
          for (int r = 0; r < 16; ++r) v[r] = X[16 * g + r];
          fft16_fwd(v);
#pragma unroll
          for (int r = 0; r < 16; ++r) X[16 * g + r] = v[r];
        }
        __syncthreads();
#pragma unroll
        for (int m = 0; m < 17; ++m) {
          int k = (m < 16) ? (tid + 512 * m) : 8192;
          asm volatile("" : "+v"(k) :: "memory");
          if (m < 16 || tid == 0) {
            const int p1 = pos14(k), p2 = pos14((16384 - k) & 16383);
            const float2 c1 = X[p1], c2 = X[p2];
            const float2 ae = make_float2(0.5f * (c1.x + c2.x), 0.5f * (c1.y - c2.y));
            const float2 ao = make_float2(0.5f * (c1.y + c2.y), -0.5f * (c1.x - c2.x));
            const float2 tw = twid((float)k * (1.f / 32768.f));
            const float2 tao = cmul(tw, ao);
            const float2 y1 = cmul(cadd(ae, tao), make_float2(lo_bf(KA[m]), hi_bf(KA[m])));
            const float2 y2 = cmul(cconj(csub(ae, tao)), make_float2(lo_bf(KB[m]), hi_bf(KB[m])));
            const float2 ye = make_float2(0.5f * (y1.x + y2.x), 0.5f * (y1.y - y2.y));
            const float2 yd = make_float2(0.5f * (y1.x - y2.x), 0.5f * (y1.y + y2.y));
            const float2 yo = cmulc(yd, tw);
            X[p1] = make_float2(ye.x - yo.y, ye.y + yo.x);
            if (k != 0) X[p2] = make_float2(ye.x + yo.y, -ye.y + yo.x);
          }
        }
        __syncthreads();
#pragma unroll 1
        for (int u = 0; u < 2; ++u) {
          const int g = tid + 512 * u;
          float2 v[16];
#pragma unroll
          for (int r = 0; r < 16; ++r) v[r] = X[16 * g + r];
          fft16_inv(v);
#pragma unroll
          for (int r = 0; r < 16; ++r) X[16 * g + r] = v[r];
        }
        fft_inv_tail(X);
        u16* orow = x1row + 16384;
        const u16* x0s = x0row + 16384;
#pragma unroll 1
        for (int u = 0; u < 4; ++u) {
          const int tl = 8 * (tid + 512 * u);
          const int n = tl >> 1;
          float y[8], g0[8], zz[8];
          unpack8(*(const u32x4*)(zs + tl), zz);
#pragma unroll
          for (int i = 0; i < 4; ++i) { const float2 xv = X[n + i]; y[2 * i] = xv.x * SCL + bias * zz[2 * i]; y[2 * i + 1] = xv.y * SCL + bias * zz[2 * i + 1]; }
          conv3_8(x0s, tl, 16384, w00, w01, w02, g0);
#pragma unroll
          for (int i = 0; i < 8; ++i) y[i] *= g0[i];
          *(u32x4*)(orow + tl) = pack8(y);
        }
      }
    }
  }
  grid.sync();

  if (PHM & (1 << 10)) {
    const u16* src = (const u16*)dsc;
    u16* yg = (u16*)(ws + C_YG);
    u16* tl = (u16*)smem;
    for (int tile = vb; tile < 16 * 512; tile += G) {
      const int tc = tile & 15, tt = tile >> 4;
      {
        const int cr = tid >> 3, c8 = tid & 7;
        const u32x4 v = *(const u32x4*)(src + (long)(tc * 64 + cr) * T_TOK + tt * 64 + c8 * 8);
        *(u32x4*)(tl + cr * 72 + c8 * 8) = v;
      }
      __syncthreads();
      {
        const int tr = tid >> 3, c8 = tid & 7;
        u32x4 o;
#pragma unroll
        for (int i = 0; i < 4; ++i) {
          const unsigned a = tl[(c8 * 8 + 2 * i) * 72 + tr], b = tl[(c8 * 8 + 2 * i + 1) * 72 + tr];
          o[i] = a | (b << 16);
        }
        *(u32x4*)(yg + (long)(tt * 64 + tr) * DM + tc * 64 + c8 * 8) = o;
      }
      __syncthreads();
    }
  }
  grid.sync();

  if (PHM & (1 << 11)) {
    const u16* yg = (const u16*)(ws + C_YG);
    const u16* Wt = (const u16*)(ws + W1_COUT);
    for (int tile = vb; tile < 1024; tile += G) {
      const int tm = tile >> 3, tn = tile & 7;
      gemm_tile(yg + (long)tm * 256 * DM, DM, Wt + (long)tn * 128 * DM, DM, DM, smem,
        [&](f32x4 (&acc)[4][4], int r0, int c0) { resid_epi(acc, r0, c0, tm, tn, rowss + 3 * T_TOK); });
    }
  }
  grid.sync();

  if (PHM & (1 << 12)) {
    u16* actC = (u16*)(ws + OFF_C);
    ffn_up((const u16*)(ws + W1_GU), rowss + 3 * T_TOK, actC, actC, 0, 64);
    grid.sync();
    ffn_down((const u16*)(ws + W1_D), nullptr, actC, actC, 0, 64, true);
    grid.sync();
    ffn_up((const u16*)(ws + W1_GU), rowss + 3 * T_TOK, actC, actC, 64, 64);
    grid.sync();
    ffn_down((const u16*)(ws + W1_D), nullptr, actC, actC, 64, 64, true);
  }
}

extern "C" void kernel_launch(void* const* d_in, const int* in_sizes, int n_in, void* d_out, int out_size,
                              void* d_ws, size_t ws_size, hipStream_t stream) {
  static int grid_blocks = 0;
  if (!grid_blocks) {
    int dev = 0, cus = 0, per_cu = 0;
    hipGetDevice(&dev);
    hipDeviceGetAttribute(&cus, hipDeviceAttributeMultiprocessorCount, dev);
    hipOccupancyMaxActiveBlocksPerMultiprocessor(&per_cu, fwd_kernel, NTHR, 0);
    if (per_cu < 1) per_cu = 1;
    grid_blocks = cus;
    if (grid_blocks % 8) grid_blocks -= grid_blocks % 8;
  }
  if (ws_size < WS_NEED || n_in < 28) { fprintf(stderr, "workspace too small\n"); return; }
  Params p{};
  for (int i = 0; i < 28; ++i) p.in[i] = (const float*)d_in[i];
  p.out = (float*)d_out;
  p.ws = (char*)d_ws;
  void* args[] = {&p};
  hipError_t e = hipLaunchCooperativeKernel((void*)fwd_kernel, dim3(grid_blocks), dim3(NTHR), args, 0, stream);
  if (e != hipSuccess) fprintf(stderr, "cooperative launch failed: %s (grid %d)\n", hipGetErrorString(e), grid_blocks);
}
```

```cpp
#include <hip/hip_runtime.h>
#include <hip/hip_cooperative_groups.h>
#include <cstdio>
#include <cstdint>
namespace cg = cooperative_groups;

typedef unsigned short u16;
typedef __attribute__((ext_vector_type(8))) short bf16x8;
typedef __attribute__((ext_vector_type(4))) short s16x4;
typedef __attribute__((ext_vector_type(4))) float f32x4;
typedef __attribute__((ext_vector_type(16))) float f32x16;
typedef __attribute__((ext_vector_type(4))) unsigned u32x4;
typedef __attribute__((ext_vector_type(2))) unsigned u32x2;

#define DI __device__ __forceinline__
#define NTHR 512
#ifndef FFTP
#define FFTP 3
#endif
#ifndef REP1
#define REP1 1
#endif
#ifndef REP5
#define REP5 1
#endif
#ifndef REP7
#define REP7 1
#endif
#ifndef REP8
#define REP8 1
#endif
#ifndef PHM
#define PHM 0xffff
#endif


DI float2 mk2(float x, float y) { float2 r; r.x = x; r.y = y; return r; }
DI void bsync() { __builtin_amdgcn_fence(__ATOMIC_RELEASE, "workgroup"); __builtin_amdgcn_s_barrier(); __builtin_amdgcn_fence(__ATOMIC_ACQUIRE, "workgroup"); }
DI float i2f(int v) { return __builtin_bit_cast(float, v); }
DI int f2i(float v) { return __builtin_bit_cast(int, v); }
#define make_float2 mk2
#define __syncthreads bsync
#define __int_as_float i2f
#define __float_as_int f2i

constexpr int T_TOK = 32768;
constexpr int DM = 1024;
constexpr int DFF = 2816;
constexpr float EPSN = 1e-6f;

constexpr size_t SM_ROWSS = 4096;
constexpr size_t SM_Z3    = 1048576;
constexpr size_t OFF_W1   = 4194304;
constexpr size_t W1_CIN   = OFF_W1;
constexpr size_t W1_COUT  = W1_CIN + 6291456;
constexpr size_t W1_W4    = W1_COUT + 2097152;
constexpr size_t W1_GU    = W1_W4 + 262144;
constexpr size_t W1_D     = W1_GU + 11534336;
constexpr size_t OFF_XB   = W1_D + 5767168;
constexpr size_t OFF_C    = OFF_XB + 67108864;
constexpr size_t W0_IN    = OFF_C;
constexpr size_t W0_Q     = W0_IN + 4194304;
constexpr size_t W0_K     = W0_Q + 393216;
constexpr size_t W0_V     = W0_K + 131072;
constexpr size_t W0_OUT   = W0_V + 131072;
constexpr size_t W0_GU    = W0_OUT + 2097152;
constexpr size_t W0_D     = W0_GU + 11534336;
constexpr size_t OFF_R    = W0_D + 5767168;
constexpr size_t WS_NEED  = 268435456;
static_assert(OFF_R == 121503744, "map");
constexpr size_t R_CQN  = OFF_R;
constexpr size_t R_CKVN = R_CQN + 16777216;
constexpr size_t R_KPE  = R_CKVN + 8388608;
constexpr size_t R_MIX  = R_KPE + 2097152;
constexpr size_t R_K    = R_MIX + 67108864;
constexpr size_t R_ROPE = R_K + 50331648;
constexpr size_t SM_SSKPE = 528384;
static_assert(R_ROPE + 2097152 <= WS_NEED, "map");
constexpr size_t D_QRAW = 0;
constexpr size_t D_KN   = 50331648;
constexpr size_t D_VT   = D_KN + 33554432;
constexpr size_t D_ROPE = D_VT + 33554432;
static_assert(D_ROPE + 2097152 <= 134217728, "map");
constexpr size_t C_X0T  = OFF_C;
constexpr size_t C_KP   = C_X0T + 67108864;
constexpr size_t C_KS   = C_KP + 33554432;
constexpr size_t C_YG   = C_KS;
static_assert(C_KS + 67108864 <= WS_NEED, "map");

struct Params {
  const float* in[28];
  float* out;
  char* ws;
};

typedef __bf16 bf16v2_t __attribute__((ext_vector_type(2)));
typedef float f32v2_t __attribute__((ext_vector_type(2)));
DI unsigned pack2(float a, float b) { f32v2_t v = {a, b}; bf16v2_t r = __builtin_convertvector(v, bf16v2_t); return __builtin_bit_cast(unsigned, r); }
DI u16 f2bf(float x) { return (u16)(pack2(x, 0.f) & 0xffffu); }
DI float bf2f(u16 v) { return __uint_as_float(((unsigned)v) << 16); }
DI float lo_bf(unsigned w) { return __uint_as_float(w << 16); }
DI float hi_bf(unsigned w) { return __uint_as_float(w & 0xffff0000u); }
DI void unpack8(const u32x4& v, float* f) {
  f[0] = lo_bf(v[0]); f[1] = hi_bf(v[0]); f[2] = lo_bf(v[1]); f[3] = hi_bf(v[1]);
  f[4] = lo_bf(v[2]); f[5] = hi_bf(v[2]); f[6] = lo_bf(v[3]); f[7] = hi_bf(v[3]);
}
DI u32x4 pack8(const float* f) {
  u32x4 v; v[0] = pack2(f[0], f[1]); v[1] = pack2(f[2], f[3]); v[2] = pack2(f[4], f[5]); v[3] = pack2(f[6], f[7]); return v;
}
DI float wave_sum(float v) {
  v += __shfl_xor(v, 32); v += __shfl_xor(v, 16); v += __shfl_xor(v, 8);
  v += __shfl_xor(v, 4); v += __shfl_xor(v, 2); v += __shfl_xor(v, 1); return v;
}
DI void seq_of(int t, int& t0, int& L) {
  if (t < 8192) { t0 = 0; L = 8192; } else if (t < 16384) { t0 = 8192; L = 8192; } else { t0 = 16384; L = 16384; }
}

namespace pg8 {
#define PG8_LAS __attribute__((address_space(3)))
typedef unsigned short bf16_t;
typedef short bf16x8 __attribute__((ext_vector_type(8)));
typedef float f32x4 __attribute__((ext_vector_type(4)));
typedef unsigned u32x4 __attribute__((ext_vector_type(4)));
constexpr int BM = 256, BK = 64, HALF = 128, HTB = HALF * BK * 2  , STAGE_BYTES = 8 * HTB, NXCD = 8, WGM = 8;

__host__ __device__ __forceinline__ int lds_byte(int r, int c) { const int st = (r >> 4) * 2 + (c >> 5), rr = r & 15, cc = c & 31, ob = rr * 64 + cc * 2; return st * 1024 + (ob ^ (((ob >> 9) & 1) << 5)); }
__host__ __device__ __forceinline__ void stage_rc(int b, int& R, int& C) { const int st = b / 1024, sb = b % 1024, swz = sb ^ (((sb >> 9) & 1) << 5); R = (st >> 1) * 16 + swz / 64; C = (st & 1) * 32 + (swz % 64) / 2; }
__host__ __device__ __forceinline__ int perm32(int rho) { const int n = rho >> 4, i = rho & 15; return 8 * (i >> 2) + 4 * n + (i & 3); }

struct Unit { int pm, pn; };
struct Gemm { const bf16_t* A; const bf16_t* Bt; int M, N, K; };

struct StaticOrder {
    int nM, nN, nwg, G, c;
    __host__ __device__ __forceinline__ void init(int M, int N, int G_, int c_) { nM = M / BM; nN = N / BM; nwg = nM * nN; G = G_; c = c_; }
    __host__ __device__ __forceinline__ bool next(int i, Unit& u) const {
        const long L = (long)i * G + c; if (L >= nwg) return false;
        int wgid = (int)L; { const int q = nwg / NXCD, r = nwg % NXCD, xcd = wgid % NXCD, off = wgid / NXCD; wgid = (xcd < r ? xcd * (q + 1) : r * (q + 1) + (xcd - r) * q) + off; }
        const int nig = WGM * nN, gid = wgid / nig, fm = gid * WGM, gsz = (nM - fm) < WGM ? (nM - fm) : WGM;
        u.pm = fm + ((wgid % nig) % gsz); u.pn = (wgid % nig) / gsz; return true;
    }
    __device__ __forceinline__ void a_ready(const Unit&) const {}
    __device__ __forceinline__ void done(const Unit&) const {}
    __device__ __forceinline__ const char* a_ptr(const char* base, int pm, size_t tstep) const { return base + (size_t)pm * tstep; }
};
__device__ __forceinline__ unsigned cvt_pk_bf16(float lo, float hi) { unsigned r; asm volatile("v_cvt_pk_bf16_f32 %0, %1, %2" : "=v"(r) : "v"(lo), "v"(hi)); return r; }
template <class Epi, class Sched, bool STAMP = false>
__device__ __forceinline__ void gemm_phase(PG8_LAS unsigned char* lds, const Gemm g, const Sched& S, const Epi& E, unsigned long long* stamps) {
    int tid = threadIdx.x; asm volatile("" : "+v"(tid));
    const int wid = __builtin_amdgcn_readfirstlane(tid >> 6), lane = tid & 63, wr = wid >> 2, wc = wid & 3, fr = lane & 15, fq = lane >> 4;
    const int K = g.K, nt = K / BK;
    int ts_lo = 0, ts_hi = 0, nts = 0; const unsigned long long rt_entry = STAMP ? (unsigned long long)wall_clock64() : 0ull;
#define PG8_STAMP() do { if (STAMP && wid == 0 && nts < 64) { const unsigned long long _c = (unsigned long long)clock64(); \
        ts_lo = (lane == nts) ? (int)(unsigned)_c : ts_lo; ts_hi = (lane == nts) ? (int)(unsigned)(_c >> 32) : ts_hi; ++nts; } } while (0)
    PG8_STAMP();
    unsigned voffA[2], voffB[2];
#pragma unroll
    for (int i = 0; i < 2; ++i) { int R, C; stage_rc(tid * 16 + i * 8192, R, C); const int Rb = Epi::PERM ? ((R & ~31) + perm32(R & 31)) : R;
        voffA[i] = (unsigned)(R * K + C) * 2u; voffB[i] = (unsigned)(Rb * K + C) * 2u; }
    const size_t kstep = (size_t)(BK * 2);
    const size_t hstep = (size_t)HALF * K * 2;
    const size_t tstep = 2 * hstep;
    const unsigned ldsw = (unsigned)wid * 1024u;
    const int aoff = lds_byte(wr * 64 + fr, fq * 8), boff = lds_byte(wc * 32 + fr, fq * 8);
#define PG8_SA(b, h) (((b) * 2 + (h)) * HTB)
#define PG8_SB(b, h) ((4 + (b) * 2 + (h)) * HTB)
#define PG8_STAGE(bufoff, gbase, voff) do { _Pragma("unroll") for (int _i = 0; _i < 2; ++_i) \
        __builtin_amdgcn_global_load_lds((const unsigned*)((const char*)(gbase) + (voff)[_i]), (PG8_LAS unsigned*)(lds + (bufoff) + ldsw + _i * 8192), 16, 0, 0); } while (0)
#define PG8_LDA(dst, b, h) do { _Pragma("unroll") for (int m = 0; m < 4; ++m) _Pragma("unroll") for (int k = 0; k < 2; ++k) dst[m][k] = *(const PG8_LAS bf16x8*)(lds + PG8_SA(b, h) + aoff + m * 2048 + k * 1024); } while (0)
#define PG8_LDB(dst, b, h) do { _Pragma("unroll") for (int n = 0; n < 2; ++n) _Pragma("unroll") for (int k = 0; k < 2; ++k) dst[n][k] = *(const PG8_LAS bf16x8*)(lds + PG8_SB(b, h) + boff + n * 2048 + k * 1024); } while (0)
#define PG8_MMA(ai, bj, At, Bt) do { __builtin_amdgcn_s_setprio(1); _Pragma("unroll") for (int m = 0; m < 4; ++m) _Pragma("unroll") for (int n = 0; n < 2; ++n) _Pragma("unroll") for (int k = 0; k < 2; ++k) \
        acc[ai][bj][m][n] = __builtin_amdgcn_mfma_f32_16x16x32_bf16(Bt[n][k], At[m][k], acc[ai][bj][m][n], 0, 0, 0); __builtin_amdgcn_s_setprio(0); } while (0)
#define PG8_WAIT_V(n) asm volatile("s_waitcnt vmcnt(" #n ")" ::: "memory")
#define PG8_WAIT_L(n) asm volatile("s_waitcnt lgkmcnt(" #n ")" ::: "memory")
#define PG8_BAR __builtin_amdgcn_s_barrier()
#define PG8_SCHED __builtin_amdgcn_sched_barrier(0)
    Unit cur, nxt; int ui = 0;
    if (!S.next(0, cur)) return;
    f32x4 acc[2][2][4][2];
#pragma unroll
    for (int a = 0; a < 2; ++a)
#pragma unroll
        for (int b = 0; b < 2; ++b)
#pragma unroll
            for (int m = 0; m < 4; ++m)
#pragma unroll
                for (int n = 0; n < 2; ++n) acc[a][b][m][n] = (f32x4){0.f, 0.f, 0.f, 0.f};
    bf16x8 At[4][2], B0[2][2], B1[2][2];
    const char* cA = S.a_ptr((const char*)g.A, cur.pm, tstep); const char* cB = (const char*)g.Bt + (size_t)cur.pn * tstep;
    S.a_ready(cur);
    PG8_STAGE(PG8_SB(0, 0), cB, voffB); PG8_STAGE(PG8_SA(0, 0), cA, voffA); PG8_STAGE(PG8_SB(0, 1), cB + hstep, voffB); PG8_STAGE(PG8_SA(0, 1), cA + hstep, voffA);
    if (wr == 1) PG8_BAR;
    PG8_WAIT_V(4); PG8_BAR;
    PG8_STAGE(PG8_SB(1, 0), cB + kstep, voffB); PG8_STAGE(PG8_SA(1, 0), cA + kstep, voffA); PG8_STAGE(PG8_SB(1, 1), cB + hstep + kstep, voffB);
    PG8_WAIT_V(6); PG8_BAR;
    PG8_STAMP();
    for (;;) {
        const bool has_next = S.next(ui + 1, nxt);
        const char* nA = has_next ? S.a_ptr((const char*)g.A, nxt.pm, tstep) : cA; const char* nB = has_next ? (const char*)g.Bt + (size_t)nxt.pn * tstep : cB;
        for (int t = 0; t < nt; t += 2) {
            const bool last = (t == nt - 2);
            const char* a1 = cA + (size_t)(t + 1) * kstep;
            const char* a2 = last ? nA : cA + (size_t)(t + 2) * kstep; const char* b2 = last ? nB : cB + (size_t)(t + 2) * kstep;
            const char* a3 = a2 + kstep; const char* b3 = b2 + kstep;
            if (last && has_next) S.a_ready(nxt);
            PG8_LDB(B0, 0, 0); PG8_SCHED; PG8_LDA(At, 0, 0); PG8_STAGE(PG8_SA(1, 1), a1 + hstep, voffA);
            PG8_WAIT_L(8); PG8_BAR; PG8_WAIT_L(0); PG8_MMA(0, 0, At, B0); PG8_BAR; PG8_SCHED;
            PG8_LDB(B1, 0, 1); PG8_STAGE(PG8_SB(0, 0), b2, voffB);
            PG8_BAR; PG8_WAIT_L(0); PG8_MMA(0, 1, At, B1); PG8_BAR;
            PG8_LDA(At, 0, 1); PG8_STAGE(PG8_SA(0, 0), a2, voffA);
            PG8_BAR; PG8_WAIT_L(0); PG8_MMA(1, 0, At, B0); PG8_BAR; PG8_SCHED;
            PG8_STAGE(PG8_SB(0, 1), b2 + hstep, voffB);
            PG8_WAIT_V(6); PG8_BAR; PG8_MMA(1, 1, At, B1); PG8_BAR;
            PG8_LDB(B0, 1, 0); PG8_SCHED; PG8_LDA(At, 1, 0); PG8_STAGE(PG8_SA(0, 1), a2 + hstep, voffA);
            PG8_WAIT_L(8); PG8_BAR; PG8_WAIT_L(0); PG8_MMA(0, 0, At, B0); PG8_BAR; PG8_SCHED;
            PG8_LDB(B1, 1, 1); PG8_STAGE(PG8_SB(1, 0), b3, voffB);
            PG8_BAR; PG8_WAIT_L(0); PG8_MMA(0, 1, At, B1); PG8_BAR;
            PG8_LDA(At, 1, 1); PG8_STAGE(PG8_SA(1, 0), a3, voffA);
            PG8_BAR; PG8_WAIT_L(0); PG8_MMA(1, 0, At, B0); PG8_BAR; PG8_SCHED;
            PG8_STAGE(PG8_SB(1, 1), b3 + hstep, voffB);
            PG8_WAIT_V(6); PG8_BAR; PG8_MMA(1, 1, At, B1); PG8_BAR;
        }
        PG8_STAMP();
        if constexpr (!Epi::AFTER_DRAIN) { E(acc, cur, wr, wc, fr, fq); S.done(cur); }
        PG8_STAMP();
        if (!has_next) break;
#pragma unroll
        for (int a = 0; a < 2; ++a)
#pragma unroll
            for (int b = 0; b < 2; ++b)
#pragma unroll
                for (int m = 0; m < 4; ++m)
#pragma unroll
                    for (int n = 0; n < 2; ++n) acc[a][b][m][n] = (f32x4){0.f, 0.f, 0.f, 0.f};
        cur = nxt; cA = nA; cB = nB; ++ui;
    }
    PG8_WAIT_V(0);
    if (wr == 0) PG8_BAR;
    PG8_BAR;
    if constexpr (Epi::AFTER_DRAIN) { E.fused(acc, cur, wr, wc, fr, fq, lds, wid, lane); S.done(cur); }
    PG8_STAMP();
    if (STAMP && wid == 0) { stamps[lane] = lane < nts ? (((unsigned long long)(unsigned)ts_hi << 32) | (unsigned)ts_lo) : 0ull;
        if (lane == 62) stamps[62] = rt_entry; if (lane == 63) stamps[63] = (unsigned long long)wall_clock64(); }
#undef PG8_STAMP
#undef PG8_SA
#undef PG8_SB
#undef PG8_STAGE
#undef PG8_LDA
#undef PG8_LDB
#undef PG8_MMA
#undef PG8_WAIT_V
#undef PG8_WAIT_L
#undef PG8_BAR
#undef PG8_SCHED
}
}

struct SplitOrder : pg8::StaticOrder {
  const char* base2; int split;
  DI const char* a_ptr(const char* base, int pm, size_t tstep) const { return pm < split ? base + (size_t)pm * tstep : base2 + (size_t)(pm - split) * tstep; }
};
struct EpiRowScaleBf16 {
  static constexpr bool PERM = true, AFTER_DRAIN = false;
  u16* O; int ldc; const float* ssq;
  DI void operator()(const f32x4 (&acc)[2][2][4][2], const pg8::Unit& u, int wr, int wc, int fr, int fq) const {
    const int row0 = u.pm * 256 + wr * 64 + fr, col0 = u.pn * 256 + wc * 32 + 8 * fq;
#pragma unroll
    for (int ai = 0; ai < 2; ++ai)
#pragma unroll
      for (int m = 0; m < 4; ++m) {
        const int row = row0 + ai * 128 + m * 16;
        const float rs = rsqrtf(ssq[row] * (1.f / 1024.f) + EPSN);
        u16* rp = O + (size_t)row * ldc + col0;
#pragma unroll
        for (int bj = 0; bj < 2; ++bj) {
          const f32x4 v0 = acc[ai][bj][m][0] * rs, v1 = acc[ai][bj][m][1] * rs;
          u32x4 w; w[0] = pack2(v0[0], v0[1]); w[1] = pack2(v0[2], v0[3]); w[2] = pack2(v1[0], v1[1]); w[3] = pack2(v1[2], v1[3]);
          *(u32x4*)(rp + bj * 128) = w;
        }
      }
  }
};
struct EpiResid {
  static constexpr bool PERM = true, AFTER_DRAIN = false;
  u16* X; float* ssq;
  DI void operator()(const f32x4 (&acc)[2][2][4][2], const pg8::Unit& u, int wr, int wc, int fr, int fq) const {
    const int row0 = u.pm * 256 + wr * 64 + fr, col0 = u.pn * 256 + wc * 32 + 8 * fq;
#pragma unroll
    for (int ai = 0; ai < 2; ++ai)
#pragma unroll
      for (int m = 0; m < 4; ++m) {
        const int row = row0 + ai * 128 + m * 16;
        u16* rp = X + (size_t)row * DM + col0;
        float part = 0.f;
#pragma unroll
        for (int bj = 0; bj < 2; ++bj) {
          float f[8]; unpack8(*(const u32x4*)(rp + bj * 128), f);
#pragma unroll
          for (int e = 0; e < 4; ++e) { f[e] += acc[ai][bj][m][0][e]; f[4 + e] += acc[ai][bj][m][1][e]; }
#pragma unroll
          for (int e = 0; e < 8; ++e) part += f[e] * f[e];
          *(u32x4*)(rp + bj * 128) = pack8(f);
        }
        part += __shfl_xor(part, 16); part += __shfl_xor(part, 32);
        if (fq == 0) atomicAdd(ssq + row, part);
      }
  }
};
struct EpiGU {
  static constexpr bool PERM = false, AFTER_DRAIN = false;
  u16* actA; u16* actB; int split_row; const float* ssq; int row_off;
  DI void operator()(const f32x4 (&acc)[2][2][4][2], const pg8::Unit& u, int wr, int wc, int fr, int fq) const {
    const int row0 = row_off + u.pm * 256 + wr * 64 + fr;
#pragma unroll
    for (int ai = 0; ai < 2; ++ai)
#pragma unroll
      for (int m = 0; m < 4; ++m) {
        const int row = row0 + ai * 128 + m * 16;
        const float rs = rsqrtf(ssq[row] * (1.f / 1024.f) + EPSN);
        u16* ap = (row < split_row) ? (actA + (size_t)row * DFF) : (actB + (size_t)(row - split_row) * DFF);
#pragma unroll
        for (int bj = 0; bj < 2; ++bj) {
          const f32x4 gv = acc[ai][bj][m][0] * rs, uv = acc[ai][bj][m][1] * rs;
          float o[4];
#pragma unroll
          for (int e = 0; e < 4; ++e) o[e] = gv[e] * uv[e] * __builtin_amdgcn_rcpf(1.f + __builtin_amdgcn_exp2f(-1.4426950408889634f * gv[e]));
          u32x2 w; w[0] = pack2(o[0], o[1]); w[1] = pack2(o[2], o[3]);
          *(u32x2*)(ap + 16 * (8 * u.pn + 4 * bj + wc) + 4 * fq) = w;
        }
      }
  }
};
struct EpiFinal {
  static constexpr bool PERM = false, AFTER_DRAIN = false;
  const u16* X; float* out; int row_off;
  DI void operator()(const f32x4 (&acc)[2][2][4][2], const pg8::Unit& u, int wr, int wc, int fr, int fq) const {
    const int row0 = row_off + u.pm * 256 + wr * 64 + fr, col0 = u.pn * 256 + wc * 32 + 4 * fq;
#pragma unroll
    for (int ai = 0; ai < 2; ++ai)
#pragma unroll
      for (int m = 0; m < 4; ++m) {
        const size_t rb = (size_t)(row0 + ai * 128 + m * 16) * DM + col0;
#pragma unroll
        for (int bj = 0; bj < 2; ++bj)
#pragma unroll
          for (int n = 0; n < 2; ++n) {
            const u32x2 xv = *(const u32x2*)(X + rb + bj * 128 + n * 16);
            f32x4 o = acc[ai][bj][m][n];
            o[0] += lo_bf(xv[0]); o[1] += hi_bf(xv[0]); o[2] += lo_bf(xv[1]); o[3] += hi_bf(xv[1]);
            *(f32x4*)(out + rb + bj * 128 + n * 16) = o;
          }
      }
  }
};
struct EpiCin {
  static constexpr bool PERM = true, AFTER_DRAIN = false;
  u16* x0t; u16* x1vt; const float* ssq;
  DI void operator()(const f32x4 (&acc)[2][2][4][2], const pg8::Unit& u, int wr, int wc, int fr, int fq) const {
    const int row0 = u.pm * 256 + wr * 64 + fr, col0 = u.pn * 256 + wc * 32 + 8 * fq;
    float rs[2][8];
#pragma unroll
    for (int bj = 0; bj < 2; ++bj)
#pragma unroll
      for (int e = 0; e < 8; ++e) rs[bj][e] = rsqrtf(ssq[col0 + bj * 128 + e] * (1.f / 1024.f) + EPSN);
#pragma unroll
    for (int ai = 0; ai < 2; ++ai)
#pragma unroll
      for (int m = 0; m < 4; ++m) {
        const int ch = row0 + ai * 128 + m * 16;
        u16* rp = ((ch < 1024) ? (x0t + (size_t)ch * T_TOK) : (x1vt + (size_t)(ch - 1024) * T_TOK)) + col0;
#pragma unroll
        for (int bj = 0; bj < 2; ++bj) {
          const f32x4 v0 = acc[ai][bj][m][0], v1 = acc[ai][bj][m][1];
          u32x4 w;
          w[0] = pack2(v0[0] * rs[bj][0], v0[1] * rs[bj][1]); w[1] = pack2(v0[2] * rs[bj][2], v0[3] * rs[bj][3]);
          w[2] = pack2(v1[0] * rs[bj][4], v1[1] * rs[bj][5]); w[3] = pack2(v1[2] * rs[bj][6], v1[3] * rs[bj][7]);
          *(u32x4*)(rp + bj * 128) = w;
        }
      }
  }
};

DI int swz(int row, int chunk) { return row * 128 + ((chunk ^ (row & 7)) << 4); }

template <int NI = 4, class Epi>
DI void gemm_tile(const u16* __restrict__ A, long lda, const u16* __restrict__ B, long ldb, int K, char* smem, Epi&& epi) {
  int tid = threadIdx.x; asm volatile("" : "+v"(tid));
  const int lane = tid & 63, wid = tid >> 6;
  const int wr = wid >> 1, wc = wid & 1;
  const int fr = lane & 15, fq = lane >> 4;
  constexpr int NBL = NI / 2;
  constexpr int BUFB = 32768 + NI * 32 * 128;
  f32x4 acc[4][NI];
#pragma unroll
  for (int i = 0; i < 4; ++i)
#pragma unroll
    for (int j = 0; j < NI; ++j) acc[i][j] = (f32x4){0.f, 0.f, 0.f, 0.f};
  const int lrow = tid >> 3, lch = tid & 7;
  const u16* Ap = A + (long)lrow * lda + lch * 8;
  const u16* Bp = B + (long)lrow * ldb + lch * 8;
  u32x4 ra[4], rb[NBL];
  const int nk = K >> 6;
#pragma unroll
  for (int i = 0; i < 4; ++i) ra[i] = *(const u32x4*)(Ap + (long)(i * 64) * lda);
#pragma unroll
  for (int i = 0; i < NBL; ++i) rb[i] = *(const u32x4*)(Bp + (long)(i * 64) * ldb);
#pragma unroll
  for (int i = 0; i < 4; ++i) *(u32x4*)(smem + swz(lrow + i * 64, lch)) = ra[i];
#pragma unroll
  for (int i = 0; i < NBL; ++i) *(u32x4*)(smem + 32768 + swz(lrow + i * 64, lch)) = rb[i];
  __syncthreads();
  for (int kt = 0; kt < nk; ++kt) {
    if (kt + 1 < nk) {
#pragma unroll
      for (int i = 0; i < 4; ++i) ra[i] = *(const u32x4*)(Ap + (long)(i * 64) * lda + (kt + 1) * 64);
#pragma unroll
      for (int i = 0; i < NBL; ++i) rb[i] = *(const u32x4*)(Bp + (long)(i * 64) * ldb + (kt + 1) * 64);
    }
    const char* sa = smem + (kt & 1) * BUFB;
    const char* sb = sa + 32768;
#pragma unroll
    for (int ks = 0; ks < 2; ++ks) {
      bf16x8 af[4], bfr[NI];
#pragma unroll
      for (int mi = 0; mi < 4; ++mi) af[mi] = *(const bf16x8*)(sa + swz(wr * 64 + mi * 16 + fr, ks * 4 + fq));
#pragma unroll
      for (int ni = 0; ni < NI; ++ni) bfr[ni] = *(const bf16x8*)(sb + swz(wc * (NI * 16) + ni * 16 + fr, ks * 4 + fq));
#pragma unroll
      for (int mi = 0; mi < 4; ++mi)
#pragma unroll
        for (int ni = 0; ni < NI; ++ni)
          acc[mi][ni] = __builtin_amdgcn_mfma_f32_16x16x32_bf16(af[mi], bfr[ni], acc[mi][ni], 0, 0, 0);
    }
    if (kt + 1 < nk) {
      char* da = smem + ((kt + 1) & 1) * BUFB;
#pragma unroll
      for (int i = 0; i < 4; ++i) *(u32x4*)(da + swz(lrow + i * 64, lch)) = ra[i];
#pragma unroll
      for (int i = 0; i < NBL; ++i) *(u32x4*)(da + 32768 + swz(lrow + i * 64, lch)) = rb[i];
    }
    __syncthreads();
  }
  epi(acc, wr * 64 + fq * 4, wc * (NI * 16) + fr);
}

template <int KIND>
DI void convert_w(const float* __restrict__ src, const float* __restrict__ src2, int Nsrc, int K, int Np,
                  u16* __restrict__ dst, const float* __restrict__ gain, long gtid, long GT) {
  const int items = Np * (K >> 3);
#pragma unroll 4
  for (int it = (int)gtid; it < items; it += (int)GT) {
    const int np = it % Np, kc = it / Np;
    const float* sp = src; int n = np; bool valid = true;
    if (KIND == 0) { valid = np < Nsrc; }
    else if (KIND == 1) { n = (np >> 6) * 128 + (np & 63); }
    else if (KIND == 2) { n = (np >> 6) * 128 + 64 + (np & 63); }
    else { const int g = np >> 5, w = np & 31; sp = (w < 16) ? src : src2; n = g * 16 + (w & 15); }
    float f[8];
#pragma unroll
    for (int j = 0; j < 8; ++j) {
      const int k = kc * 8 + j;
      float v = valid ? sp[(long)k * Nsrc + n] : 0.f;
      if (gain) v *= gain[k];
      f[j] = v;
    }
    *(u32x4*)(dst + (long)np * K + kc * 8) = pack8(f);
  }
}

DI float2 cadd(float2 a, float2 b) { return make_float2(a.x + b.x, a.y + b.y); }
DI float2 csub(float2 a, float2 b) { return make_float2(a.x - b.x, a.y - b.y); }
DI float2 cmul(float2 a, float2 b) { return make_float2(a.x * b.x - a.y * b.y, a.x * b.y + a.y * b.x); }
DI float2 cmulc(float2 a, float2 b) { return make_float2(a.x * b.x + a.y * b.y, a.y * b.x - a.x * b.y); }
DI float2 cconj(float2 a) { return make_float2(a.x, -a.y); }
DI float2 twid(float rev) {
  return make_float2(__builtin_amdgcn_cosf(rev), -__builtin_amdgcn_sinf(rev));
}
DI void r4f(float2& a0, float2& a1, float2& a2, float2& a3) {
  const float2 s02 = cadd(a0, a2), d02 = csub(a0, a2), s13 = cadd(a1, a3), d13 = csub(a1, a3);
  a0 = cadd(s02, s13); a2 = csub(s02, s13);
  a1 = make_float2(d02.x + d13.y, d02.y - d13.x);
  a3 = make_float2(d02.x - d13.y, d02.y + d13.x);
}
DI void r4i(float2& a0, float2& a1, float2& a2, float2& a3) {
  const float2 s02 = cadd(a0, a2), d02 = csub(a0, a2), s13 = cadd(a1, a3), d13 = csub(a1, a3);
  a0 = cadd(s02, s13); a2 = csub(s02, s13);
  a1 = make_float2(d02.x - d13.y, d02.y + d13.x);
  a3 = make_float2(d02.x + d13.y, d02.y - d13.x);
}
#define C8 0.9238795325112867f
#define S8 0.3826834323650898f
#define R2 0.7071067811865476f
DI void fft16_fwd(float2 (&v)[16]) {
#pragma unroll
  for (int r0 = 0; r0 < 4; ++r0) r4f(v[r0], v[r0 + 4], v[r0 + 8], v[r0 + 12]);
  v[5]  = cmul(v[5],  make_float2(C8, -S8));
  v[9]  = cmul(v[9],  make_float2(R2, -R2));
  v[13] = cmul(v[13], make_float2(S8, -C8));
  v[6]  = cmul(v[6],  make_float2(R2, -R2));
  v[10] = make_float2(v[10].y, -v[10].x);
  v[14] = cmul(v[14], make_float2(-R2, -R2));
  v[7]  = cmul(v[7],  make_float2(S8, -C8));
  v[11] = cmul(v[11], make_float2(-R2, -R2));
  v[15] = cmul(v[15], make_float2(-C8, S8));
#pragma unroll
  for (int q1 = 0; q1 < 4; ++q1) r4f(v[4 * q1], v[4 * q1 + 1], v[4 * q1 + 2], v[4 * q1 + 3]);
}
DI void fft16_inv(float2 (&v)[16]) {
#pragma unroll
  for (int q1 = 0; q1 < 4; ++q1) r4i(v[4 * q1], v[4 * q1 + 1], v[4 * q1 + 2], v[4 * q1 + 3]);
  v[5]  = cmulc(v[5],  make_float2(C8, -S8));
  v[9]  = cmulc(v[9],  make_float2(R2, -R2));
  v[13] = cmulc(v[13], make_float2(S8, -C8));
  v[6]  = cmulc(v[6],  make_float2(R2, -R2));
  v[10] = make_float2(-v[10].y, v[10].x);
  v[14] = cmulc(v[14], make_float2(-R2, -R2));
  v[7]  = cmulc(v[7],  make_float2(S8, -C8));
  v[11] = cmulc(v[11], make_float2(-R2, -R2));
  v[15] = cmulc(v[15], make_float2(-C8, S8));
#pragma unroll
  for (int r0 = 0; r0 < 4; ++r0) r4i(v[r0], v[r0 + 4], v[r0 + 8], v[r0 + 12]);
}
template <int M, bool INV, bool HALF = false>
DI void fft_pass16(float2* X) {
  constexpr int S = M / 16;
  static_assert(S == 1024 || S == 64, "addressing below assumes these two sizes");
  const int tid = threadIdx.x;
#pragma unroll 1
  for (int u = 0; u < 2; ++u) {
    const int bf = tid + 512 * u;
    int j = bf % S; const int b = (bf / S) * M;
    asm volatile("" : "+v"(j));
    int pa4[4];
    if (S >= 256) { pa4[0] = b + (j ^ ((j >> 4) & 15)); pa4[1] = pa4[0]; pa4[2] = pa4[0]; pa4[3] = pa4[0]; }
    else {
      const int low = (j & 15) ^ ((j >> 4) & 3);
#pragma unroll
      for (int q = 0; q < 4; ++q) pa4[q] = b + (j & 48) + (low ^ (q << 2));
    }
    float2 v[16];
#pragma unroll
    for (int r = 0; r < 16; ++r) v[r] = (HALF && !INV && r >= 8) ? make_float2(0.f, 0.f) : X[pa4[r & 3] + r * S];
    const float2 w1 = twid((float)j * (1.0f / (float)M));
    if (!INV) {
      fft16_fwd(v);
      float2 cur = w1;
#pragma unroll
      for (int f = 1; f < 16; ++f) {
        const int slot = ((f & 3) << 2) | (f >> 2);
        v[slot] = cmul(v[slot], cur);
        cur = cmul(cur, w1);
      }
    } else {
      float2 cur = w1;
#pragma unroll
      for (int f = 1; f < 16; ++f) {
        const int slot = ((f & 3) << 2) | (f >> 2);
        v[slot] = cmulc(v[slot], cur);
        cur = cmul(cur, w1);
      }
      fft16_inv(v);
    }
#pragma unroll
    for (int r = 0; r < 16; ++r) if (!(HALF && INV && r >= 8)) X[pa4[r & 3] + r * S] = v[r];
  }
}
template <bool INV>
DI void fft_pass4_64(float2* X) {
  const int tid = threadIdx.x;
#pragma unroll 1
  for (int u = 0; u < 8; ++u) {
    const int bf = tid + 512 * u;
    int j = bf & 15; const int b = (bf >> 4) * 64;
    asm volatile("" : "+v"(j));
    const int xb = ((bf >> 4) & 3) << 2;
    float2* p0 = X + b + (j ^ xb); float2* p1 = X + b + 16 + (j ^ (xb | 1)); float2* p2 = X + b + 32 + (j ^ (xb | 2)); float2* p3 = X + b + 48 + (j ^ (xb | 3));
    float2 a0 = *p0, a1 = *p1, a2 = *p2, a3 = *p3;
    const float2 w1 = twid((float)j * (1.0f / 64.f));
    const float2 w2 = cmul(w1, w1), w3 = cmul(w2, w1);
    if (!INV) {
      r4f(a0, a1, a2, a3);
      a1 = cmul(a1, w1); a2 = cmul(a2, w2); a3 = cmul(a3, w3);
    } else {
      a1 = cmulc(a1, w1); a2 = cmulc(a2, w2); a3 = cmulc(a3, w3);
      r4i(a0, a1, a2, a3);
    }
    *p0 = a0; *p1 = a1; *p2 = a2; *p3 = a3;
  }
}
template <bool HALF = false>
DI void fft_fwd_head(float2* X) {
  __syncthreads();
  fft_pass16<16384, false, HALF>(X); __syncthreads();
  fft_pass16<1024, false>(X);  __syncthreads();
  fft_pass4_64<false>(X);      __syncthreads();
}
DI void fft_inv_tail(float2* X) {
  __syncthreads();
  fft_pass4_64<true>(X);       __syncthreads();
  fft_pass16<1024, true>(X);   __syncthreads();
  fft_pass16<16384, true, true>(X);  __syncthreads();
}
DI int PX(int idx) { return idx ^ ((idx >> 4) & 15); }
DI int pos14(int k) {
  unsigned r = __brev((unsigned)k) >> 18;
  return (int)(((r & 0x1555u) << 1) | ((r >> 1) & 0x1555u));
}
DI void conv3_8(const u16* row, int tl, int L, float w0, float w1, float w2, float* out) {
  const u32x4 c = *(const u32x4*)(row + tl);
  float f[10];
  unpack8(c, f + 1);
  f[0] = (tl > 0) ? bf2f(row[tl - 1]) : 0.f;
  f[9] = (tl + 8 < L) ? bf2f(row[tl + 8]) : 0.f;
#pragma unroll
  for (int i = 0; i < 8; ++i) out[i] = w0 * f[i] + w1 * f[i + 1] + w2 * f[i + 2];
}


template <int I> struct IC { static constexpr int v = I; };
template <bool FIXED>
DI void attn_item(const u16* __restrict__ Q, const u16* __restrict__ Kb, const u16* __restrict__ Vt, u16* __restrict__ mix,
                  int t0, int L, int h, int qb, float M0, char* smem, int tid) {
  const int lane = tid & 63, wid = tid >> 6, l31 = lane & 31, hh = lane >> 5;
  const int tq = t0 + qb * 256 + wid * 32 + l31;
  bf16x8 qf[6];
#pragma unroll
  for (int ks = 0; ks < 6; ++ks) qf[ks] = *(const bf16x8*)(Q + (long)tq * 768 + h * 96 + ks * 16 + hh * 8);
  f32x16 o[2];
#pragma unroll
  for (int i = 0; i < 16; ++i) { o[0][i] = 0.f; o[1][i] = 0.f; }
  float m_run = FIXED ? M0 : -1e30f, l_run = 0.f;
  u32x4 rk[3], rv[2];
  const u16* gK[3]; int sK[3];
#pragma unroll
  for (int i = 0; i < 3; ++i) {
    const int id = tid + 512 * i, row = id / 12, c = id % 12;
    gK[i] = Kb + ((long)h * T_TOK + t0 + row) * 96 + c * 8;
    sK[i] = row * 208 + c * 16;
  }
  const u16* gV[2]; int sV[2];
#pragma unroll
  for (int i = 0; i < 2; ++i) {
    const int id = tid + 512 * i, dv = id >> 4, c = id & 15;
    gV[i] = Vt + (long)(h * 64 + dv) * T_TOK + t0 + c * 8;
    sV[i] = 26624 + dv * 264 + c * 16;
  }
  const int ntile = L >> 7;
#pragma unroll
  for (int i = 0; i < 3; ++i) rk[i] = *(const u32x4*)(gK[i]);
#pragma unroll
  for (int i = 0; i < 2; ++i) rv[i] = *(const u32x4*)(gV[i]);
#pragma unroll
  for (int i = 0; i < 3; ++i) *(u32x4*)(smem + sK[i]) = rk[i];
#pragma unroll
  for (int i = 0; i < 2; ++i) { u32x2 a, b; a[0] = rv[i][0]; a[1] = rv[i][1]; b[0] = rv[i][2]; b[1] = rv[i][3];
    *(u32x2*)(smem + sV[i]) = a; *(u32x2*)(smem + sV[i] + 8) = b; }
  __syncthreads();
#define AT_QK(S, half, k2, ks) S[k2] = __builtin_amdgcn_mfma_f32_32x32x16_bf16( \
    *(const bf16x8*)(Ks + ((half) * 64 + (k2) * 32 + l31) * 208 + ((ks) * 2 + hh) * 16), qf[ks], S[k2], 0, 0, 0)
#define AT_PV(half, k2, st, dvt, PB) do { const char* ad_ = Vs + ((dvt) * 32 + l31) * 264 + ((half) * 64 + (k2) * 32 + (st) * 16 + hh * 4) * 2; \
    const s16x4 lo_ = *(const s16x4*)(ad_); const s16x4 hi_ = *(const s16x4*)(ad_ + 16); \
    o[dvt] = __builtin_amdgcn_mfma_f32_32x32x16_bf16(__builtin_shufflevector(lo_, hi_, 0, 1, 2, 3, 4, 5, 6, 7), PB, o[dvt], 0, 0, 0); } while (0)
#define AT_PACK(S, k2, st) __builtin_bit_cast(bf16x8, (u32x4){pack2(S[k2][8 * (st) + 0], S[k2][8 * (st) + 1]), pack2(S[k2][8 * (st) + 2], S[k2][8 * (st) + 3]), \
    pack2(S[k2][8 * (st) + 4], S[k2][8 * (st) + 5]), pack2(S[k2][8 * (st) + 6], S[k2][8 * (st) + 7])})
  for (int kt = 0; kt < ntile; ++kt) {
    if (kt + 1 < ntile) {
#pragma unroll
      for (int i = 0; i < 3; ++i) rk[i] = *(const u32x4*)(gK[i] + (long)(kt + 1) * 128 * 96);
#pragma unroll
      for (int i = 0; i < 2; ++i) rv[i] = *(const u32x4*)(gV[i] + (kt + 1) * 128);
    }
    const char* Ks = smem + (kt & 1) * 43520;
    const char* Vs = Ks + 26624;
    if (FIXED) {
#define AT_D 3
#define AT_KF(half, k2, ks) (*(const bf16x8*)(Ks + ((half) * 64 + (k2) * 32 + l31) * 208 + ((ks) * 2 + hh) * 16))
#define AT_VADDR(half, step) (Vs + (((step) & 1) * 32 + l31) * 264 + ((half) * 64 + ((step) >> 2) * 32 + (((step) >> 1) & 1) * 16 + hh * 4) * 2)
#define AT_VF(half, step) __builtin_shufflevector(*(const s16x4*)(AT_VADDR(half, step)), *(const s16x4*)(AT_VADDR(half, step) + 16), 0, 1, 2, 3, 4, 5, 6, 7)
#define AT_RD(i) (((i) < 12) ? AT_KF(0, (i) & 1, (i) >> 1) : ((i) < 24) ? AT_KF(1, ((i) - 12) & 1, ((i) - 12) >> 1) : ((i) < 32) ? AT_VF(0, (i) - 24) : AT_VF(1, (i) - 32))
      f32x16 sa[2], sb[2];
      const float ninit = -M0;
#pragma unroll
      for (int i = 0; i < 16; ++i) { sa[0][i] = ninit; sa[1][i] = ninit; sb[0][i] = ninit; sb[1][i] = ninit; }
      bf16x8 fr[40];
      bf16x8 pa[2][2];
      float rs4[4] = {0.f, 0.f, 0.f, 0.f};
#pragma unroll
      for (int i = 0; i < AT_D; ++i) fr[i] = AT_RD(i);
      auto at_step = [&](auto ic) {
        constexpr int i = decltype(ic)::v;
        if (i + AT_D < 40) fr[(i + AT_D) % 40] = AT_RD(i + AT_D);
        if (i < 12) {
          sa[i & 1] = __builtin_amdgcn_mfma_f32_32x32x16_bf16(fr[i], qf[i >> 1], sa[i & 1], 0, 0, 0);
        } else if (i < 24) {
          const int j = i - 12;
          sb[j & 1] = __builtin_amdgcn_mfma_f32_32x32x16_bf16(fr[i], qf[j >> 1], sb[j & 1], 0, 0, 0);
#pragma unroll
          for (int e = j * 3; e < j * 3 + 3; ++e) if (e < 32) { const float pv = __builtin_amdgcn_exp2f(sa[e >> 4][e & 15]); sa[e >> 4][e & 15] = pv; rs4[e & 3] += pv; }
          if (j == 11) {
#pragma unroll
            for (int k2 = 0; k2 < 2; ++k2)
#pragma unroll
              for (int st = 0; st < 2; ++st) pa[k2][st] = AT_PACK(sa, k2, st);
          }
        } else if (i < 32) {
          const int j = i - 24;
          o[j & 1] = __builtin_amdgcn_mfma_f32_32x32x16_bf16(fr[i], pa[j >> 2][(j >> 1) & 1], o[j & 1], 0, 0, 0);
#pragma unroll
          for (int e = j * 4; e < j * 4 + 4; ++e) { const float pv = __builtin_amdgcn_exp2f(sb[e >> 4][e & 15]); sb[e >> 4][e & 15] = pv; rs4[e & 3] += pv; }
        } else {
          const int j = i - 32;
          if (j == 0) {
#pragma unroll
            for (int k2 = 0; k2 < 2; ++k2)
#pragma unroll
              for (int st = 0; st < 2; ++st) pa[k2][st] = AT_PACK(sb, k2, st);
          }
          o[j & 1] = __builtin_amdgcn_mfma_f32_32x32x16_bf16(fr[i], pa[j >> 2][(j >> 1) & 1], o[j & 1], 0, 0, 0);
        }
#ifdef AT_PIN
        __builtin_amdgcn_sched_barrier(0);
#endif
      };
#define AT_S4(b) at_step(IC<(b)>{}); at_step(IC<(b) + 1>{}); at_step(IC<(b) + 2>{}); at_step(IC<(b) + 3>{});
      AT_S4(0) AT_S4(4) AT_S4(8) AT_S4(12) AT_S4(16) AT_S4(20) AT_S4(24) AT_S4(28) AT_S4(32) AT_S4(36)
#undef AT_S4
      const float rsum = (rs4[0] + rs4[1]) + (rs4[2] + rs4[3]);
      l_run += rsum;
#undef AT_D
#undef AT_KF
#undef AT_VADDR
#undef AT_VF
#undef AT_RD
    } else {
#pragma unroll
      for (int half = 0; half < 2; ++half) {
        f32x16 s[2];
#pragma unroll
        for (int i = 0; i < 16; ++i) { s[0][i] = 0.f; s[1][i] = 0.f; }
#pragma unroll
        for (int ks = 0; ks < 6; ++ks) { AT_QK(s, half, 0, ks); AT_QK(s, half, 1, ks); }
        float mloc = s[0][0];
#pragma unroll
        for (int i = 1; i < 16; ++i) mloc = fmaxf(mloc, s[0][i]);
#pragma unroll
        for (int i = 0; i < 16; ++i) mloc = fmaxf(mloc, s[1][i]);
        mloc = fmaxf(mloc, __shfl_xor(mloc, 32));
        const bool need = mloc > m_run + 8.f;
        if (__builtin_amdgcn_ballot_w64(need) != 0ull) {
          const float mnew = need ? mloc : m_run;
          const float alpha = __builtin_amdgcn_exp2f(m_run - mnew);
          m_run = mnew;
          l_run *= alpha;
#pragma unroll
          for (int i = 0; i < 16; ++i) { o[0][i] *= alpha; o[1][i] *= alpha; }
        }
        float rsum = 0.f;
#pragma unroll
        for (int k2 = 0; k2 < 2; ++k2)
#pragma unroll
          for (int i = 0; i < 16; ++i) { const float pv = __builtin_amdgcn_exp2f(s[k2][i] - m_run); s[k2][i] = pv; rsum += pv; }
        l_run += rsum;
#pragma unroll
        for (int k2 = 0; k2 < 2; ++k2)
#pragma unroll
          for (int st = 0; st < 2; ++st) {
            const bf16x8 pb = AT_PACK(s, k2, st);
            AT_PV(half, k2, st, 0, pb);
            AT_PV(half, k2, st, 1, pb);
          }
      }
    }
    if (kt + 1 < ntile) {
      char* d = smem + ((kt + 1) & 1) * 43520;
#pragma unroll
      for (int i = 0; i < 3; ++i) *(u32x4*)(d + sK[i]) = rk[i];
#pragma unroll
      for (int i = 0; i < 2; ++i) { u32x2 a, b; a[0] = rv[i][0]; a[1] = rv[i][1]; b[0] = rv[i][2]; b[1] = rv[i][3];
        *(u32x2*)(d + sV[i]) = a; *(u32x2*)(d + sV[i] + 8) = b; }
    }
    __syncthreads();
  }
#undef AT_QK
#undef AT_PV
#undef AT_PACK
  const float ltot = l_run + __shfl_xor(l_run, 32);
  const float inv = 1.f / ltot;
#pragma unroll
  for (int dvt = 0; dvt < 2; ++dvt)
#pragma unroll
    for (int g = 0; g < 4; ++g) {
      u32x2 w;
      w[0] = pack2(o[dvt][4 * g] * inv, o[dvt][4 * g + 1] * inv);
      w[1] = pack2(o[dvt][4 * g + 2] * inv, o[dvt][4 * g + 3] * inv);
      *(u32x2*)(mix + (long)tq * 1024 + 512 + h * 64 + dvt * 32 + 8 * g + 4 * hh) = w;
    }
}

DI void grid_bar(unsigned* bw, unsigned& epoch, unsigned G) {
  asm volatile("s_waitcnt vmcnt(0)" ::: "memory");
  __syncthreads();
  if (threadIdx.x == 0) {
    __builtin_amdgcn_fence(__ATOMIC_RELEASE, "agent");
    asm volatile("s_waitcnt vmcnt(0)" ::: "memory");
    epoch += 1u;
    const unsigned g = blockIdx.x & 7u, ng = (G + 7u - g) >> 3;
    const unsigned old = __hip_atomic_fetch_add(bw + 64 * g, 1u, __ATOMIC_RELAXED, __HIP_MEMORY_SCOPE_AGENT);
    if (old + 1u == ng * epoch) {
      const unsigned ngrp = G < 8u ? G : 8u;
      const unsigned t = __hip_atomic_fetch_add(bw + 64 * 8, 1u, __ATOMIC_RELAXED, __HIP_MEMORY_SCOPE_AGENT);
      if (t + 1u == ngrp * epoch) __hip_atomic_store(bw + 64 * 9, epoch, __ATOMIC_RELAXED, __HIP_MEMORY_SCOPE_AGENT);
    }
    unsigned spins = 0;
    while (__hip_atomic_load(bw + 64 * 9, __ATOMIC_RELAXED, __HIP_MEMORY_SCOPE_AGENT) < epoch) {
      __builtin_amdgcn_s_sleep(1);
      if (++spins > (1u << 24)) break;
    }
    __builtin_amdgcn_fence(__ATOMIC_ACQUIRE, "agent");
    asm volatile("s_waitcnt vmcnt(0)" ::: "memory");
  }
  __syncthreads();
}


__global__ void __launch_bounds__(NTHR) __attribute__((target("no-packed-fp32-ops"))) fwd_kernel(Params p) {
  __shared__ __attribute__((aligned(16))) char smem[163840];
  cg::grid_group grid = cg::this_grid();
  const int G = gridDim.x, bid = blockIdx.x;
  const int vb = (bid & 7) * (G >> 3) + (bid >> 3);
  const int NW = G * 8;
  const long GT = (long)G * NTHR;
#define PHASE_IDS int tid = threadIdx.x; asm volatile("" : "+v"(tid)); const int lane = tid & 63, wid = tid >> 6; \
  const int gw = bid * 8 + wid; const long gtid = (long)bid * NTHR + tid; (void)lane; (void)gw; (void)gtid;
  char* ws = p.ws;
  char* dsc = (char*)p.out;
  float* rowss = (float*)(ws + SM_ROWSS);
  u16* XB = (u16*)(ws + OFF_XB);
  unsigned* barcnt = (unsigned*)ws;
  unsigned bar_target = 0;
  if (p.ws == nullptr) grid.sync();
  PG8_LAS unsigned char* lds = (PG8_LAS unsigned char*)smem;

  if (PHM & (1 << 0)) {
    PHASE_IDS
    {
#define CW_LIST(X) \
      X(0, p.in[7], p.in[7], 1952, 1024, 2048, W0_IN, p.in[2], 0) \
      X(1, p.in[11], p.in[11], 768, 256, 768, W0_Q, p.in[2], 4) \
      X(2, p.in[12], p.in[12], 1024, 128, 512, W0_K, p.in[2], 5) \
      X(3, p.in[12], p.in[12], 1024, 128, 512, W0_V, p.in[2], 6) \
      X(4, p.in[15], p.in[15], 1024, 1024, 1024, W0_OUT, p.in[2], 4) \
      X(5, p.in[4], p.in[5], 2816, 1024, 5632, W0_GU, p.in[3], 3) \
      X(6, p.in[6], p.in[6], 1024, 2816, 1024, W0_D, p.in[2], 4) \
      X(7, p.in[16], p.in[16], 3072, 1024, 3072, W1_CIN, (p.in[2] + 1024), 0) \
      X(8, p.in[27], p.in[27], 1024, 1024, 1024, W1_COUT, p.in[2], 4) \
      X(9, p.in[25], p.in[25], 2048, 64, 2048, W1_W4, p.in[2], 4) \
      X(10, (p.in[4] + 1024 * 2816), (p.in[5] + 1024 * 2816), 2816, 1024, 5632, W1_GU, (p.in[3] + 1024), 3) \
      X(11, (p.in[6] + 2816 * 1024), (p.in[6] + 2816 * 1024), 1024, 2816, 1024, W1_D, p.in[2], 4)
      int total = 0;
#define CW_CNT(i, s1, s2, ns, k, np, off, g, kind) const int cw_start##i = total; total += (np) * ((k) >> 3);
      CW_LIST(CW_CNT)
#undef CW_CNT
#pragma unroll 4
      for (int it = (int)gtid; it < total; it += (int)GT) {
        const float* s1 = nullptr; const float* s2 = nullptr; const float* gp = nullptr; u16* dst = nullptr;
        int Nsrc = 0, K = 0, Np = 1, kind = 0, st = 0;
#define CW_SEL(i, a1, a2, ns, k, np, off, g, kd) if (it >= cw_start##i) { s1 = a1; s2 = a2; gp = g; dst = (u16*)(ws + off); Nsrc = ns; K = k; Np = np; kind = kd; st = cw_start##i; }
        CW_LIST(CW_SEL)
#undef CW_SEL
        const int li = it - st;
        const int np = li % Np, kc = li / Np;
        const float* sp = s1; int n = np; bool valid = true;
        if (kind == 0) valid = np < Nsrc;
        else if (kind == 5) n = (np >> 6) * 128 + (np & 63);
        else if (kind == 6) n = (np >> 6) * 128 + 64 + (np & 63);
        else if (kind == 3) { const int g = np >> 5, w = np & 31; sp = (w < 16) ? s1 : s2; n = g * 16 + (w & 15); }
        const bool hasg = (kind == 0) || (kind == 3);
        float f[8];
#pragma unroll
        for (int j = 0; j < 8; ++j) {
          const int k = kc * 8 + j;
          float v = valid ? sp[(long)k * Nsrc + n] : 0.f;
          const float gv = hasg ? gp[k] : 1.f;
          f[j] = v * gv;
        }
        *(u32x4*)(dst + (long)np * K + kc * 8) = pack8(f);
      }
#undef CW_LIST
    }
    for (int row0 = gw * 4; row0 < T_TOK; row0 += NW * 4) {
      float4 va[4][4];
#pragma unroll
      for (int r = 0; r < 4; ++r) {
        const int row = row0 + r;
        const float* xr = (row < 16384) ? (p.in[0] + (long)row * DM) : (p.in[1] + (long)(row - 16384) * DM);
#pragma unroll
        for (int hb = 0; hb < 2; ++hb) { va[r][2 * hb] = *(const float4*)(xr + hb * 512 + lane * 8); va[r][2 * hb + 1] = *(const float4*)(xr + hb * 512 + lane * 8 + 4); }
      }
#pragma unroll
      for (int r = 0; r < 4; ++r) {
        const int row = row0 + r;
        float ss = 0.f;
#pragma unroll
        for (int hb = 0; hb < 2; ++hb) {
          const float4 a = va[r][2 * hb], b = va[r][2 * hb + 1];
          ss += a.x * a.x + a.y * a.y + a.z * a.z + a.w * a.w + b.x * b.x + b.y * b.y + b.z * b.z + b.w * b.w;
          u32x4 o; o[0] = pack2(a.x, a.y); o[1] = pack2(a.z, a.w); o[2] = pack2(b.x, b.y); o[3] = pack2(b.z, b.w);
          *(u32x4*)(XB + (long)row * DM + hb * 512 + lane * 8) = o;
        }
        ss = wave_sum(ss);
        if (lane == 0) rowss[row] = ss;
      }
    }
    for (long i = gtid; i < 3 * T_TOK; i += GT) rowss[T_TOK + i] = 0.f;
    float2* rope = (float2*)(ws + R_ROPE);
    for (long e = gtid; e < 16384 * 16; e += GT) {
      const int pos = (int)(e >> 4), i = (int)(e & 15);
      const int lo = i & 3, hi = i >> 2;
      const double base = (lo == 0) ? 1.0 : (lo == 1) ? 0.5623413251903491 : (lo == 2) ? 0.31622776601683794 : 0.1778279410038923;
      const double sc = (hi == 0) ? 1.0 : (hi == 1) ? 0.1 : (hi == 2) ? 0.01 : 0.001;
      double rev = (double)pos * (base * sc) * 0.15915494309189535;
      rev -= floor(rev);
      const float rf = (float)rev;
      rope[e] = make_float2(__builtin_amdgcn_cosf(rf), __builtin_amdgcn_sinf(rf));
    }

    {
      const float* w1 = p.in[18]; const float* b1 = p.in[19];
      const float* w2 = p.in[20]; const float* b2 = p.in[21];
      const float* w3 = p.in[22]; const float* b3 = p.in[23];
      const float* fq = p.in[24];
      const float INV2PI = 0.15915494309189535f;
      float w1c[33], w2c[64], w3c[64];
#pragma unroll
      for (int k = 0; k < 33; ++k) w1c[k] = w1[k * 64 + lane];
#pragma unroll
      for (int k = 0; k < 64; ++k) { w2c[k] = w2[k * 64 + lane]; w3c[k] = w3[k * 64 + lane]; }
      const float bb1 = b1[lane], bb2 = b2[lane], bb3 = b3[lane];
      const float f1 = fq[lane] * INV2PI, f2 = fq[64 + lane] * INV2PI, f3 = fq[128 + lane] * INV2PI;
#pragma unroll 1
      for (int rg = 0; rg < 3; ++rg) {
        const int rbase = gw * 12 + rg * 4;
        if (rbase < 24576) {
          float zr[4], acc[4];
#pragma unroll
          for (int r = 0; r < 4; ++r) {
            const int rr = rbase + r;
            const int Lf = (rr < 8192) ? 8192 : 16384;
            const int l = (rr < 8192) ? rr : (rr - 8192);
            const float tpos = (float)l / (float)(Lf - 1);
            const float frac = (float)l / (float)Lf;
            const int bi = (lane >= 17) ? (lane - 17) : (lane - 1);
            const float band = 1e-4f + (float)bi * ((15.f - 1e-4f) / 15.f);
            const float rev = frac * band;
            zr[r] = (lane == 0) ? tpos : ((lane <= 16) ? __builtin_amdgcn_cosf(rev) : -__builtin_amdgcn_sinf(rev));
            acc[r] = bb1;
          }
#pragma unroll
          for (int k = 0; k < 33; ++k)
#pragma unroll
            for (int r = 0; r < 4; ++r) acc[r] += __int_as_float(__builtin_amdgcn_readlane(__float_as_int(zr[r]), k)) * w1c[k];
#pragma unroll
          for (int r = 0; r < 4; ++r) { zr[r] = __builtin_amdgcn_sinf(f1 * acc[r]); acc[r] = bb2; }
#pragma unroll
          for (int k = 0; k < 64; ++k)
#pragma unroll
            for (int r = 0; r < 4; ++r) acc[r] += __int_as_float(__builtin_amdgcn_readlane(__float_as_int(zr[r]), k)) * w2c[k];
#pragma unroll
          for (int r = 0; r < 4; ++r) { zr[r] = __builtin_amdgcn_sinf(f2 * acc[r]); acc[r] = bb3; }
#pragma unroll
          for (int k = 0; k < 64; ++k)
#pragma unroll
            for (int r = 0; r < 4; ++r) acc[r] += __int_as_float(__builtin_amdgcn_readlane(__float_as_int(zr[r]), k)) * w3c[k];
          u16* z3 = (u16*)(ws + SM_Z3);
#pragma unroll
          for (int r = 0; r < 4; ++r) z3[(long)(rbase + r) * 64 + lane] = f2bf(__builtin_amdgcn_sinf(f3 * acc[r]));
        }
      }
    }
  }
  grid_bar(barcnt, bar_target, (unsigned)G);

  for (int rep = 0; rep < REP1; ++rep) if (PHM & (1 << 1)) {
    pg8::Gemm g{XB, (const u16*)(ws + W0_IN), T_TOK, 2048, DM};
    pg8::StaticOrder S; S.init(T_TOK, 2048, G, bid);
    EpiRowScaleBf16 E{(u16*)dsc, 2048, rowss};
    pg8::gemm_phase<EpiRowScaleBf16, pg8::StaticOrder>(lds, g, S, E, nullptr);
  }
  grid_bar(barcnt, bar_target, (unsigned)G);

  if (PHM & (1 << 2)) {
    PHASE_IDS
    const u16* proj = (const u16*)dsc;
    u16* mix = (u16*)(ws + R_MIX);
    u16* cqn = (u16*)(ws + R_CQN);
    u16* ckvn = (u16*)(ws + R_CKVN);
    u16* kpe = (u16*)(ws + R_KPE);
    float* sskpe = (float*)(ws + SM_SSKPE);
    const float* cw = p.in[8];
    float w0[8], w1[8], w2[8];
#pragma unroll
    for (int i = 0; i < 8; ++i) { w0[i] = cw[(lane * 8 + i) * 3]; w1[i] = cw[(lane * 8 + i) * 3 + 1]; w2[i] = cw[(lane * 8 + i) * 3 + 2]; }
    float gq[4], gk[2];
#pragma unroll
    for (int i = 0; i < 4; ++i) gq[i] = p.in[9][lane * 4 + i];
    gk[0] = p.in[10][lane * 2]; gk[1] = p.in[10][lane * 2 + 1];
    for (int t = gw; t < T_TOK; t += NW) {
      int t0, L; seq_of(t, t0, L);
      const u16* pr = proj + (long)t * 2048;
      const int c = lane * 8;
      float gb[8], mc[8], mp[8], mn[8], a[8], b[8];
      unpack8(*(const u32x4*)(pr + c), gb);
      unpack8(*(const u32x4*)(pr + 512 + c), a); unpack8(*(const u32x4*)(pr + 1024 + c), b);
#pragma unroll
      for (int i = 0; i < 8; ++i) mc[i] = a[i] * b[i];
      if (t > t0) {
        unpack8(*(const u32x4*)(pr - 2048 + 512 + c), a); unpack8(*(const u32x4*)(pr - 2048 + 1024 + c), b);
#pragma unroll
        for (int i = 0; i < 8; ++i) mp[i] = a[i] * b[i];
      } else {
#pragma unroll
        for (int i = 0; i < 8; ++i) mp[i] = 0.f;
      }
      if (t < t0 + L - 1) {
        unpack8(*(const u32x4*)(pr + 2048 + 512 + c), a); unpack8(*(const u32x4*)(pr + 2048 + 1024 + c), b);
#pragma unroll
        for (int i = 0; i < 8; ++i) mn[i] = a[i] * b[i];
      } else {
#pragma unroll
        for (int i = 0; i < 8; ++i) mn[i] = 0.f;
      }
      float y[8];
#pragma unroll
      for (int i = 0; i < 8; ++i) y[i] = gb[i] * (w0[i] * mp[i] + w1[i] * mc[i] + w2[i] * mn[i]);
      *(u32x4*)(mix + (long)t * 1024 + c) = pack8(y);
      {
        const u32x2 v = *(const u32x2*)(pr + 1536 + lane * 4);
        float f0 = lo_bf(v[0]), f1 = hi_bf(v[0]), f2 = lo_bf(v[1]), f3 = hi_bf(v[1]);
        const float ss = wave_sum(f0 * f0 + f1 * f1 + f2 * f2 + f3 * f3);
        const float rs = rsqrtf(ss * (1.f / 256.f) + EPSN);
        u32x2 o; o[0] = pack2(f0 * rs * gq[0], f1 * rs * gq[1]); o[1] = pack2(f2 * rs * gq[2], f3 * rs * gq[3]);
        *(u32x2*)(cqn + (long)t * 256 + lane * 4) = o;
      }
      {
        const unsigned v = *(const unsigned*)(pr + 1792 + lane * 2);
        float f0 = lo_bf(v), f1 = hi_bf(v);
        const float ss = wave_sum(f0 * f0 + f1 * f1);
        const float rs = rsqrtf(ss * (1.f / 128.f) + EPSN);
        *(unsigned*)(ckvn + (long)t * 128 + lane * 2) = pack2(f0 * rs * gk[0], f1 * rs * gk[1]);
      }
      {
        const unsigned v = (lane < 16) ? *(const unsigned*)(pr + 1920 + lane * 2) : 0u;
        if (lane < 16) *(unsigned*)(kpe + (long)t * 32 + lane * 2) = v;
        const float f0 = lo_bf(v), f1 = hi_bf(v);
        const float ss = wave_sum(f0 * f0 + f1 * f1);
        if (lane == 0) sskpe[t] = ss;
      }
    }
  }
  grid_bar(barcnt, bar_target, (unsigned)G);

  if (PHM & (1 << 3)) {
    PHASE_IDS
    const u16* cqn = (const u16*)(ws + R_CQN);
    const u16* ckvn = (const u16*)(ws + R_CKVN);
    const u16* kpe = (const u16*)(ws + R_KPE);
    const float* sskpe = (const float*)(ws + SM_SSKPE);
    const float2* rope = (const float2*)(ws + R_ROPE);
    u16* Qo = (u16*)(dsc + D_QRAW);
    u16* Kb = (u16*)(ws + R_K);
    u16* Vt = (u16*)(dsc + D_VT);
    const float* qn = p.in[13]; const float* kn = p.in[14];
    const float qscale = 0.10206207261596577f * 1.4426950408889634f;
    for (int tile = vb; tile < 512 + 512 + 512; tile += G) {
      if (tile < 512) {
        const int tm = tile >> 2, tn = tile & 3;
        gemm_tile<6>(cqn + (long)tm * 256 * 256, 256, (const u16*)(ws + W0_Q) + (long)tn * 192 * 256, 256, 256, smem,
          [&](f32x4 (&acc)[4][6], int r0, int c0) {
            const int fr_ = c0 % 96, h = tn * 2 + c0 / 96;
#pragma unroll
            for (int mi = 0; mi < 4; ++mi)
#pragma unroll
              for (int j = 0; j < 4; ++j) {
                const int row = tm * 256 + r0 + mi * 16 + j;
                float ss = 0.f;
#pragma unroll
                for (int ni = 0; ni < 6; ++ni) ss += acc[mi][ni][j] * acc[mi][ni][j];
                ss += __shfl_xor(ss, 8); ss += __shfl_xor(ss, 4); ss += __shfl_xor(ss, 2); ss += __shfl_xor(ss, 1);
                const float rs = rsqrtf(ss * (1.f / 96.f) + EPSN) * qscale;
                int t0, L; seq_of(row, t0, L);
                const float2 cs = rope[(long)(row - t0) * 16 + fr_];
                u16* qp = Qo + (long)row * 768 + h * 96 + fr_;
#pragma unroll
                for (int ni = 0; ni < 4; ++ni) qp[ni * 16] = f2bf(acc[mi][ni][j] * rs * qn[ni * 16 + fr_]);
                const float x1 = acc[mi][4][j] * rs * qn[64 + fr_], x2 = acc[mi][5][j] * rs * qn[80 + fr_];
                qp[64] = f2bf(x1 * cs.x - x2 * cs.y);
                qp[80] = f2bf(x1 * cs.y + x2 * cs.x);
              }
          });
      } else if (tile < 1024) {
        const int tt = tile - 512, tm = tt >> 2, tn = tt & 3;
        gemm_tile<4>(ckvn + (long)tm * 256 * 128, 128, (const u16*)(ws + W0_K) + (long)tn * 128 * 128, 128, 128, smem,
          [&](f32x4 (&acc)[4][4], int r0, int c0) {
            const int fr_ = c0 & 63, h = tn * 2 + (c0 >> 6);
#pragma unroll
            for (int mi = 0; mi < 4; ++mi)
#pragma unroll
              for (int j = 0; j < 4; ++j) {
                const int row = tm * 256 + r0 + mi * 16 + j;
                float ss = 0.f;
#pragma unroll
                for (int ni = 0; ni < 4; ++ni) ss += acc[mi][ni][j] * acc[mi][ni][j];
                ss += __shfl_xor(ss, 8); ss += __shfl_xor(ss, 4); ss += __shfl_xor(ss, 2); ss += __shfl_xor(ss, 1);
                const float rs = rsqrtf((ss + sskpe[row]) * (1.f / 96.f) + EPSN);
                int t0, L; seq_of(row, t0, L);
                const float2 cs = rope[(long)(row - t0) * 16 + fr_];
                u16* kp = Kb + ((long)h * T_TOK + row) * 96 + fr_;
#pragma unroll
                for (int ni = 0; ni < 4; ++ni) kp[ni * 16] = f2bf(acc[mi][ni][j] * rs * kn[ni * 16 + fr_]);
                const float x1 = bf2f(kpe[(long)row * 32 + fr_]) * rs * kn[64 + fr_], x2 = bf2f(kpe[(long)row * 32 + 16 + fr_]) * rs * kn[80 + fr_];
                kp[64] = f2bf(x1 * cs.x - x2 * cs.y);
                kp[80] = f2bf(x1 * cs.y + x2 * cs.x);
              }
          });
      } else {
        const int tt = tile - 1024, tm = tt & 1, tn = tt >> 1;
        gemm_tile<4>((const u16*)(ws + W0_V) + (long)tm * 256 * 128, 128, ckvn + (long)tn * 128 * 128, 128, 128, smem,
          [&](f32x4 (&acc)[4][4], int r0, int c0) {
#pragma unroll
            for (int mi = 0; mi < 4; ++mi)
#pragma unroll
              for (int j = 0; j < 4; ++j)
#pragma unroll
                for (int ni = 0; ni < 4; ++ni)
                  Vt[(long)(tm * 256 + r0 + mi * 16 + j) * T_TOK + tn * 128 + c0 + ni * 16] = f2bf(acc[mi][ni][j]);
          });
      }
    }
  }
  grid_bar(barcnt, bar_target, (unsigned)G);

  for (int rep = 0; rep < REP5; ++rep) if (PHM & (1 << 5)) {
    PHASE_IDS
    const u16* Q = (const u16*)(dsc + D_QRAW);
    const u16* Kb = (const u16*)(ws + R_K);
    const u16* Vt = (const u16*)(dsc + D_VT);
    u16* mix = (u16*)(ws + R_MIX);
    float mq = 0.f, mk = 0.f;
    for (int i = 0; i < 96; ++i) { mq = fmaxf(mq, fabsf(p.in[13][i])); mk = fmaxf(mk, fabsf(p.in[14][i])); }
    const float M0 = 96.f * mq * mk * (0.10206207261596577f * 1.4426950408889634f) * 1.02f + 0.5f;
    const bool fixed_ref = M0 < 40.f;
    for (int item = vb; item < 1024; item += G) {
      int t0, L, h, qb;
      if (item < 512) { t0 = 16384; L = 16384; h = item >> 6; qb = item & 63; }
      else { const int it = item - 512; const int sq = it >> 8; t0 = sq * 8192; L = 8192; h = (it >> 5) & 7; qb = it & 31; }
      if (fixed_ref) attn_item<true>(Q, Kb, Vt, mix, t0, L, h, qb, M0, smem, tid);
      else attn_item<false>(Q, Kb, Vt, mix, t0, L, h, qb, M0, smem, tid);
    }
  }
  grid_bar(barcnt, bar_target, (unsigned)G);

  if (PHM & (1 << 6)) {
    pg8::Gemm g{(const u16*)(ws + R_MIX), (const u16*)(ws + W0_OUT), T_TOK, DM, DM};
    pg8::StaticOrder S; S.init(T_TOK, DM, G, bid);
    EpiResid E{XB, rowss + T_TOK};
    pg8::gemm_phase<EpiResid, pg8::StaticOrder>(lds, g, S, E, nullptr);
  }
  grid_bar(barcnt, bar_target, (unsigned)G);
  for (int rep = 0; rep < REP7; ++rep) if (PHM & (1 << 7)) {
    pg8::Gemm g{XB, (const u16*)(ws + W0_GU), T_TOK, 5632, DM};
    pg8::StaticOrder S; S.init(T_TOK, 5632, G, bid);
    EpiGU E{(u16*)(ws + OFF_R), (u16*)dsc, 16384, rowss + T_TOK, 0};
    pg8::gemm_phase<EpiGU, pg8::StaticOrder>(lds, g, S, E, nullptr);
  }
  grid_bar(barcnt, bar_target, (unsigned)G);
  if (PHM & (1 << 7)) {
    pg8::Gemm g{(const u16*)(ws + OFF_R), (const u16*)(ws + W0_D), T_TOK, DM, DFF};
    SplitOrder S; S.init(T_TOK, DM, G, bid); S.base2 = (const char*)dsc; S.split = 64;
    EpiResid E{XB, rowss + 2 * T_TOK};
    pg8::gemm_phase<EpiResid, SplitOrder>(lds, g, S, E, nullptr);
  }
  grid_bar(barcnt, bar_target, (unsigned)G);

  for (int rep = 0; rep < REP8; ++rep) if (PHM & (1 << 8)) {
    const u16* Wt = (const u16*)(ws + W1_CIN);
    u16* x0t = (u16*)(ws + C_X0T);
    u16* x1vt = (u16*)dsc;
    const float* ssq = rowss + 2 * T_TOK;
    {
      pg8::Gemm g{Wt, XB, 3072, T_TOK, DM};
      pg8::StaticOrder S; S.init(3072, T_TOK, G, bid);
      EpiCin E{x0t, x1vt, ssq};
      pg8::gemm_phase<EpiCin, pg8::StaticOrder>(lds, g, S, E, nullptr);
    }
    for (int tile = 3072 + vb; tile < 3072 + 1536; tile += G) {
      {
        const int tt = tile - 3072;
        const bool smp = tt >= 512;
        const int t2 = smp ? tt - 512 : tt;
        const int tm = t2 & 7, tn = t2 >> 3;
        const int Lf = smp ? 16384 : 8192;
        const u16* z3 = (const u16*)(ws + SM_Z3) + (smp ? (long)8192 * 64 : 0);
        u16* kern = smp ? (u16*)(ws + C_KS) : (u16*)(ws + C_KP);
        gemm_tile((const u16*)(ws + W1_W4) + (long)tm * 256 * 64, 64, z3 + (long)tn * 128 * 64, 64, 64, smem,
          [&](f32x4 (&acc)[4][4], int r0, int c0) {
            const float invLm1 = 1.f / (float)(Lf - 1);
#pragma unroll
            for (int mi = 0; mi < 4; ++mi)
#pragma unroll
              for (int j = 0; j < 4; ++j) {
                const int cp = tm * 256 + r0 + mi * 16 + j;
                const int ch = cp & 1023;
                const bool bwd = cp >= 1024;
                const float ad = 3.0701134573253945f + (float)ch * (12.280453829301578f / 1023.f);
                u16* kr = kern + (long)ch * (2 * Lf);
#pragma unroll
                for (int ni = 0; ni < 4; ++ni) {
                  const int l = tn * 128 + c0 + ni * 16;
                  const float wv = __expf(-(float)l * invLm1 * ad);
                  const float val = acc[mi][ni][j] * wv;
                  if (!bwd) kr[l] = f2bf(val);
                  else if (l > 0) kr[2 * Lf - l] = f2bf(val);
                  else kr[Lf] = 0;
                }
              }
          });
      }
    }
  }
  grid_bar(barcnt, bar_target, (unsigned)G);

  if (PHM & (1 << 9)) {
    PHASE_IDS
    float2* X = (float2*)smem;
    u16* zs = (u16*)(smem + 131072);
    const u16* x0t = (const u16*)(ws + C_X0T);
    u16* x1vt = (u16*)dsc;
    const float* sw = p.in[17];
    const float SCL = 1.f / 16384.f;
    for (int job = vb; job < 2048; job += G) {
      int tidj = threadIdx.x; asm volatile("" : "+v"(tidj));
      const int tid = tidj;
      const bool smp = job >= 1024;
      const int ch = job & 1023;
      const float w00 = sw[ch * 3], w01 = sw[ch * 3 + 1], w02 = sw[ch * 3 + 2];
      const float w10 = sw[(1024 + ch) * 3], w11 = sw[(1024 + ch) * 3 + 1], w12 = sw[(1024 + ch) * 3 + 2];
      const float w20 = sw[(2048 + ch) * 3], w21 = sw[(2048 + ch) * 3 + 1], w22 = sw[(2048 + ch) * 3 + 2];
      const float bias = p.in[26][ch];
      u16* x1row = x1vt + (long)ch * T_TOK;
      const u16* vrow = x1vt + (long)(1024 + ch) * T_TOK;
      const u16* x0row = x0t + (long)ch * T_TOK;
      __syncthreads();
      if (!smp && (FFTP & 1)) {
        const u16* kr = (const u16*)(ws + C_KP) + (long)ch * 16384;
#pragma unroll
        for (int u = 0; u < 4; ++u) {
          const int n = 8 * (tid + 512 * u);
          float f[8]; unpack8(*(const u32x4*)(kr + n), f);
#pragma unroll
          for (int i = 0; i < 8; ++i) X[PX(n + i)] = make_float2(f[i], 0.f);
        }
        fft_fwd_head(X);
        unsigned Kf[2][16];
#pragma unroll
        for (int u = 0; u < 2; ++u) {
          const int g = tid + 512 * u;
          float2 v[16];
#pragma unroll
          for (int r = 0; r < 16; ++r) v[r] = X[16 * g + (r ^ (g & 15))];
          fft16_fwd(v);
#pragma unroll
          for (int r = 0; r < 16; ++r) Kf[u][r] = pack2(v[r].x, v[r].y);
          asm volatile("" ::: "memory");
        }
        __syncthreads();
#pragma unroll 1
        for (int u = 0; u < 2; ++u) {
          const int n = 8 * (tid + 512 * u);
          float z0[8], z1[8];
          {
            float a[8], c[8];
            conv3_8(x1row, n, 8192, w10, w11, w12, a);
            conv3_8(vrow, n, 8192, w20, w21, w22, c);
#pragma unroll
            for (int i = 0; i < 8; ++i) z0[i] = a[i] * c[i];
            conv3_8(x1row + 8192, n, 8192, w10, w11, w12, a);
            conv3_8(vrow + 8192, n, 8192, w20, w21, w22, c);
#pragma unroll
            for (int i = 0; i < 8; ++i) z1[i] = a[i] * c[i];
          }
          *(u32x4*)(zs + n) = pack8(z0);
          *(u32x4*)(zs + 8192 + n) = pack8(z1);
#pragma unroll
          for (int i = 0; i < 8; ++i) X[PX(n + i)] = make_float2(z0[i], z1[i]);
        }
        fft_fwd_head<true>(X);
#pragma unroll
        for (int u = 0; u < 2; ++u) {
          const int g = tid + 512 * u;
          float2 v[16];
#pragma unroll
          for (int r = 0; r < 16; ++r) v[r] = X[16 * g + (r ^ (g & 15))];
          fft16_fwd(v);
#pragma unroll
          for (int r = 0; r < 16; ++r) v[r] = cmul(v[r], make_float2(lo_bf(Kf[u][r]), hi_bf(Kf[u][r])));
          fft16_inv(v);
#pragma unroll
          for (int r = 0; r < 16; ++r) X[16 * g + (r ^ (g & 15))] = v[r];
          asm volatile("" ::: "memory");
        }
        fft_inv_tail(X);
#pragma unroll 1
        for (int u = 0; u < 2; ++u) {
          const int n = 8 * (tid + 512 * u);
          float yr[8], yi[8], z0[8], z1[8];
          unpack8(*(const u32x4*)(zs + n), z0);
          unpack8(*(const u32x4*)(zs + 8192 + n), z1);
#pragma unroll
          for (int i = 0; i < 8; ++i) { const float2 xv = X[PX(n + i)]; yr[i] = xv.x * SCL + bias * z0[i]; yi[i] = xv.y * SCL + bias * z1[i]; }
          float g0[8];
          conv3_8(x0row, n, 8192, w00, w01, w02, g0);
#pragma unroll
          for (int i = 0; i < 8; ++i) yr[i] *= g0[i];
          conv3_8(x0row + 8192, n, 8192, w00, w01, w02, g0);
#pragma unroll
          for (int i = 0; i < 8; ++i) yi[i] *= g0[i];
          *(u32x4*)(x1row + n) = pack8(yr);
          *(u32x4*)(x1row + 8192 + n) = pack8(yi);
        }
      } else if (smp && (FFTP & 2)) {
        const u16* kr = (const u16*)(ws + C_KS) + (long)ch * 32768;
#pragma unroll
        for (int u = 0; u < 8; ++u) {
          const int n = 4 * (tid + 512 * u);
          float f[8]; unpack8(*(const u32x4*)(kr + 2 * n), f);
#pragma unroll
          for (int i = 0; i < 4; ++i) X[PX(n + i)] = make_float2(f[2 * i], f[2 * i + 1]);
        }
        fft_fwd_head(X);
#pragma unroll 1
        for (int u = 0; u < 2; ++u) {
          const int g = tid + 512 * u;
          float2 v[16];
#pragma unroll
          for (int r = 0; r < 16; ++r) v[r] = X[16 * g + (r ^ (g & 15))];
          fft16_fwd(v);
#pragma unroll
          for (int r = 0; r < 16; ++r) X[16 * g + (r ^ (g & 15))] = v[r];
        }
        __syncthreads();
        unsigned KA[17], KB[17];
#pragma unroll
        for (int m = 0; m < 17; ++m) {
          int k = (m < 16) ? (((tid & 31) << 8) | (m * 16 + ((tid >> 6) << 1) + ((tid >> 5) & 1))) : 8192;
          asm volatile("" : "+v"(k) :: "memory");
          if (m < 16 || tid == 0) {
            const float2 c1 = X[PX(pos14(k))], c2 = X[PX(pos14((16384 - k) & 16383))];
            const float2 ae = make_float2(0.5f * (c1.x + c2.x), 0.5f * (c1.y - c2.y));
            const float2 ao = make_float2(0.5f * (c1.y + c2.y), -0.5f * (c1.x - c2.x));
            const float2 tw = twid((float)k * (1.f / 32768.f));
            const float2 tao = cmul(tw, ao);
            const float2 ka = cadd(ae, tao), kb = cconj(csub(ae, tao));
            KA[m] = pack2(ka.x, ka.y);
            KB[m] = pack2(kb.x, kb.y);
          } else { KA[m] = 0u; KB[m] = 0u; }
        }
        __syncthreads();
        const u16* x1s = x1row + 16384; const u16* vs = vrow + 16384;
#pragma unroll 1
        for (int u = 0; u < 4; ++u) {
          const int tl = 8 * (tid + 512 * u);
          float a[8], c[8];
          conv3_8(x1s, tl, 16384, w10, w11, w12, a);
          conv3_8(vs, tl, 16384, w20, w21, w22, c);
#pragma unroll
          for (int i = 0; i < 8; ++i) a[i] *= c[i];
          *(u32x4*)(zs + tl) = pack8(a);
          const int n = tl >> 1;
#pragma unroll
          for (int i = 0; i < 4; ++i) X[PX(n + i)] = make_float2(a[2 * i], a[2 * i + 1]);
        }
        fft_fwd_head<true>(X);
#pragma unroll 1
        for (int u = 0; u < 2; ++u) {
          const int g = tid + 512 * u;
          float2 v[16];
#pragma unroll
          for (int r = 0; r < 16; ++r) v[r] = X[16 * g + (r ^ (g & 15))];
          fft16_fwd(v);
#pragma unroll
          for (int r = 0; r < 16; ++r) X[16 * g + (r ^ (g & 15))] = v[r];
        }
        __syncthreads();
#pragma unroll
        for (int m = 0; m < 17; ++m) {
          int k = (m < 16) ? (((tid & 31) << 8) | (m * 16 + ((tid >> 6) << 1) + ((tid >> 5) & 1))) : 8192;
          asm volatile("" : "+v"(k) :: "memory");
          if (m < 16 || tid == 0) {
            const int p1 = PX(pos14(k)), p2 = PX(pos14((16384 - k) & 16383));
            const float2 c1 = X[p1], c2 = X[p2];
            const float2 ae = make_float2(0.5f * (c1.x + c2.x), 0.5f * (c1.y - c2.y));
            const float2 ao = make_float2(0.5f * (c1.y + c2.y), -0.5f * (c1.x - c2.x));
            const float2 tw = twid((float)k * (1.f / 32768.f));
            const float2 tao = cmul(tw, ao);
            const float2 y1 = cmul(cadd(ae, tao), make_float2(lo_bf(KA[m]), hi_bf(KA[m])));
            const float2 y2 = cmul(cconj(csub(ae, tao)), make_float2(lo_bf(KB[m]), hi_bf(KB[m])));
            const float2 ye = make_float2(0.5f * (y1.x + y2.x), 0.5f * (y1.y - y2.y));
            const float2 yd = make_float2(0.5f * (y1.x - y2.x), 0.5f * (y1.y + y2.y));
            const float2 yo = cmulc(yd, tw);
            X[p1] = make_float2(ye.x - yo.y, ye.y + yo.x);
            if (k != 0) X[p2] = make_float2(ye.x + yo.y, -ye.y + yo.x);
          }
        }
        __syncthreads();
#pragma unroll 1
        for (int u = 0; u < 2; ++u) {
          const int g = tid + 512 * u;
          float2 v[16];
#pragma unroll
          for (int r = 0; r < 16; ++r) v[r] = X[16 * g + (r ^ (g & 15))];
          fft16_inv(v);
#pragma unroll
          for (int r = 0; r < 16; ++r) X[16 * g + (r ^ (g & 15))] = v[r];
        }
        fft_inv_tail(X);
        u16* orow = x1row + 16384;
        const u16* x0s = x0row + 16384;
#pragma unroll 1
        for (int u = 0; u < 4; ++u) {
          const int tl = 8 * (tid + 512 * u);
          const int n = tl >> 1;
          float y[8], g0[8], zz[8];
          unpack8(*(const u32x4*)(zs + tl), zz);
#pragma unroll
          for (int i = 0; i < 4; ++i) { const float2 xv = X[PX(n + i)]; y[2 * i] = xv.x * SCL + bias * zz[2 * i]; y[2 * i + 1] = xv.y * SCL + bias * zz[2 * i + 1]; }
          conv3_8(x0s, tl, 16384, w00, w01, w02, g0);
#pragma unroll
          for (int i = 0; i < 8; ++i) y[i] *= g0[i];
          *(u32x4*)(orow + tl) = pack8(y);
        }
      }
    }
  }
  grid_bar(barcnt, bar_target, (unsigned)G);

  if (PHM & (1 << 10)) {
    PHASE_IDS
    const u16* src = (const u16*)dsc;
    u16* yg = (u16*)(ws + C_YG);
    u16* tl = (u16*)smem;
    for (int tile = vb; tile < 16 * 512; tile += G) {
      const int tc = tile & 15, tt = tile >> 4;
      {
        const int cr = tid >> 3, c8 = tid & 7;
        const u32x4 v = *(const u32x4*)(src + (long)(tc * 64 + cr) * T_TOK + tt * 64 + c8 * 8);
        *(u32x4*)(tl + cr * 72 + c8 * 8) = v;
      }
      __syncthreads();
      {
        const int tr = tid >> 3, c8 = tid & 7;
        u32x4 o;
#pragma unroll
        for (int i = 0; i < 4; ++i) {
          const unsigned a = tl[(c8 * 8 + 2 * i) * 72 + tr], b = tl[(c8 * 8 + 2 * i + 1) * 72 + tr];
          o[i] = a | (b << 16);
        }
        *(u32x4*)(yg + (long)(tt * 64 + tr) * DM + tc * 64 + c8 * 8) = o;
      }
      __syncthreads();
    }
  }
  grid_bar(barcnt, bar_target, (unsigned)G);

  if (PHM & (1 << 11)) {
    pg8::Gemm g{(const u16*)(ws + C_YG), (const u16*)(ws + W1_COUT), T_TOK, DM, DM};
    pg8::StaticOrder S; S.init(T_TOK, DM, G, bid);
    EpiResid E{XB, rowss + 3 * T_TOK};
    pg8::gemm_phase<EpiResid, pg8::StaticOrder>(lds, g, S, E, nullptr);
  }
  grid_bar(barcnt, bar_target, (unsigned)G);

  if (PHM & (1 << 12)) {
    u16* actC = (u16*)(ws + OFF_C);
    pg8::Gemm g{XB + (size_t)0 * 16384 * DM, (const u16*)(ws + W1_GU), 16384, 5632, DM};
    pg8::StaticOrder S; S.init(16384, 5632, G, bid);
    EpiGU E{actC - (size_t)0 * 16384 * DFF, actC, 1 << 30, rowss + 3 * T_TOK, 0 * 16384};
    pg8::gemm_phase<EpiGU, pg8::StaticOrder>(lds, g, S, E, nullptr);
  }
  grid_bar(barcnt, bar_target, (unsigned)G);
  if (PHM & (1 << 12)) {
    pg8::Gemm g{(const u16*)(ws + OFF_C), (const u16*)(ws + W1_D), 16384, DM, DFF};
    pg8::StaticOrder S; S.init(16384, DM, G, bid);
    EpiFinal E{XB, p.out, 0 * 16384};
    pg8::gemm_phase<EpiFinal, pg8::StaticOrder>(lds, g, S, E, nullptr);
  }
  grid_bar(barcnt, bar_target, (unsigned)G);
  if (PHM & (1 << 12)) {
    u16* actC = (u16*)(ws + OFF_C);
    pg8::Gemm g{XB + (size_t)1 * 16384 * DM, (const u16*)(ws + W1_GU), 16384, 5632, DM};
    pg8::StaticOrder S; S.init(16384, 5632, G, bid);
    EpiGU E{actC - (size_t)1 * 16384 * DFF, actC, 1 << 30, rowss + 3 * T_TOK, 1 * 16384};
    pg8::gemm_phase<EpiGU, pg8::StaticOrder>(lds, g, S, E, nullptr);
  }
  grid_bar(barcnt, bar_target, (unsigned)G);
  if (PHM & (1 << 12)) {
    pg8::Gemm g{(const u16*)(ws + OFF_C), (const u16*)(ws + W1_D), 16384, DM, DFF};
    pg8::StaticOrder S; S.init(16384, DM, G, bid);
    EpiFinal E{XB, p.out, 1 * 16384};
    pg8::gemm_phase<EpiFinal, pg8::StaticOrder>(lds, g, S, E, nullptr);
  }
}

extern "C" void kernel_launch(void* const* d_in, const int* in_sizes, int n_in, void* d_out, int out_size,
                              void* d_ws, size_t ws_size, hipStream_t stream) {
  static int grid_blocks = 0;
  if (!grid_blocks) {
    int dev = 0, cus = 0, per_cu = 0;
    hipGetDevice(&dev);
    hipDeviceGetAttribute(&cus, hipDeviceAttributeMultiprocessorCount, dev);
    hipOccupancyMaxActiveBlocksPerMultiprocessor(&per_cu, fwd_kernel, NTHR, 0);
    if (per_cu < 1) per_cu = 1;
    grid_blocks = cus;
    if (grid_blocks % 8) grid_blocks -= grid_blocks % 8;
  }
  if (ws_size < WS_NEED || n_in < 28) { fprintf(stderr, "workspace too small\n"); return; }
  Params p{};
  for (int i = 0; i < 28; ++i) p.in[i] = (const float*)d_in[i];
  p.out = (float*)d_out;
  p.ws = (char*)d_ws;
  hipMemsetAsync(d_ws, 0, 4096, stream);
  void* args[] = {&p};
  hipError_t e = hipLaunchCooperativeKernel((void*)fwd_kernel, dim3(grid_blocks), dim3(NTHR), args, 0, stream);
  if (e != hipSuccess) fprintf(stderr, "cooperative launch failed: %s (grid %d)\n", hipGetErrorString(e), grid_blocks);
}
```

```cpp
#include <hip/hip_runtime.h>
#include <hip/hip_cooperative_groups.h>
#include <cstdio>
#include <cstdint>
namespace cg = cooperative_groups;

typedef unsigned short u16;
typedef __attribute__((ext_vector_type(8))) short bf16x8;
typedef __attribute__((ext_vector_type(4))) short s16x4;
typedef __attribute__((ext_vector_type(4))) float f32x4;
typedef __attribute__((ext_vector_type(16))) float f32x16;
typedef __attribute__((ext_vector_type(4))) unsigned u32x4;
typedef __attribute__((ext_vector_type(2))) unsigned u32x2;

#define DI __device__ __forceinline__
#define NTHR 512
#ifndef FFTP
#define FFTP 3
#endif
#ifndef REP1
#define REP1 1
#endif
#ifndef REP5
#define REP5 1
#endif
#ifndef REP7
#define REP7 1
#endif
#ifndef REP8
#define REP8 1
#endif
#ifndef PHM
#define PHM 0xffff
#endif


DI float2 mk2(float x, float y) { float2 r; r.x = x; r.y = y; return r; }
DI void bsync() { __builtin_amdgcn_fence(__ATOMIC_RELEASE, "workgroup"); __builtin_amdgcn_s_barrier(); __builtin_amdgcn_fence(__ATOMIC_ACQUIRE, "workgroup"); }
DI float i2f(int v) { return __builtin_bit_cast(float, v); }
DI int f2i(float v) { return __builtin_bit_cast(int, v); }
DI float4 mk4(float x, float y, float z, float w) { float4 r; r.x = x; r.y = y; r.z = z; r.w = w; return r; }
#define make_float4 mk4
#define make_float2 mk2
#define __syncthreads bsync
#define __int_as_float i2f
#define __float_as_int f2i

constexpr int T_TOK = 32768;
constexpr int DM = 1024;
constexpr int DFF = 2816;
constexpr float EPSN = 1e-6f;

constexpr size_t SM_ROWSS = 4096;
constexpr size_t SM_Z3    = 1048576;
constexpr size_t OFF_W1   = 4194304;
constexpr size_t W1_CIN   = OFF_W1;
constexpr size_t W1_COUT  = W1_CIN + 6291456;
constexpr size_t W1_W4    = W1_COUT + 2097152;
constexpr size_t W1_GU    = W1_W4 + 262144;
constexpr size_t W1_D     = W1_GU + 11534336;
constexpr size_t OFF_XB   = W1_D + 5767168;
constexpr size_t OFF_C    = OFF_XB + 67108864;
constexpr size_t W0_IN    = OFF_C;
constexpr size_t W0_Q     = W0_IN + 4194304;
constexpr size_t W0_K     = W0_Q + 393216;
constexpr size_t W0_V     = W0_K + 131072;
constexpr size_t W0_OUT   = W0_V + 131072;
constexpr size_t W0_GU    = W0_OUT + 2097152;
constexpr size_t W0_D     = W0_GU + 11534336;
constexpr size_t OFF_R    = W0_D + 5767168;
constexpr size_t WS_NEED  = 268435456;
static_assert(OFF_R == 121503744, "map");
constexpr size_t R_CQN  = OFF_R;
constexpr size_t R_CKVN = R_CQN + 16777216;
constexpr size_t R_KPE  = R_CKVN + 8388608;
constexpr size_t R_MIX  = R_KPE + 2097152;
constexpr size_t R_K    = R_MIX + 67108864;
constexpr size_t R_ROPE = R_K + 50331648;
constexpr size_t SM_SSKPE = 528384;
static_assert(R_ROPE + 2097152 <= WS_NEED, "map");
constexpr size_t D_QRAW = 0;
constexpr size_t D_KN   = 50331648;
constexpr size_t D_VT   = D_KN + 33554432;
constexpr size_t D_ROPE = D_VT + 33554432;
static_assert(D_ROPE + 2097152 <= 134217728, "map");
constexpr size_t C_X0T  = OFF_C;
constexpr size_t C_KP   = C_X0T + 67108864;
constexpr size_t C_KS   = C_KP + 33554432;
constexpr size_t C_YG   = C_KS;
static_assert(C_KS + 67108864 <= WS_NEED, "map");

struct Params {
  const float* in[28];
  float* out;
  char* ws;
};

typedef __bf16 bf16v2_t __attribute__((ext_vector_type(2)));
typedef float f32v2_t __attribute__((ext_vector_type(2)));
DI unsigned pack2(float a, float b) { f32v2_t v = {a, b}; bf16v2_t r = __builtin_convertvector(v, bf16v2_t); return __builtin_bit_cast(unsigned, r); }
DI u16 f2bf(float x) { return (u16)(pack2(x, 0.f) & 0xffffu); }
DI float bf2f(u16 v) { return __uint_as_float(((unsigned)v) << 16); }
DI float lo_bf(unsigned w) { return __uint_as_float(w << 16); }
DI float hi_bf(unsigned w) { return __uint_as_float(w & 0xffff0000u); }
DI void unpack8(const u32x4& v, float* f) {
  f[0] = lo_bf(v[0]); f[1] = hi_bf(v[0]); f[2] = lo_bf(v[1]); f[3] = hi_bf(v[1]);
  f[4] = lo_bf(v[2]); f[5] = hi_bf(v[2]); f[6] = lo_bf(v[3]); f[7] = hi_bf(v[3]);
}
DI u32x4 pack8(const float* f) {
  u32x4 v; v[0] = pack2(f[0], f[1]); v[1] = pack2(f[2], f[3]); v[2] = pack2(f[4], f[5]); v[3] = pack2(f[6], f[7]); return v;
}
DI float wave_sum(float v) {
  v += __shfl_xor(v, 32); v += __shfl_xor(v, 16); v += __shfl_xor(v, 8);
  v += __shfl_xor(v, 4); v += __shfl_xor(v, 2); v += __shfl_xor(v, 1); return v;
}
DI void seq_of(int t, int& t0, int& L) {
  if (t < 8192) { t0 = 0; L = 8192; } else if (t < 16384) { t0 = 8192; L = 8192; } else { t0 = 16384; L = 16384; }
}

namespace pg8 {
#define PG8_LAS __attribute__((address_space(3)))
typedef unsigned short bf16_t;
typedef short bf16x8 __attribute__((ext_vector_type(8)));
typedef float f32x4 __attribute__((ext_vector_type(4)));
typedef unsigned u32x4 __attribute__((ext_vector_type(4)));
constexpr int BM = 256, BK = 64, HALF = 128, HTB = HALF * BK * 2  , STAGE_BYTES = 8 * HTB, NXCD = 8, WGM = 8;

__host__ __device__ __forceinline__ int lds_byte(int r, int c) { const int st = (r >> 4) * 2 + (c >> 5), rr = r & 15, cc = c & 31, ob = rr * 64 + cc * 2; return st * 1024 + (ob ^ (((ob >> 9) & 1) << 5)); }
__host__ __device__ __forceinline__ void stage_rc(int b, int& R, int& C) { const int st = b / 1024, sb = b % 1024, swz = sb ^ (((sb >> 9) & 1) << 5); R = (st >> 1) * 16 + swz / 64; C = (st & 1) * 32 + (swz % 64) / 2; }
__host__ __device__ __forceinline__ int perm32(int rho) { const int n = rho >> 4, i = rho & 15; return 8 * (i >> 2) + 4 * n + (i & 3); }

struct Unit { int pm, pn; };
struct Gemm { const bf16_t* A; const bf16_t* Bt; int M, N, K; };

struct StaticOrder {
    int nM, nN, nwg, G, c;
    __host__ __device__ __forceinline__ void init(int M, int N, int G_, int c_) { nM = M / BM; nN = N / BM; nwg = nM * nN; G = G_; c = c_; }
    __host__ __device__ __forceinline__ bool next(int i, Unit& u) const {
        const long L = (long)i * G + c; if (L >= nwg) return false;
        int wgid = (int)L; { const int q = nwg / NXCD, r = nwg % NXCD, xcd = wgid % NXCD, off = wgid / NXCD; wgid = (xcd < r ? xcd * (q + 1) : r * (q + 1) + (xcd - r) * q) + off; }
        const int nig = WGM * nN, gid = wgid / nig, fm = gid * WGM, gsz = (nM - fm) < WGM ? (nM - fm) : WGM;
        u.pm = fm + ((wgid % nig) % gsz); u.pn = (wgid % nig) / gsz; return true;
    }
    __device__ __forceinline__ void a_ready(const Unit&) const {}
    __device__ __forceinline__ void done(const Unit&) const {}
    __device__ __forceinline__ const char* a_ptr(const char* base, int pm, size_t tstep) const { return base + (size_t)pm * tstep; }
};
__device__ __forceinline__ unsigned cvt_pk_bf16(float lo, float hi) { unsigned r; asm volatile("v_cvt_pk_bf16_f32 %0, %1, %2" : "=v"(r) : "v"(lo), "v"(hi)); return r; }
template <class Epi, class Sched, bool STAMP = false>
__device__ __forceinline__ void gemm_phase(PG8_LAS unsigned char* lds, const Gemm g, const Sched& S, const Epi& E, unsigned long long* stamps) {
    int tid = threadIdx.x; asm volatile("" : "+v"(tid));
    const int wid = __builtin_amdgcn_readfirstlane(tid >> 6), lane = tid & 63, wr = wid >> 2, wc = wid & 3, fr = lane & 15, fq = lane >> 4;
    const int K = g.K, nt = K / BK;
    int ts_lo = 0, ts_hi = 0, nts = 0; const unsigned long long rt_entry = STAMP ? (unsigned long long)wall_clock64() : 0ull;
#define PG8_STAMP() do { if (STAMP && wid == 0 && nts < 64) { const unsigned long long _c = (unsigned long long)clock64(); \
        ts_lo = (lane == nts) ? (int)(unsigned)_c : ts_lo; ts_hi = (lane == nts) ? (int)(unsigned)(_c >> 32) : ts_hi; ++nts; } } while (0)
    PG8_STAMP();
    unsigned voffA[2], voffB[2];
#pragma unroll
    for (int i = 0; i < 2; ++i) { int R, C; stage_rc(tid * 16 + i * 8192, R, C); const int Rb = Epi::PERM ? ((R & ~31) + perm32(R & 31)) : R;
        voffA[i] = (unsigned)(R * K + C) * 2u; voffB[i] = (unsigned)(Rb * K + C) * 2u; }
    const size_t kstep = (size_t)(BK * 2);
    const size_t hstep = (size_t)HALF * K * 2;
    const size_t tstep = 2 * hstep;
    const unsigned ldsw = (unsigned)wid * 1024u;
    const int aoff = lds_byte(wr * 64 + fr, fq * 8), boff = lds_byte(wc * 32 + fr, fq * 8);
#define PG8_SA(b, h) (((b) * 2 + (h)) * HTB)
#define PG8_SB(b, h) ((4 + (b) * 2 + (h)) * HTB)
#define PG8_STAGE(bufoff, gbase, voff) do { _Pragma("unroll") for (int _i = 0; _i < 2; ++_i) \
        __builtin_amdgcn_global_load_lds((const unsigned*)((const char*)(gbase) + (voff)[_i]), (PG8_LAS unsigned*)(lds + (bufoff) + ldsw + _i * 8192), 16, 0, 0); } while (0)
#define PG8_LDA(dst, b, h) do { _Pragma("unroll") for (int m = 0; m < 4; ++m) _Pragma("unroll") for (int k = 0; k < 2; ++k) dst[m][k] = *(const PG8_LAS bf16x8*)(lds + PG8_SA(b, h) + aoff + m * 2048 + k * 1024); } while (0)
#define PG8_LDB(dst, b, h) do { _Pragma("unroll") for (int n = 0; n < 2; ++n) _Pragma("unroll") for (int k = 0; k < 2; ++k) dst[n][k] = *(const PG8_LAS bf16x8*)(lds + PG8_SB(b, h) + boff + n * 2048 + k * 1024); } while (0)
#define PG8_MMA(ai, bj, At, Bt) do { __builtin_amdgcn_s_setprio(1); _Pragma("unroll") for (int m = 0; m < 4; ++m) _Pragma("unroll") for (int n = 0; n < 2; ++n) _Pragma("unroll") for (int k = 0; k < 2; ++k) \
        acc[ai][bj][m][n] = __builtin_amdgcn_mfma_f32_16x16x32_bf16(Bt[n][k], At[m][k], acc[ai][bj][m][n], 0, 0, 0); __builtin_amdgcn_s_setprio(0); } while (0)
#define PG8_WAIT_V(n) asm volatile("s_waitcnt vmcnt(" #n ")" ::: "memory")
#define PG8_WAIT_L(n) asm volatile("s_waitcnt lgkmcnt(" #n ")" ::: "memory")
#define PG8_BAR __builtin_amdgcn_s_barrier()
#define PG8_SCHED __builtin_amdgcn_sched_barrier(0)
    Unit cur, nxt; int ui = 0;
    if (!S.next(0, cur)) return;
    f32x4 acc[2][2][4][2];
#pragma unroll
    for (int a = 0; a < 2; ++a)
#pragma unroll
        for (int b = 0; b < 2; ++b)
#pragma unroll
            for (int m = 0; m < 4; ++m)
#pragma unroll
                for (int n = 0; n < 2; ++n) acc[a][b][m][n] = (f32x4){0.f, 0.f, 0.f, 0.f};
    bf16x8 At[4][2], B0[2][2], B1[2][2];
    const char* cA = S.a_ptr((const char*)g.A, cur.pm, tstep); const char* cB = (const char*)g.Bt + (size_t)cur.pn * tstep;
    S.a_ready(cur);
    PG8_STAGE(PG8_SB(0, 0), cB, voffB); PG8_STAGE(PG8_SA(0, 0), cA, voffA); PG8_STAGE(PG8_SB(0, 1), cB + hstep, voffB); PG8_STAGE(PG8_SA(0, 1), cA + hstep, voffA);
    if (wr == 1) PG8_BAR;
    PG8_WAIT_V(4); PG8_BAR;
    PG8_STAGE(PG8_SB(1, 0), cB + kstep, voffB); PG8_STAGE(PG8_SA(1, 0), cA + kstep, voffA); PG8_STAGE(PG8_SB(1, 1), cB + hstep + kstep, voffB);
    PG8_WAIT_V(6); PG8_BAR;
    PG8_STAMP();
    for (;;) {
        const bool has_next = S.next(ui + 1, nxt);
        const char* nA = has_next ? S.a_ptr((const char*)g.A, nxt.pm, tstep) : cA; const char* nB = has_next ? (const char*)g.Bt + (size_t)nxt.pn * tstep : cB;
        for (int t = 0; t < nt; t += 2) {
            const bool last = (t == nt - 2);
            const char* a1 = cA + (size_t)(t + 1) * kstep;
            const char* a2 = last ? nA : cA + (size_t)(t + 2) * kstep; const char* b2 = last ? nB : cB + (size_t)(t + 2) * kstep;
            const char* a3 = a2 + kstep; const char* b3 = b2 + kstep;
            if (last && has_next) S.a_ready(nxt);
            PG8_LDB(B0, 0, 0); PG8_SCHED; PG8_LDA(At, 0, 0); PG8_STAGE(PG8_SA(1, 1), a1 + hstep, voffA);
            PG8_WAIT_L(8); PG8_BAR; PG8_WAIT_L(0); PG8_MMA(0, 0, At, B0); PG8_BAR; PG8_SCHED;
            PG8_LDB(B1, 0, 1); PG8_STAGE(PG8_SB(0, 0), b2, voffB);
            PG8_BAR; PG8_WAIT_L(0); PG8_MMA(0, 1, At, B1); PG8_BAR;
            PG8_LDA(At, 0, 1); PG8_STAGE(PG8_SA(0, 0), a2, voffA);
            PG8_BAR; PG8_WAIT_L(0); PG8_MMA(1, 0, At, B0); PG8_BAR; PG8_SCHED;
            PG8_STAGE(PG8_SB(0, 1), b2 + hstep, voffB);
            PG8_WAIT_V(6); PG8_BAR; PG8_MMA(1, 1, At, B1); PG8_BAR;
            PG8_LDB(B0, 1, 0); PG8_SCHED; PG8_LDA(At, 1, 0); PG8_STAGE(PG8_SA(0, 1), a2 + hstep, voffA);
            PG8_WAIT_L(8); PG8_BAR; PG8_WAIT_L(0); PG8_MMA(0, 0, At, B0); PG8_BAR; PG8_SCHED;
            PG8_LDB(B1, 1, 1); PG8_STAGE(PG8_SB(1, 0), b3, voffB);
            PG8_BAR; PG8_WAIT_L(0); PG8_MMA(0, 1, At, B1); PG8_BAR;
            PG8_LDA(At, 1, 1); PG8_STAGE(PG8_SA(1, 0), a3, voffA);
            PG8_BAR; PG8_WAIT_L(0); PG8_MMA(1, 0, At, B0); PG8_BAR; PG8_SCHED;
            PG8_STAGE(PG8_SB(1, 1), b3 + hstep, voffB);
            PG8_WAIT_V(6); PG8_BAR; PG8_MMA(1, 1, At, B1); PG8_BAR;
        }
        PG8_STAMP();
        if constexpr (!Epi::AFTER_DRAIN) { E(acc, cur, wr, wc, fr, fq); S.done(cur); }
        PG8_STAMP();
        if (!has_next) break;
#pragma unroll
        for (int a = 0; a < 2; ++a)
#pragma unroll
            for (int b = 0; b < 2; ++b)
#pragma unroll
                for (int m = 0; m < 4; ++m)
#pragma unroll
                    for (int n = 0; n < 2; ++n) acc[a][b][m][n] = (f32x4){0.f, 0.f, 0.f, 0.f};
        cur = nxt; cA = nA; cB = nB; ++ui;
    }
    PG8_WAIT_V(0);
    if (wr == 0) PG8_BAR;
    PG8_BAR;
    if constexpr (Epi::AFTER_DRAIN) { E.fused(acc, cur, wr, wc, fr, fq, lds, wid, lane); S.done(cur); }
    PG8_STAMP();
    if (STAMP && wid == 0) { stamps[lane] = lane < nts ? (((unsigned long long)(unsigned)ts_hi << 32) | (unsigned)ts_lo) : 0ull;
        if (lane == 62) stamps[62] = rt_entry; if (lane == 63) stamps[63] = (unsigned long long)wall_clock64(); }
#undef PG8_STAMP
#undef PG8_SA
#undef PG8_SB
#undef PG8_STAGE
#undef PG8_LDA
#undef PG8_LDB
#undef PG8_MMA
#undef PG8_WAIT_V
#undef PG8_WAIT_L
#undef PG8_BAR
#undef PG8_SCHED
}
}

struct SplitOrder : pg8::StaticOrder {
  const char* base2; int split;
  DI const char* a_ptr(const char* base, int pm, size_t tstep) const { return pm < split ? base + (size_t)pm * tstep : base2 + (size_t)(pm - split) * tstep; }
};
struct EpiRowScaleBf16 {
  static constexpr bool PERM = true, AFTER_DRAIN = false;
  u16* O; int ldc; const float* ssq;
  DI void operator()(const f32x4 (&acc)[2][2][4][2], const pg8::Unit& u, int wr, int wc, int fr, int fq) const {
    const int row0 = u.pm * 256 + wr * 64 + fr, col0 = u.pn * 256 + wc * 32 + 8 * fq;
#pragma unroll
    for (int ai = 0; ai < 2; ++ai)
#pragma unroll
      for (int m = 0; m < 4; ++m) {
        const int row = row0 + ai * 128 + m * 16;
        const float rs = rsqrtf(ssq[row] * (1.f / 1024.f) + EPSN);
        u16* rp = O + (size_t)row * ldc + col0;
#pragma unroll
        for (int bj = 0; bj < 2; ++bj) {
          const f32x4 v0 = acc[ai][bj][m][0] * rs, v1 = acc[ai][bj][m][1] * rs;
          u32x4 w; w[0] = pack2(v0[0], v0[1]); w[1] = pack2(v0[2], v0[3]); w[2] = pack2(v1[0], v1[1]); w[3] = pack2(v1[2], v1[3]);
          *(u32x4*)(rp + bj * 128) = w;
        }
      }
  }
};
struct EpiResid {
  static constexpr bool PERM = true, AFTER_DRAIN = false;
  u16* X; float* ssq;
  DI void operator()(const f32x4 (&acc)[2][2][4][2], const pg8::Unit& u, int wr, int wc, int fr, int fq) const {
    const int row0 = u.pm * 256 + wr * 64 + fr, col0 = u.pn * 256 + wc * 32 + 8 * fq;
#pragma unroll
    for (int ai = 0; ai < 2; ++ai)
#pragma unroll
      for (int m = 0; m < 4; ++m) {
        const int row = row0 + ai * 128 + m * 16;
        u16* rp = X + (size_t)row * DM + col0;
        float part = 0.f;
#pragma unroll
        for (int bj = 0; bj < 2; ++bj) {
          float f[8]; unpack8(*(const u32x4*)(rp + bj * 128), f);
#pragma unroll
          for (int e = 0; e < 4; ++e) { f[e] += acc[ai][bj][m][0][e]; f[4 + e] += acc[ai][bj][m][1][e]; }
#pragma unroll
          for (int e = 0; e < 8; ++e) part += f[e] * f[e];
          *(u32x4*)(rp + bj * 128) = pack8(f);
        }
        part += __shfl_xor(part, 16); part += __shfl_xor(part, 32);
        if (fq == 0) atomicAdd(ssq + row, part);
      }
  }
};
struct EpiGU {
  static constexpr bool PERM = false, AFTER_DRAIN = false;
  u16* actA; u16* actB; int split_row; const float* ssq; int row_off;
  DI void operator()(const f32x4 (&acc)[2][2][4][2], const pg8::Unit& u, int wr, int wc, int fr, int fq) const {
    const int row0 = row_off + u.pm * 256 + wr * 64 + fr;
#pragma unroll
    for (int ai = 0; ai < 2; ++ai)
#pragma unroll
      for (int m = 0; m < 4; ++m) {
        const int row = row0 + ai * 128 + m * 16;
        const float rs = rsqrtf(ssq[row] * (1.f / 1024.f) + EPSN);
        u16* ap = (row < split_row) ? (actA + (size_t)row * DFF) : (actB + (size_t)(row - split_row) * DFF);
#pragma unroll
        for (int bj = 0; bj < 2; ++bj) {
          const f32x4 gv = acc[ai][bj][m][0] * rs, uv = acc[ai][bj][m][1] * rs;
          float o[4];
#pragma unroll
          for (int e = 0; e < 4; ++e) o[e] = gv[e] * uv[e] * __builtin_amdgcn_rcpf(1.f + __builtin_amdgcn_exp2f(-1.4426950408889634f * gv[e]));
          u32x2 w; w[0] = pack2(o[0], o[1]); w[1] = pack2(o[2], o[3]);
          *(u32x2*)(ap + 16 * (8 * u.pn + 4 * bj + wc) + 4 * fq) = w;
        }
      }
  }
};
struct EpiFinal {
  static constexpr bool PERM = false, AFTER_DRAIN = false;
  const u16* X; float* out; int row_off;
  DI void operator()(const f32x4 (&acc)[2][2][4][2], const pg8::Unit& u, int wr, int wc, int fr, int fq) const {
    const int row0 = row_off + u.pm * 256 + wr * 64 + fr, col0 = u.pn * 256 + wc * 32 + 4 * fq;
#pragma unroll
    for (int ai = 0; ai < 2; ++ai)
#pragma unroll
      for (int m = 0; m < 4; ++m) {
        const size_t rb = (size_t)(row0 + ai * 128 + m * 16) * DM + col0;
#pragma unroll
        for (int bj = 0; bj < 2; ++bj)
#pragma unroll
          for (int n = 0; n < 2; ++n) {
            const u32x2 xv = *(const u32x2*)(X + rb + bj * 128 + n * 16);
            f32x4 o = acc[ai][bj][m][n];
            o[0] += lo_bf(xv[0]); o[1] += hi_bf(xv[0]); o[2] += lo_bf(xv[1]); o[3] += hi_bf(xv[1]);
            *(f32x4*)(out + rb + bj * 128 + n * 16) = o;
          }
      }
  }
};
struct EpiCin {
  static constexpr bool PERM = true, AFTER_DRAIN = false;
  u16* x0t; u16* x1vt; const float* ssq;
  DI void operator()(const f32x4 (&acc)[2][2][4][2], const pg8::Unit& u, int wr, int wc, int fr, int fq) const {
    const int row0 = u.pm * 256 + wr * 64 + fr, col0 = u.pn * 256 + wc * 32 + 8 * fq;
    float rs[2][8];
#pragma unroll
    for (int bj = 0; bj < 2; ++bj)
#pragma unroll
      for (int e = 0; e < 8; ++e) rs[bj][e] = rsqrtf(ssq[col0 + bj * 128 + e] * (1.f / 1024.f) + EPSN);
#pragma unroll
    for (int ai = 0; ai < 2; ++ai)
#pragma unroll
      for (int m = 0; m < 4; ++m) {
        const int ch = row0 + ai * 128 + m * 16;
        u16* rp = ((ch < 1024) ? (x0t + (size_t)ch * T_TOK) : (x1vt + (size_t)(ch - 1024) * T_TOK)) + col0;
#pragma unroll
        for (int bj = 0; bj < 2; ++bj) {
          const f32x4 v0 = acc[ai][bj][m][0], v1 = acc[ai][bj][m][1];
          u32x4 w;
          w[0] = pack2(v0[0] * rs[bj][0], v0[1] * rs[bj][1]); w[1] = pack2(v0[2] * rs[bj][2], v0[3] * rs[bj][3]);
          w[2] = pack2(v1[0] * rs[bj][4], v1[1] * rs[bj][5]); w[3] = pack2(v1[2] * rs[bj][6], v1[3] * rs[bj][7]);
          *(u32x4*)(rp + bj * 128) = w;
        }
      }
  }
};

DI int swz(int row, int chunk) { return row * 128 + ((chunk ^ (row & 7)) << 4); }

template <int NI = 4, class Epi>
DI void gemm_tile(const u16* __restrict__ A, long lda, const u16* __restrict__ B, long ldb, int K, char* smem, Epi&& epi) {
  int tid = threadIdx.x; asm volatile("" : "+v"(tid));
  const int lane = tid & 63, wid = tid >> 6;
  const int wr = wid >> 1, wc = wid & 1;
  const int fr = lane & 15, fq = lane >> 4;
  constexpr int NBL = NI / 2;
  constexpr int BUFB = 32768 + NI * 32 * 128;
  f32x4 acc[4][NI];
#pragma unroll
  for (int i = 0; i < 4; ++i)
#pragma unroll
    for (int j = 0; j < NI; ++j) acc[i][j] = (f32x4){0.f, 0.f, 0.f, 0.f};
  const int lrow = tid >> 3, lch = tid & 7;
  const u16* Ap = A + (long)lrow * lda + lch * 8;
  const u16* Bp = B + (long)lrow * ldb + lch * 8;
  u32x4 ra[4], rb[NBL];
  const int nk = K >> 6;
#pragma unroll
  for (int i = 0; i < 4; ++i) ra[i] = *(const u32x4*)(Ap + (long)(i * 64) * lda);
#pragma unroll
  for (int i = 0; i < NBL; ++i) rb[i] = *(const u32x4*)(Bp + (long)(i * 64) * ldb);
#pragma unroll
  for (int i = 0; i < 4; ++i) *(u32x4*)(smem + swz(lrow + i * 64, lch)) = ra[i];
#pragma unroll
  for (int i = 0; i < NBL; ++i) *(u32x4*)(smem + 32768 + swz(lrow + i * 64, lch)) = rb[i];
  __syncthreads();
  for (int kt = 0; kt < nk; ++kt) {
    if (kt + 1 < nk) {
#pragma unroll
      for (int i = 0; i < 4; ++i) ra[i] = *(const u32x4*)(Ap + (long)(i * 64) * lda + (kt + 1) * 64);
#pragma unroll
      for (int i = 0; i < NBL; ++i) rb[i] = *(const u32x4*)(Bp + (long)(i * 64) * ldb + (kt + 1) * 64);
    }
    const char* sa = smem + (kt & 1) * BUFB;
    const char* sb = sa + 32768;
#pragma unroll
    for (int ks = 0; ks < 2; ++ks) {
      bf16x8 af[4], bfr[NI];
#pragma unroll
      for (int mi = 0; mi < 4; ++mi) af[mi] = *(const bf16x8*)(sa + swz(wr * 64 + mi * 16 + fr, ks * 4 + fq));
#pragma unroll
      for (int ni = 0; ni < NI; ++ni) bfr[ni] = *(const bf16x8*)(sb + swz(wc * (NI * 16) + ni * 16 + fr, ks * 4 + fq));
#pragma unroll
      for (int mi = 0; mi < 4; ++mi)
#pragma unroll
        for (int ni = 0; ni < NI; ++ni)
          acc[mi][ni] = __builtin_amdgcn_mfma_f32_16x16x32_bf16(af[mi], bfr[ni], acc[mi][ni], 0, 0, 0);
    }
    if (kt + 1 < nk) {
      char* da = smem + ((kt + 1) & 1) * BUFB;
#pragma unroll
      for (int i = 0; i < 4; ++i) *(u32x4*)(da + swz(lrow + i * 64, lch)) = ra[i];
#pragma unroll
      for (int i = 0; i < NBL; ++i) *(u32x4*)(da + 32768 + swz(lrow + i * 64, lch)) = rb[i];
    }
    __syncthreads();
  }
  epi(acc, wr * 64 + fq * 4, wc * (NI * 16) + fr);
}

template <int KIND>
DI void convert_w(const float* __restrict__ src, const float* __restrict__ src2, int Nsrc, int K, int Np,
                  u16* __restrict__ dst, const float* __restrict__ gain, long gtid, long GT) {
  const int items = Np * (K >> 3);
#pragma unroll 4
  for (int it = (int)gtid; it < items; it += (int)GT) {
    const int np = it % Np, kc = it / Np;
    const float* sp = src; int n = np; bool valid = true;
    if (KIND == 0) { valid = np < Nsrc; }
    else if (KIND == 1) { n = (np >> 6) * 128 + (np & 63); }
    else if (KIND == 2) { n = (np >> 6) * 128 + 64 + (np & 63); }
    else { const int g = np >> 5, w = np & 31; sp = (w < 16) ? src : src2; n = g * 16 + (w & 15); }
    float f[8];
#pragma unroll
    for (int j = 0; j < 8; ++j) {
      const int k = kc * 8 + j;
      float v = valid ? sp[(long)k * Nsrc + n] : 0.f;
      if (gain) v *= gain[k];
      f[j] = v;
    }
    *(u32x4*)(dst + (long)np * K + kc * 8) = pack8(f);
  }
}

DI float2 cadd(float2 a, float2 b) { return make_float2(a.x + b.x, a.y + b.y); }
DI float2 csub(float2 a, float2 b) { return make_float2(a.x - b.x, a.y - b.y); }
DI float2 cmul(float2 a, float2 b) { return make_float2(a.x * b.x - a.y * b.y, a.x * b.y + a.y * b.x); }
DI float2 cmulc(float2 a, float2 b) { return make_float2(a.x * b.x + a.y * b.y, a.y * b.x - a.x * b.y); }
DI float2 cconj(float2 a) { return make_float2(a.x, -a.y); }
DI float2 twid(float rev) {
  return make_float2(__builtin_amdgcn_cosf(rev), -__builtin_amdgcn_sinf(rev));
}
DI void r4f(float2& a0, float2& a1, float2& a2, float2& a3) {
  const float2 s02 = cadd(a0, a2), d02 = csub(a0, a2), s13 = cadd(a1, a3), d13 = csub(a1, a3);
  a0 = cadd(s02, s13); a2 = csub(s02, s13);
  a1 = make_float2(d02.x + d13.y, d02.y - d13.x);
  a3 = make_float2(d02.x - d13.y, d02.y + d13.x);
}
DI void r4i(float2& a0, float2& a1, float2& a2, float2& a3) {
  const float2 s02 = cadd(a0, a2), d02 = csub(a0, a2), s13 = cadd(a1, a3), d13 = csub(a1, a3);
  a0 = cadd(s02, s13); a2 = csub(s02, s13);
  a1 = make_float2(d02.x - d13.y, d02.y + d13.x);
  a3 = make_float2(d02.x + d13.y, d02.y - d13.x);
}
#define C8 0.9238795325112867f
#define S8 0.3826834323650898f
#define R2 0.7071067811865476f
DI void fft16_fwd(float2 (&v)[16]) {
#pragma unroll
  for (int r0 = 0; r0 < 4; ++r0) r4f(v[r0], v[r0 + 4], v[r0 + 8], v[r0 + 12]);
  v[5]  = cmul(v[5],  make_float2(C8, -S8));
  v[9]  = cmul(v[9],  make_float2(R2, -R2));
  v[13] = cmul(v[13], make_float2(S8, -C8));
  v[6]  = cmul(v[6],  make_float2(R2, -R2));
  v[10] = make_float2(v[10].y, -v[10].x);
  v[14] = cmul(v[14], make_float2(-R2, -R2));
  v[7]  = cmul(v[7],  make_float2(S8, -C8));
  v[11] = cmul(v[11], make_float2(-R2, -R2));
  v[15] = cmul(v[15], make_float2(-C8, S8));
#pragma unroll
  for (int q1 = 0; q1 < 4; ++q1) r4f(v[4 * q1], v[4 * q1 + 1], v[4 * q1 + 2], v[4 * q1 + 3]);
}
DI void fft16_inv(float2 (&v)[16]) {
#pragma unroll
  for (int q1 = 0; q1 < 4; ++q1) r4i(v[4 * q1], v[4 * q1 + 1], v[4 * q1 + 2], v[4 * q1 + 3]);
  v[5]  = cmulc(v[5],  make_float2(C8, -S8));
  v[9]  = cmulc(v[9],  make_float2(R2, -R2));
  v[13] = cmulc(v[13], make_float2(S8, -C8));
  v[6]  = cmulc(v[6],  make_float2(R2, -R2));
  v[10] = make_float2(-v[10].y, v[10].x);
  v[14] = cmulc(v[14], make_float2(-R2, -R2));
  v[7]  = cmulc(v[7],  make_float2(S8, -C8));
  v[11] = cmulc(v[11], make_float2(-R2, -R2));
  v[15] = cmulc(v[15], make_float2(-C8, S8));
#pragma unroll
  for (int r0 = 0; r0 < 4; ++r0) r4i(v[r0], v[r0 + 4], v[r0 + 8], v[r0 + 12]);
}
template <int M, bool INV>
DI void fft_pass16(float2* X) {
  constexpr int S = M / 16;
  static_assert(S == 1024 || S == 64, "addressing below assumes these two sizes");
  const int tid = threadIdx.x;
#pragma unroll 1
  for (int u = 0; u < 2; ++u) {
    const int bf = tid + 512 * u;
    int j = bf % S; const int b = (bf / S) * M;
    asm volatile("" : "+v"(j));
    int pa4[4];
    if (S >= 256) { pa4[0] = b + (j ^ ((j >> 4) & 15)); pa4[1] = pa4[0]; pa4[2] = pa4[0]; pa4[3] = pa4[0]; }
    else {
      const int low = (j & 15) ^ ((j >> 4) & 3);
#pragma unroll
      for (int q = 0; q < 4; ++q) pa4[q] = b + (j & 48) + (low ^ (q << 2));
    }
    float2 v[16];
#pragma unroll
    for (int r = 0; r < 16; ++r) v[r] = X[pa4[r & 3] + r * S];
    const float2 w1 = twid((float)j * (1.0f / (float)M));
    if (!INV) {
      fft16_fwd(v);
      float2 cur = w1;
#pragma unroll
      for (int f = 1; f < 16; ++f) {
        const int slot = ((f & 3) << 2) | (f >> 2);
        v[slot] = cmul(v[slot], cur);
        cur = cmul(cur, w1);
      }
    } else {
      float2 cur = w1;
#pragma unroll
      for (int f = 1; f < 16; ++f) {
        const int slot = ((f & 3) << 2) | (f >> 2);
        v[slot] = cmulc(v[slot], cur);
        cur = cmul(cur, w1);
      }
      fft16_inv(v);
    }
#pragma unroll
    for (int r = 0; r < 16; ++r) X[pa4[r & 3] + r * S] = v[r];
  }
}
template <bool INV>
DI void fft_pass4_64(float2* X) {
  const int tid = threadIdx.x;
#pragma unroll 1
  for (int u = 0; u < 8; ++u) {
    const int bf = tid + 512 * u;
    int j = bf & 15; const int b = (bf >> 4) * 64;
    asm volatile("" : "+v"(j));
    const int xb = ((bf >> 4) & 3) << 2;
    float2* p0 = X + b + (j ^ xb); float2* p1 = X + b + 16 + (j ^ (xb | 1)); float2* p2 = X + b + 32 + (j ^ (xb | 2)); float2* p3 = X + b + 48 + (j ^ (xb | 3));
    float2 a0 = *p0, a1 = *p1, a2 = *p2, a3 = *p3;
    const float2 w1 = twid((float)j * (1.0f / 64.f));
    const float2 w2 = cmul(w1, w1), w3 = cmul(w2, w1);
    if (!INV) {
      r4f(a0, a1, a2, a3);
      a1 = cmul(a1, w1); a2 = cmul(a2, w2); a3 = cmul(a3, w3);
    } else {
      a1 = cmulc(a1, w1); a2 = cmulc(a2, w2); a3 = cmulc(a3, w3);
      r4i(a0, a1, a2, a3);
    }
    *p0 = a0; *p1 = a1; *p2 = a2; *p3 = a3;
  }
}
DI void fft_fwd_head(float2* X) {
  __syncthreads();
  fft_pass16<16384, false>(X); __syncthreads();
  fft_pass16<1024, false>(X);  __syncthreads();
  fft_pass4_64<false>(X);      __syncthreads();
}
DI void fft_inv_tail(float2* X) {
  __syncthreads();
  fft_pass4_64<true>(X);       __syncthreads();
  fft_pass16<1024, true>(X);   __syncthreads();
  fft_pass16<16384, true>(X);  __syncthreads();
}
DI int PX(int idx) { return idx ^ ((idx >> 4) & 15); }
DI int pos14(int k) {
  unsigned r = __brev((unsigned)k) >> 18;
  return (int)(((r & 0x1555u) << 1) | ((r >> 1) & 0x1555u));
}
DI void conv3_8(const u16* row, int tl, int L, float w0, float w1, float w2, float* out) {
  const u32x4 c = *(const u32x4*)(row + tl);
  float f[10];
  unpack8(c, f + 1);
  f[0] = (tl > 0) ? bf2f(row[tl - 1]) : 0.f;
  f[9] = (tl + 8 < L) ? bf2f(row[tl + 8]) : 0.f;
#pragma unroll
  for (int i = 0; i < 8; ++i) out[i] = w0 * f[i] + w1 * f[i + 1] + w2 * f[i + 2];
}


template <int I> struct IC { static constexpr int v = I; };
template <bool FIXED>
DI void attn_item(const u16* __restrict__ Q, const u16* __restrict__ Kb, const u16* __restrict__ Vt, u16* __restrict__ mix,
                  int t0, int L, int h, int qb, float M0, char* smem, int tid) {
  const int lane = tid & 63, wid = tid >> 6, l31 = lane & 31, hh = lane >> 5;
  const int tq = t0 + qb * 256 + wid * 32 + l31;
  bf16x8 qf[6];
#pragma unroll
  for (int ks = 0; ks < 6; ++ks) qf[ks] = *(const bf16x8*)(Q + (long)tq * 768 + h * 96 + ks * 16 + hh * 8);
  f32x16 o[2];
#pragma unroll
  for (int i = 0; i < 16; ++i) { o[0][i] = 0.f; o[1][i] = 0.f; }
  float m_run = FIXED ? M0 : -1e30f, l_run = 0.f;
  u32x4 rk[3], rv[2];
  const u16* gK[3]; int sK[3];
#pragma unroll
  for (int i = 0; i < 3; ++i) {
    const int id = tid + 512 * i, row = id / 12, c = id % 12;
    gK[i] = Kb + (long)(t0 + row) * 768 + h * 96 + c * 8;
    sK[i] = row * 208 + c * 16;
  }
  const u16* gV[2]; int sV[2];
#pragma unroll
  for (int i = 0; i < 2; ++i) {
    const int id = tid + 512 * i, dv = id >> 4, c = id & 15;
    gV[i] = Vt + (long)(h * 64 + dv) * T_TOK + t0 + c * 8;
    sV[i] = 26624 + dv * 264 + c * 16;
  }
  const int ntile = L >> 7;
#pragma unroll
  for (int i = 0; i < 3; ++i) rk[i] = *(const u32x4*)(gK[i]);
#pragma unroll
  for (int i = 0; i < 2; ++i) rv[i] = *(const u32x4*)(gV[i]);
#pragma unroll
  for (int i = 0; i < 3; ++i) *(u32x4*)(smem + sK[i]) = rk[i];
#pragma unroll
  for (int i = 0; i < 2; ++i) { u32x2 a, b; a[0] = rv[i][0]; a[1] = rv[i][1]; b[0] = rv[i][2]; b[1] = rv[i][3];
    *(u32x2*)(smem + sV[i]) = a; *(u32x2*)(smem + sV[i] + 8) = b; }
  __syncthreads();
#define AT_QK(S, half, k2, ks) S[k2] = __builtin_amdgcn_mfma_f32_32x32x16_bf16( \
    *(const bf16x8*)(Ks + ((half) * 64 + (k2) * 32 + l31) * 208 + ((ks) * 2 + hh) * 16), qf[ks], S[k2], 0, 0, 0)
#define AT_PV(half, k2, st, dvt, PB) do { const char* ad_ = Vs + ((dvt) * 32 + l31) * 264 + ((half) * 64 + (k2) * 32 + (st) * 16 + hh * 4) * 2; \
    const s16x4 lo_ = *(const s16x4*)(ad_); const s16x4 hi_ = *(const s16x4*)(ad_ + 16); \
    o[dvt] = __builtin_amdgcn_mfma_f32_32x32x16_bf16(__builtin_shufflevector(lo_, hi_, 0, 1, 2, 3, 4, 5, 6, 7), PB, o[dvt], 0, 0, 0); } while (0)
#define AT_PACK(S, k2, st) __builtin_bit_cast(bf16x8, (u32x4){pack2(S[k2][8 * (st) + 0], S[k2][8 * (st) + 1]), pack2(S[k2][8 * (st) + 2], S[k2][8 * (st) + 3]), \
    pack2(S[k2][8 * (st) + 4], S[k2][8 * (st) + 5]), pack2(S[k2][8 * (st) + 6], S[k2][8 * (st) + 7])})
  for (int kt = 0; kt < ntile; ++kt) {
    if (kt + 1 < ntile) {
#pragma unroll
      for (int i = 0; i < 3; ++i) rk[i] = *(const u32x4*)(gK[i] + (long)(kt + 1) * 128 * 768);
#pragma unroll
      for (int i = 0; i < 2; ++i) rv[i] = *(const u32x4*)(gV[i] + (kt + 1) * 128);
    }
    const char* Ks = smem + (kt & 1) * 43520;
    const char* Vs = Ks + 26624;
    if (FIXED) {
#define AT_D 3
#define AT_KF(half, k2, ks) (*(const bf16x8*)(Ks + ((half) * 64 + (k2) * 32 + l31) * 208 + ((ks) * 2 + hh) * 16))
#define AT_VADDR(half, step) (Vs + (((step) & 1) * 32 + l31) * 264 + ((half) * 64 + ((step) >> 2) * 32 + (((step) >> 1) & 1) * 16 + hh * 4) * 2)
#define AT_VF(half, step) __builtin_shufflevector(*(const s16x4*)(AT_VADDR(half, step)), *(const s16x4*)(AT_VADDR(half, step) + 16), 0, 1, 2, 3, 4, 5, 6, 7)
#define AT_RD(i) (((i) < 12) ? AT_KF(0, (i) & 1, (i) >> 1) : ((i) < 24) ? AT_KF(1, ((i) - 12) & 1, ((i) - 12) >> 1) : ((i) < 32) ? AT_VF(0, (i) - 24) : AT_VF(1, (i) - 32))
      f32x16 sa[2], sb[2];
      const float ninit = -M0;
#pragma unroll
      for (int i = 0; i < 16; ++i) { sa[0][i] = ninit; sa[1][i] = ninit; sb[0][i] = ninit; sb[1][i] = ninit; }
      bf16x8 fr[40];
      bf16x8 pa[2][2];
      float rsum = 0.f;
#pragma unroll
      for (int i = 0; i < AT_D; ++i) fr[i] = AT_RD(i);
      auto at_step = [&](auto ic) {
        constexpr int i = decltype(ic)::v;
        if (i + AT_D < 40) fr[(i + AT_D) % 40] = AT_RD(i + AT_D);
        if (i < 12) {
          sa[i & 1] = __builtin_amdgcn_mfma_f32_32x32x16_bf16(fr[i], qf[i >> 1], sa[i & 1], 0, 0, 0);
        } else if (i < 24) {
          const int j = i - 12;
          sb[j & 1] = __builtin_amdgcn_mfma_f32_32x32x16_bf16(fr[i], qf[j >> 1], sb[j & 1], 0, 0, 0);
#pragma unroll
          for (int e = j * 3; e < j * 3 + 3; ++e) if (e < 32) { const float pv = __builtin_amdgcn_exp2f(sa[e >> 4][e & 15]); sa[e >> 4][e & 15] = pv; rsum += pv; }
          if (j == 11) {
#pragma unroll
            for (int k2 = 0; k2 < 2; ++k2)
#pragma unroll
              for (int st = 0; st < 2; ++st) pa[k2][st] = AT_PACK(sa, k2, st);
          }
        } else if (i < 32) {
          const int j = i - 24;
          o[j & 1] = __builtin_amdgcn_mfma_f32_32x32x16_bf16(fr[i], pa[j >> 2][(j >> 1) & 1], o[j & 1], 0, 0, 0);
#pragma unroll
          for (int e = j * 4; e < j * 4 + 4; ++e) { const float pv = __builtin_amdgcn_exp2f(sb[e >> 4][e & 15]); sb[e >> 4][e & 15] = pv; rsum += pv; }
        } else {
          const int j = i - 32;
          if (j == 0) {
#pragma unroll
            for (int k2 = 0; k2 < 2; ++k2)
#pragma unroll
              for (int st = 0; st < 2; ++st) pa[k2][st] = AT_PACK(sb, k2, st);
          }
          o[j & 1] = __builtin_amdgcn_mfma_f32_32x32x16_bf16(fr[i], pa[j >> 2][(j >> 1) & 1], o[j & 1], 0, 0, 0);
        }
#ifdef AT_PIN
        __builtin_amdgcn_sched_barrier(0);
#endif
      };
#define AT_S4(b) at_step(IC<(b)>{}); at_step(IC<(b) + 1>{}); at_step(IC<(b) + 2>{}); at_step(IC<(b) + 3>{});
      AT_S4(0) AT_S4(4) AT_S4(8) AT_S4(12) AT_S4(16) AT_S4(20) AT_S4(24) AT_S4(28) AT_S4(32) AT_S4(36)
#undef AT_S4
      l_run += rsum;
#undef AT_D
#undef AT_KF
#undef AT_VADDR
#undef AT_VF
#undef AT_RD
    } else {
#pragma unroll
      for (int half = 0; half < 2; ++half) {
        f32x16 s[2];
#pragma unroll
        for (int i = 0; i < 16; ++i) { s[0][i] = 0.f; s[1][i] = 0.f; }
#pragma unroll
        for (int ks = 0; ks < 6; ++ks) { AT_QK(s, half, 0, ks); AT_QK(s, half, 1, ks); }
        float mloc = s[0][0];
#pragma unroll
        for (int i = 1; i < 16; ++i) mloc = fmaxf(mloc, s[0][i]);
#pragma unroll
        for (int i = 0; i < 16; ++i) mloc = fmaxf(mloc, s[1][i]);
        mloc = fmaxf(mloc, __shfl_xor(mloc, 32));
        const bool need = mloc > m_run + 8.f;
        if (__builtin_amdgcn_ballot_w64(need) != 0ull) {
          const float mnew = need ? mloc : m_run;
          const float alpha = __builtin_amdgcn_exp2f(m_run - mnew);
          m_run = mnew;
          l_run *= alpha;
#pragma unroll
          for (int i = 0; i < 16; ++i) { o[0][i] *= alpha; o[1][i] *= alpha; }
        }
        float rsum = 0.f;
#pragma unroll
        for (int k2 = 0; k2 < 2; ++k2)
#pragma unroll
          for (int i = 0; i < 16; ++i) { const float pv = __builtin_amdgcn_exp2f(s[k2][i] - m_run); s[k2][i] = pv; rsum += pv; }
        l_run += rsum;
#pragma unroll
        for (int k2 = 0; k2 < 2; ++k2)
#pragma unroll
          for (int st = 0; st < 2; ++st) {
            const bf16x8 pb = AT_PACK(s, k2, st);
            AT_PV(half, k2, st, 0, pb);
            AT_PV(half, k2, st, 1, pb);
          }
      }
    }
    if (kt + 1 < ntile) {
      char* d = smem + ((kt + 1) & 1) * 43520;
#pragma unroll
      for (int i = 0; i < 3; ++i) *(u32x4*)(d + sK[i]) = rk[i];
#pragma unroll
      for (int i = 0; i < 2; ++i) { u32x2 a, b; a[0] = rv[i][0]; a[1] = rv[i][1]; b[0] = rv[i][2]; b[1] = rv[i][3];
        *(u32x2*)(d + sV[i]) = a; *(u32x2*)(d + sV[i] + 8) = b; }
    }
    __syncthreads();
  }
#undef AT_QK
#undef AT_PV
#undef AT_PACK
  const float ltot = l_run + __shfl_xor(l_run, 32);
  const float inv = 1.f / ltot;
#pragma unroll
  for (int dvt = 0; dvt < 2; ++dvt)
#pragma unroll
    for (int g = 0; g < 4; ++g) {
      u32x2 w;
      w[0] = pack2(o[dvt][4 * g] * inv, o[dvt][4 * g + 1] * inv);
      w[1] = pack2(o[dvt][4 * g + 2] * inv, o[dvt][4 * g + 3] * inv);
      *(u32x2*)(mix + (long)tq * 1024 + 512 + h * 64 + dvt * 32 + 8 * g + 4 * hh) = w;
    }
}

DI void grid_bar(unsigned* bw, unsigned& epoch, unsigned G) {
  asm volatile("s_waitcnt vmcnt(0)" ::: "memory");
  __syncthreads();
  if (threadIdx.x == 0) {
    __builtin_amdgcn_fence(__ATOMIC_RELEASE, "agent");
    asm volatile("s_waitcnt vmcnt(0)" ::: "memory");
    epoch += 1u;
    const unsigned g = blockIdx.x & 7u, ng = (G + 7u - g) >> 3;
    const unsigned old = __hip_atomic_fetch_add(bw + 64 * g, 1u, __ATOMIC_RELAXED, __HIP_MEMORY_SCOPE_AGENT);
    if (old + 1u == ng * epoch) {
      const unsigned ngrp = G < 8u ? G : 8u;
      const unsigned t = __hip_atomic_fetch_add(bw + 64 * 8, 1u, __ATOMIC_RELAXED, __HIP_MEMORY_SCOPE_AGENT);
      if (t + 1u == ngrp * epoch) __hip_atomic_store(bw + 64 * 9, epoch, __ATOMIC_RELAXED, __HIP_MEMORY_SCOPE_AGENT);
    }
    unsigned spins = 0;
    while (__hip_atomic_load(bw + 64 * 9, __ATOMIC_RELAXED, __HIP_MEMORY_SCOPE_AGENT) < epoch) {
      __builtin_amdgcn_s_sleep(1);
      if (++spins > (1u << 24)) break;
    }
    __builtin_amdgcn_fence(__ATOMIC_ACQUIRE, "agent");
    asm volatile("s_waitcnt vmcnt(0)" ::: "memory");
  }
  __syncthreads();
}


__global__ void __launch_bounds__(NTHR) __attribute__((target("no-packed-fp32-ops"))) fwd_kernel(Params p) {
  __shared__ __attribute__((aligned(16))) char smem[163840];
  cg::grid_group grid = cg::this_grid();
  const int G = gridDim.x, bid = blockIdx.x;
  const int vb = (bid & 7) * (G >> 3) + (bid >> 3);
  const int NW = G * 8;
  const long GT = (long)G * NTHR;
#define PHASE_IDS int tid = threadIdx.x; asm volatile("" : "+v"(tid)); const int lane = tid & 63, wid = tid >> 6; \
  const int gw = bid * 8 + wid; const long gtid = (long)bid * NTHR + tid; (void)lane; (void)gw; (void)gtid;
  char* ws = p.ws;
  char* dsc = (char*)p.out;
  float* rowss = (float*)(ws + SM_ROWSS);
  u16* XB = (u16*)(ws + OFF_XB);
  unsigned* barcnt = (unsigned*)ws;
  unsigned bar_target = 0;
  if (p.ws == nullptr) grid.sync();
  PG8_LAS unsigned char* lds = (PG8_LAS unsigned char*)smem;

  if (PHM & (1 << 0)) {
    PHASE_IDS
    {
#define CW_LIST(X) \
      X(0, p.in[7], p.in[7], 1952, 1024, 2048, W0_IN, p.in[2], 0) \
      X(1, p.in[11], p.in[11], 768, 256, 768, W0_Q, p.in[2], 4) \
      X(2, p.in[12], p.in[12], 1024, 128, 512, W0_K, p.in[2], 5) \
      X(3, p.in[12], p.in[12], 1024, 128, 512, W0_V, p.in[2], 6) \
      X(4, p.in[15], p.in[15], 1024, 1024, 1024, W0_OUT, p.in[2], 4) \
      X(5, p.in[4], p.in[5], 2816, 1024, 5632, W0_GU, p.in[3], 3) \
      X(6, p.in[6], p.in[6], 1024, 2816, 1024, W0_D, p.in[2], 4) \
      X(7, p.in[16], p.in[16], 3072, 1024, 3072, W1_CIN, (p.in[2] + 1024), 0) \
      X(8, p.in[27], p.in[27], 1024, 1024, 1024, W1_COUT, p.in[2], 4) \
      X(9, p.in[25], p.in[25], 2048, 64, 2048, W1_W4, p.in[2], 4) \
      X(10, (p.in[4] + 1024 * 2816), (p.in[5] + 1024 * 2816), 2816, 1024, 5632, W1_GU, (p.in[3] + 1024), 3) \
      X(11, (p.in[6] + 2816 * 1024), (p.in[6] + 2816 * 1024), 1024, 2816, 1024, W1_D, p.in[2], 4)
      int total = 0;
#define CW_CNT(i, s1, s2, ns, k, np, off, g, kind) const int cw_start##i = total; total += (np) * ((k) >> 3);
      CW_LIST(CW_CNT)
#undef CW_CNT
#pragma unroll 4
      for (int it = (int)gtid; it < total; it += (int)GT) {
        const float* s1 = nullptr; const float* s2 = nullptr; const float* gp = nullptr; u16* dst = nullptr;
        int Nsrc = 0, K = 0, Np = 1, kind = 0, st = 0;
#define CW_SEL(i, a1, a2, ns, k, np, off, g, kd) if (it >= cw_start##i) { s1 = a1; s2 = a2; gp = g; dst = (u16*)(ws + off); Nsrc = ns; K = k; Np = np; kind = kd; st = cw_start##i; }
        CW_LIST(CW_SEL)
#undef CW_SEL
        const int li = it - st;
        const int np = li % Np, kc = li / Np;
        const float* sp = s1; int n = np; bool valid = true;
        if (kind == 0) valid = np < Nsrc;
        else if (kind == 5) n = (np >> 6) * 128 + (np & 63);
        else if (kind == 6) n = (np >> 6) * 128 + 64 + (np & 63);
        else if (kind == 3) { const int g = np >> 5, w = np & 31; sp = (w < 16) ? s1 : s2; n = g * 16 + (w & 15); }
        const bool hasg = (kind == 0) || (kind == 3);
        float f[8];
#pragma unroll
        for (int j = 0; j < 8; ++j) {
          const int k = kc * 8 + j;
          float v = valid ? __builtin_nontemporal_load(sp + (long)k * Nsrc + n) : 0.f;
          const float gv = hasg ? gp[k] : 1.f;
          f[j] = v * gv;
        }
        *(u32x4*)(dst + (long)np * K + kc * 8) = pack8(f);
      }
#undef CW_LIST
    }
    for (int row0 = gw * 4; row0 < T_TOK; row0 += NW * 4) {
      float4 va[4][4];
#pragma unroll
      for (int r = 0; r < 4; ++r) {
        const int row = row0 + r;
        const float* xr = (row < 16384) ? (p.in[0] + (long)row * DM) : (p.in[1] + (long)(row - 16384) * DM);
#pragma unroll
        for (int hb = 0; hb < 2; ++hb) {
          const f32x4 q0 = __builtin_nontemporal_load((const f32x4*)(xr + hb * 512 + lane * 8));
          const f32x4 q1 = __builtin_nontemporal_load((const f32x4*)(xr + hb * 512 + lane * 8 + 4));
          va[r][2 * hb] = make_float4(q0[0], q0[1], q0[2], q0[3]); va[r][2 * hb + 1] = make_float4(q1[0], q1[1], q1[2], q1[3]);
        }
      }
#pragma unroll
      for (int r = 0; r < 4; ++r) {
        const int row = row0 + r;
        float ss = 0.f;
#pragma unroll
        for (int hb = 0; hb < 2; ++hb) {
          const float4 a = va[r][2 * hb], b = va[r][2 * hb + 1];
          ss += a.x * a.x + a.y * a.y + a.z * a.z + a.w * a.w + b.x * b.x + b.y * b.y + b.z * b.z + b.w * b.w;
          u32x4 o; o[0] = pack2(a.x, a.y); o[1] = pack2(a.z, a.w); o[2] = pack2(b.x, b.y); o[3] = pack2(b.z, b.w);
          *(u32x4*)(XB + (long)row * DM + hb * 512 + lane * 8) = o;
        }
        ss = wave_sum(ss);
        if (lane == 0) rowss[row] = ss;
      }
    }
    for (long i = gtid; i < 3 * T_TOK; i += GT) rowss[T_TOK + i] = 0.f;
    float2* rope = (float2*)(ws + R_ROPE);
    for (long e = gtid; e < 16384 * 16; e += GT) {
      const int pos = (int)(e >> 4), i = (int)(e & 15);
      const int lo = i & 3, hi = i >> 2;
      const double base = (lo == 0) ? 1.0 : (lo == 1) ? 0.5623413251903491 : (lo == 2) ? 0.31622776601683794 : 0.1778279410038923;
      const double sc = (hi == 0) ? 1.0 : (hi == 1) ? 0.1 : (hi == 2) ? 0.01 : 0.001;
      double rev = (double)pos * (base * sc) * 0.15915494309189535;
      rev -= floor(rev);
      const float rf = (float)rev;
      rope[e] = make_float2(__builtin_amdgcn_cosf(rf), __builtin_amdgcn_sinf(rf));
    }

    {
      const float* w1 = p.in[18]; const float* b1 = p.in[19];
      const float* w2 = p.in[20]; const float* b2 = p.in[21];
      const float* w3 = p.in[22]; const float* b3 = p.in[23];
      const float* fq = p.in[24];
      const float INV2PI = 0.15915494309189535f;
      float w1c[33], w2c[64], w3c[64];
#pragma unroll
      for (int k = 0; k < 33; ++k) w1c[k] = w1[k * 64 + lane];
#pragma unroll
      for (int k = 0; k < 64; ++k) { w2c[k] = w2[k * 64 + lane]; w3c[k] = w3[k * 64 + lane]; }
      const float bb1 = b1[lane], bb2 = b2[lane], bb3 = b3[lane];
      const float f1 = fq[lane] * INV2PI, f2 = fq[64 + lane] * INV2PI, f3 = fq[128 + lane] * INV2PI;
#pragma unroll 1
      for (int rg = 0; rg < 3; ++rg) {
        const int rbase = gw * 12 + rg * 4;
        if (rbase < 24576) {
          float zr[4], acc[4];
#pragma unroll
          for (int r = 0; r < 4; ++r) {
            const int rr = rbase + r;
            const int Lf = (rr < 8192) ? 8192 : 16384;
            const int l = (rr < 8192) ? rr : (rr - 8192);
            const float tpos = (float)l / (float)(Lf - 1);
            const float frac = (float)l / (float)Lf;
            const int bi = (lane >= 17) ? (lane - 17) : (lane - 1);
            const float band = 1e-4f + (float)bi * ((15.f - 1e-4f) / 15.f);
            const float rev = frac * band;
            zr[r] = (lane == 0) ? tpos : ((lane <= 16) ? __builtin_amdgcn_cosf(rev) : -__builtin_amdgcn_sinf(rev));
            acc[r] = bb1;
          }
#pragma unroll
          for (int k = 0; k < 33; ++k)
#pragma unroll
            for (int r = 0; r < 4; ++r) acc[r] += __int_as_float(__builtin_amdgcn_readlane(__float_as_int(zr[r]), k)) * w1c[k];
#pragma unroll
          for (int r = 0; r < 4; ++r) { zr[r] = __builtin_amdgcn_sinf(f1 * acc[r]); acc[r] = bb2; }
#pragma unroll
          for (int k = 0; k < 64; ++k)
#pragma unroll
            for (int r = 0; r < 4; ++r) acc[r] += __int_as_float(__builtin_amdgcn_readlane(__float_as_int(zr[r]), k)) * w2c[k];
#pragma unroll
          for (int r = 0; r < 4; ++r) { zr[r] = __builtin_amdgcn_sinf(f2 * acc[r]); acc[r] = bb3; }
#pragma unroll
          for (int k = 0; k < 64; ++k)
#pragma unroll
            for (int r = 0; r < 4; ++r) acc[r] += __int_as_float(__builtin_amdgcn_readlane(__float_as_int(zr[r]), k)) * w3c[k];
          u16* z3 = (u16*)(ws + SM_Z3);
#pragma unroll
          for (int r = 0; r < 4; ++r) z3[(long)(rbase + r) * 64 + lane] = f2bf(__builtin_amdgcn_sinf(f3 * acc[r]));
        }
      }
    }
  }
  grid_bar(barcnt, bar_target, (unsigned)G);

  for (int rep = 0; rep < REP1; ++rep) if (PHM & (1 << 1)) {
    pg8::Gemm g{XB, (const u16*)(ws + W0_IN), T_TOK, 2048, DM};
    pg8::StaticOrder S; S.init(T_TOK, 2048, G, bid);
    EpiRowScaleBf16 E{(u16*)dsc, 2048, rowss};
    pg8::gemm_phase<EpiRowScaleBf16, pg8::StaticOrder>(lds, g, S, E, nullptr);
  }
  grid_bar(barcnt, bar_target, (unsigned)G);

  if (PHM & (1 << 2)) {
    PHASE_IDS
    const u16* proj = (const u16*)dsc;
    u16* mix = (u16*)(ws + R_MIX);
    u16* cqn = (u16*)(ws + R_CQN);
    u16* ckvn = (u16*)(ws + R_CKVN);
    u16* kpe = (u16*)(ws + R_KPE);
    float* sskpe = (float*)(ws + SM_SSKPE);
    const float* cw = p.in[8];
    float w0[8], w1[8], w2[8];
#pragma unroll
    for (int i = 0; i < 8; ++i) { w0[i] = cw[(lane * 8 + i) * 3]; w1[i] = cw[(lane * 8 + i) * 3 + 1]; w2[i] = cw[(lane * 8 + i) * 3 + 2]; }
    float gq[4], gk[2];
#pragma unroll
    for (int i = 0; i < 4; ++i) gq[i] = p.in[9][lane * 4 + i];
    gk[0] = p.in[10][lane * 2]; gk[1] = p.in[10][lane * 2 + 1];
    for (int t = gw; t < T_TOK; t += NW) {
      int t0, L; seq_of(t, t0, L);
      const u16* pr = proj + (long)t * 2048;
      const int c = lane * 8;
      float gb[8], mc[8], mp[8], mn[8], a[8], b[8];
      unpack8(*(const u32x4*)(pr + c), gb);
      unpack8(*(const u32x4*)(pr + 512 + c), a); unpack8(*(const u32x4*)(pr + 1024 + c), b);
#pragma unroll
      for (int i = 0; i < 8; ++i) mc[i] = a[i] * b[i];
      if (t > t0) {
        unpack8(*(const u32x4*)(pr - 2048 + 512 + c), a); unpack8(*(const u32x4*)(pr - 2048 + 1024 + c), b);
#pragma unroll
        for (int i = 0; i < 8; ++i) mp[i] = a[i] * b[i];
      } else {
#pragma unroll
        for (int i = 0; i < 8; ++i) mp[i] = 0.f;
      }
      if (t < t0 + L - 1) {
        unpack8(*(const u32x4*)(pr + 2048 + 512 + c), a); unpack8(*(const u32x4*)(pr + 2048 + 1024 + c), b);
#pragma unroll
        for (int i = 0; i < 8; ++i) mn[i] = a[i] * b[i];
      } else {
#pragma unroll
        for (int i = 0; i < 8; ++i) mn[i] = 0.f;
      }
      float y[8];
#pragma unroll
      for (int i = 0; i < 8; ++i) y[i] = gb[i] * (w0[i] * mp[i] + w1[i] * mc[i] + w2[i] * mn[i]);
      *(u32x4*)(mix + (long)t * 1024 + c) = pack8(y);
      {
        const u32x2 v = *(const u32x2*)(pr + 1536 + lane * 4);
        float f0 = lo_bf(v[0]), f1 = hi_bf(v[0]), f2 = lo_bf(v[1]), f3 = hi_bf(v[1]);
        const float ss = wave_sum(f0 * f0 + f1 * f1 + f2 * f2 + f3 * f3);
        const float rs = rsqrtf(ss * (1.f / 256.f) + EPSN);
        u32x2 o; o[0] = pack2(f0 * rs * gq[0], f1 * rs * gq[1]); o[1] = pack2(f2 * rs * gq[2], f3 * rs * gq[3]);
        *(u32x2*)(cqn + (long)t * 256 + lane * 4) = o;
      }
      {
        const unsigned v = *(const unsigned*)(pr + 1792 + lane * 2);
        float f0 = lo_bf(v), f1 = hi_bf(v);
        const float ss = wave_sum(f0 * f0 + f1 * f1);
        const float rs = rsqrtf(ss * (1.f / 128.f) + EPSN);
        *(unsigned*)(ckvn + (long)t * 128 + lane * 2) = pack2(f0 * rs * gk[0], f1 * rs * gk[1]);
      }
      {
        const unsigned v = (lane < 16) ? *(const unsigned*)(pr + 1920 + lane * 2) : 0u;
        if (lane < 16) *(unsigned*)(kpe + (long)t * 32 + lane * 2) = v;
        const float f0 = lo_bf(v), f1 = hi_bf(v);
        const float ss = wave_sum(f0 * f0 + f1 * f1);
        if (lane == 0) sskpe[t] = ss;
      }
    }
  }
  grid_bar(barcnt, bar_target, (unsigned)G);

  if (PHM & (1 << 3)) {
    PHASE_IDS
    const u16* cqn = (const u16*)(ws + R_CQN);
    const u16* ckvn = (const u16*)(ws + R_CKVN);
    const u16* kpe = (const u16*)(ws + R_KPE);
    const float* sskpe = (const float*)(ws + SM_SSKPE);
    const float2* rope = (const float2*)(ws + R_ROPE);
    u16* Qo = (u16*)(dsc + D_QRAW);
    u16* Kb = (u16*)(ws + R_K);
    u16* Vt = (u16*)(dsc + D_VT);
    const float* qn = p.in[13]; const float* kn = p.in[14];
    const float qscale = 0.10206207261596577f * 1.4426950408889634f;
    for (int tile = vb; tile < 512 + 512 + 512; tile += G) {
      if (tile < 512) {
        const int tm = tile >> 2, tn = tile & 3;
        gemm_tile<6>(cqn + (long)tm * 256 * 256, 256, (const u16*)(ws + W0_Q) + (long)tn * 192 * 256, 256, 256, smem,
          [&](f32x4 (&acc)[4][6], int r0, int c0) {
            const int fr_ = c0 % 96, h = tn * 2 + c0 / 96;
#pragma unroll
            for (int mi = 0; mi < 4; ++mi)
#pragma unroll
              for (int j = 0; j < 4; ++j) {
                const int row = tm * 256 + r0 + mi * 16 + j;
                float ss = 0.f;
#pragma unroll
                for (int ni = 0; ni < 6; ++ni) ss += acc[mi][ni][j] * acc[mi][ni][j];
                ss += __shfl_xor(ss, 8); ss += __shfl_xor(ss, 4); ss += __shfl_xor(ss, 2); ss += __shfl_xor(ss, 1);
                const float rs = rsqrtf(ss * (1.f / 96.f) + EPSN) * qscale;
                int t0, L; seq_of(row, t0, L);
                const float2 cs = rope[(long)(row - t0) * 16 + fr_];
                u16* qp = Qo + (long)row * 768 + h * 96 + fr_;
#pragma unroll
                for (int ni = 0; ni < 4; ++ni) qp[ni * 16] = f2bf(acc[mi][ni][j] * rs * qn[ni * 16 + fr_]);
                const float x1 = acc[mi][4][j] * rs * qn[64 + fr_], x2 = acc[mi][5][j] * rs * qn[80 + fr_];
                qp[64] = f2bf(x1 * cs.x - x2 * cs.y);
                qp[80] = f2bf(x1 * cs.y + x2 * cs.x);
              }
          });
      } else if (tile < 1024) {
        const int tt = tile - 512, tm = tt >> 2, tn = tt & 3;
        gemm_tile<4>(ckvn + (long)tm * 256 * 128, 128, (const u16*)(ws + W0_K) + (long)tn * 128 * 128, 128, 128, smem,
          [&](f32x4 (&acc)[4][4], int r0, int c0) {
            const int fr_ = c0 & 63, h = tn * 2 + (c0 >> 6);
#pragma unroll
            for (int mi = 0; mi < 4; ++mi)
#pragma unroll
              for (int j = 0; j < 4; ++j) {
                const int row = tm * 256 + r0 + mi * 16 + j;
                float ss = 0.f;
#pragma unroll
                for (int ni = 0; ni < 4; ++ni) ss += acc[mi][ni][j] * acc[mi][ni][j];
                ss += __shfl_xor(ss, 8); ss += __shfl_xor(ss, 4); ss += __shfl_xor(ss, 2); ss += __shfl_xor(ss, 1);
                const float rs = rsqrtf((ss + sskpe[row]) * (1.f / 96.f) + EPSN);
                int t0, L; seq_of(row, t0, L);
                const float2 cs = rope[(long)(row - t0) * 16 + fr_];
                u16* kp = Kb + (long)row * 768 + h * 96 + fr_;
#pragma unroll
                for (int ni = 0; ni < 4; ++ni) kp[ni * 16] = f2bf(acc[mi][ni][j] * rs * kn[ni * 16 + fr_]);
                const float x1 = bf2f(kpe[(long)row * 32 + fr_]) * rs * kn[64 + fr_], x2 = bf2f(kpe[(long)row * 32 + 16 + fr_]) * rs * kn[80 + fr_];
                kp[64] = f2bf(x1 * cs.x - x2 * cs.y);
                kp[80] = f2bf(x1 * cs.y + x2 * cs.x);
              }
          });
      } else {
        const int tt = tile - 1024, tm = tt & 1, tn = tt >> 1;
        gemm_tile<4>((const u16*)(ws + W0_V) + (long)tm * 256 * 128, 128, ckvn + (long)tn * 128 * 128, 128, 128, smem,
          [&](f32x4 (&acc)[4][4], int r0, int c0) {
#pragma unroll
            for (int mi = 0; mi < 4; ++mi)
#pragma unroll
              for (int j = 0; j < 4; ++j)
#pragma unroll
                for (int ni = 0; ni < 4; ++ni)
                  Vt[(long)(tm * 256 + r0 + mi * 16 + j) * T_TOK + tn * 128 + c0 + ni * 16] = f2bf(acc[mi][ni][j]);
          });
      }
    }
  }
  grid_bar(barcnt, bar_target, (unsigned)G);

  for (int rep = 0; rep < REP5; ++rep) if (PHM & (1 << 5)) {
    PHASE_IDS
    const u16* Q = (const u16*)(dsc + D_QRAW);
    const u16* Kb = (const u16*)(ws + R_K);
    const u16* Vt = (const u16*)(dsc + D_VT);
    u16* mix = (u16*)(ws + R_MIX);
    float mq = 0.f, mk = 0.f;
    for (int i = 0; i < 96; ++i) { mq = fmaxf(mq, fabsf(p.in[13][i])); mk = fmaxf(mk, fabsf(p.in[14][i])); }
    const float M0 = 96.f * mq * mk * (0.10206207261596577f * 1.4426950408889634f) * 1.02f + 0.5f;
    const bool fixed_ref = M0 < 40.f;
    for (int item = vb; item < 1024; item += G) {
      int t0, L, h, qb;
      if (item < 512) { t0 = 16384; L = 16384; h = item >> 6; qb = item & 63; }
      else { const int it = item - 512; const int sq = it >> 8; t0 = sq * 8192; L = 8192; h = (it >> 5) & 7; qb = it & 31; }
      if (fixed_ref) attn_item<true>(Q, Kb, Vt, mix, t0, L, h, qb, M0, smem, tid);
      else attn_item<false>(Q, Kb, Vt, mix, t0, L, h, qb, M0, smem, tid);
    }
  }
  grid_bar(barcnt, bar_target, (unsigned)G);

  if (PHM & (1 << 6)) {
    pg8::Gemm g{(const u16*)(ws + R_MIX), (const u16*)(ws + W0_OUT), T_TOK, DM, DM};
    pg8::StaticOrder S; S.init(T_TOK, DM, G, bid);
    EpiResid E{XB, rowss + T_TOK};
    pg8::gemm_phase<EpiResid, pg8::StaticOrder>(lds, g, S, E, nullptr);
  }
  grid_bar(barcnt, bar_target, (unsigned)G);
  for (int rep = 0; rep < REP7; ++rep) if (PHM & (1 << 7)) {
    pg8::Gemm g{XB, (const u16*)(ws + W0_GU), T_TOK, 5632, DM};
    pg8::StaticOrder S; S.init(T_TOK, 5632, G, bid);
    EpiGU E{(u16*)(ws + OFF_R), (u16*)dsc, 16384, rowss + T_TOK, 0};
    pg8::gemm_phase<EpiGU, pg8::StaticOrder>(lds, g, S, E, nullptr);
  }
  grid_bar(barcnt, bar_target, (unsigned)G);
  if (PHM & (1 << 7)) {
    pg8::Gemm g{(const u16*)(ws + OFF_R), (const u16*)(ws + W0_D), T_TOK, DM, DFF};
    SplitOrder S; S.init(T_TOK, DM, G, bid); S.base2 = (const char*)dsc; S.split = 64;
    EpiResid E{XB, rowss + 2 * T_TOK};
    pg8::gemm_phase<EpiResid, SplitOrder>(lds, g, S, E, nullptr);
  }
  grid_bar(barcnt, bar_target, (unsigned)G);

  for (int rep = 0; rep < REP8; ++rep) if (PHM & (1 << 8)) {
    const u16* Wt = (const u16*)(ws + W1_CIN);
    u16* x0t = (u16*)(ws + C_X0T);
    u16* x1vt = (u16*)dsc;
    const float* ssq = rowss + 2 * T_TOK;
    {
      pg8::Gemm g{Wt, XB, 3072, T_TOK, DM};
      pg8::StaticOrder S; S.init(3072, T_TOK, G, bid);
      EpiCin E{x0t, x1vt, ssq};
      pg8::gemm_phase<EpiCin, pg8::StaticOrder>(lds, g, S, E, nullptr);
    }
    for (int tile = 3072 + vb; tile < 3072 + 1536; tile += G) {
      {
        const int tt = tile - 3072;
        const bool smp = tt >= 512;
        const int t2 = smp ? tt - 512 : tt;
        const int tm = t2 & 7, tn = t2 >> 3;
        const int Lf = smp ? 16384 : 8192;
        const u16* z3 = (const u16*)(ws + SM_Z3) + (smp ? (long)8192 * 64 : 0);
        u16* kern = smp ? (u16*)(ws + C_KS) : (u16*)(ws + C_KP);
        gemm_tile((const u16*)(ws + W1_W4) + (long)tm * 256 * 64, 64, z3 + (long)tn * 128 * 64, 64, 64, smem,
          [&](f32x4 (&acc)[4][4], int r0, int c0) {
            const float invLm1 = 1.f / (float)(Lf - 1);
#pragma unroll
            for (int mi = 0; mi < 4; ++mi)
#pragma unroll
              for (int j = 0; j < 4; ++j) {
                const int cp = tm * 256 + r0 + mi * 16 + j;
                const int ch = cp & 1023;
                const bool bwd = cp >= 1024;
                const float ad = 3.0701134573253945f + (float)ch * (12.280453829301578f / 1023.f);
                u16* kr = kern + (long)ch * (2 * Lf);
#pragma unroll
                for (int ni = 0; ni < 4; ++ni) {
                  const int l = tn * 128 + c0 + ni * 16;
                  const float wv = __expf(-(float)l * invLm1 * ad);
                  const float val = acc[mi][ni][j] * wv;
                  if (!bwd) kr[l] = f2bf(val);
                  else if (l > 0) kr[2 * Lf - l] = f2bf(val);
                  else kr[Lf] = 0;
                }
              }
          });
      }
    }
  }
  grid_bar(barcnt, bar_target, (unsigned)G);

  if (PHM & (1 << 9)) {
    PHASE_IDS
    float2* X = (float2*)smem;
    u16* zs = (u16*)(smem + 131072);
    const u16* x0t = (const u16*)(ws + C_X0T);
    u16* x1vt = (u16*)dsc;
    const float* sw = p.in[17];
    const float SCL = 1.f / 16384.f;
    for (int job = vb; job < 2048; job += G) {
      int tidj = threadIdx.x; asm volatile("" : "+v"(tidj));
      const int tid = tidj;
      const bool smp = job >= 1024;
      const int ch = job & 1023;
      const float w00 = sw[ch * 3], w01 = sw[ch * 3 + 1], w02 = sw[ch * 3 + 2];
      const float w10 = sw[(1024 + ch) * 3], w11 = sw[(1024 + ch) * 3 + 1], w12 = sw[(1024 + ch) * 3 + 2];
      const float w20 = sw[(2048 + ch) * 3], w21 = sw[(2048 + ch) * 3 + 1], w22 = sw[(2048 + ch) * 3 + 2];
      const float bias = p.in[26][ch];
      u16* x1row = x1vt + (long)ch * T_TOK;
      const u16* vrow = x1vt + (long)(1024 + ch) * T_TOK;
      const u16* x0row = x0t + (long)ch * T_TOK;
      __syncthreads();
      if (!smp && (FFTP & 1)) {
        const u16* kr = (const u16*)(ws + C_KP) + (long)ch * 16384;
#pragma unroll
        for (int u = 0; u < 4; ++u) {
          const int n = 8 * (tid + 512 * u);
          float f[8]; unpack8(*(const u32x4*)(kr + n), f);
#pragma unroll
          for (int i = 0; i < 8; ++i) X[PX(n + i)] = make_float2(f[i], 0.f);
        }
        fft_fwd_head(X);
        unsigned Kf[2][16];
#pragma unroll
        for (int u = 0; u < 2; ++u) {
          const int g = tid + 512 * u;
          float2 v[16];
#pragma unroll
          for (int r = 0; r < 16; ++r) v[r] = X[16 * g + (r ^ (g & 15))];
          fft16_fwd(v);
#pragma unroll
          for (int r = 0; r < 16; ++r) Kf[u][r] = pack2(v[r].x, v[r].y);
          asm volatile("" ::: "memory");
        }
        __syncthreads();
#pragma unroll 1
        for (int u = 0; u < 2; ++u) {
          const int n = 8 * (tid + 512 * u);
          float z0[8], z1[8];
          {
            float a[8], c[8];
            conv3_8(x1row, n, 8192, w10, w11, w12, a);
            conv3_8(vrow, n, 8192, w20, w21, w22, c);
#pragma unroll
            for (int i = 0; i < 8; ++i) z0[i] = a[i] * c[i];
            conv3_8(x1row + 8192, n, 8192, w10, w11, w12, a);
            conv3_8(vrow + 8192, n, 8192, w20, w21, w22, c);
#pragma unroll
            for (int i = 0; i < 8; ++i) z1[i] = a[i] * c[i];
          }
          *(u32x4*)(zs + n) = pack8(z0);
          *(u32x4*)(zs + 8192 + n) = pack8(z1);
#pragma unroll
          for (int i = 0; i < 8; ++i) { X[PX(n + i)] = make_float2(z0[i], z1[i]); X[PX(8192 + n + i)] = make_float2(0.f, 0.f); }
        }
        fft_fwd_head(X);
#pragma unroll
        for (int u = 0; u < 2; ++u) {
          const int g = tid + 512 * u;
          float2 v[16];
#pragma unroll
          for (int r = 0; r < 16; ++r) v[r] = X[16 * g + (r ^ (g & 15))];
          fft16_fwd(v);
#pragma unroll
          for (int r = 0; r < 16; ++r) v[r] = cmul(v[r], make_float2(lo_bf(Kf[u][r]), hi_bf(Kf[u][r])));
          fft16_inv(v);
#pragma unroll
          for (int r = 0; r < 16; ++r) X[16 * g + (r ^ (g & 15))] = v[r];
          asm volatile("" ::: "memory");
        }
        fft_inv_tail(X);
#pragma unroll 1
        for (int u = 0; u < 2; ++u) {
          const int n = 8 * (tid + 512 * u);
          float yr[8], yi[8], z0[8], z1[8];
          unpack8(*(const u32x4*)(zs + n), z0);
          unpack8(*(const u32x4*)(zs + 8192 + n), z1);
#pragma unroll
          for (int i = 0; i < 8; ++i) { const float2 xv = X[PX(n + i)]; yr[i] = xv.x * SCL + bias * z0[i]; yi[i] = xv.y * SCL + bias * z1[i]; }
          float g0[8];
          conv3_8(x0row, n, 8192, w00, w01, w02, g0);
#pragma unroll
          for (int i = 0; i < 8; ++i) yr[i] *= g0[i];
          conv3_8(x0row + 8192, n, 8192, w00, w01, w02, g0);
#pragma unroll
          for (int i = 0; i < 8; ++i) yi[i] *= g0[i];
          *(u32x4*)(x1row + n) = pack8(yr);
          *(u32x4*)(x1row + 8192 + n) = pack8(yi);
        }
      } else if (smp && (FFTP & 2)) {
        const u16* kr = (const u16*)(ws + C_KS) + (long)ch * 32768;
#pragma unroll
        for (int u = 0; u < 8; ++u) {
          const int n = 4 * (tid + 512 * u);
          float f[8]; unpack8(*(const u32x4*)(kr + 2 * n), f);
#pragma unroll
          for (int i = 0; i < 4; ++i) X[PX(n + i)] = make_float2(f[2 * i], f[2 * i + 1]);
        }
        fft_fwd_head(X);
#pragma unroll 1
        for (int u = 0; u < 2; ++u) {
          const int g = tid + 512 * u;
          float2 v[16];
#pragma unroll
          for (int r = 0; r < 16; ++r) v[r] = X[16 * g + (r ^ (g & 15))];
          fft16_fwd(v);
#pragma unroll
          for (int r = 0; r < 16; ++r) X[16 * g + (r ^ (g & 15))] = v[r];
        }
        __syncthreads();
        unsigned KA[17], KB[17];
#pragma unroll
        for (int m = 0; m < 17; ++m) {
          int k = (m < 16) ? (((tid & 31) << 8) | (m * 16 + ((tid >> 6) << 1) + ((tid >> 5) & 1))) : 8192;
          asm volatile("" : "+v"(k) :: "memory");
          if (m < 16 || tid == 0) {
            const float2 c1 = X[PX(pos14(k))], c2 = X[PX(pos14((16384 - k) & 16383))];
            const float2 ae = make_float2(0.5f * (c1.x + c2.x), 0.5f * (c1.y - c2.y));
            const float2 ao = make_float2(0.5f * (c1.y + c2.y), -0.5f * (c1.x - c2.x));
            const float2 tw = twid((float)k * (1.f / 32768.f));
            const float2 tao = cmul(tw, ao);
            const float2 ka = cadd(ae, tao), kb = cconj(csub(ae, tao));
            KA[m] = pack2(ka.x, ka.y);
            KB[m] = pack2(kb.x, kb.y);
          } else { KA[m] = 0u; KB[m] = 0u; }
        }
        __syncthreads();
        const u16* x1s = x1row + 16384; const u16* vs = vrow + 16384;
#pragma unroll 1
        for (int u = 0; u < 4; ++u) {
          const int tl = 8 * (tid + 512 * u);
          float a[8], c[8];
          conv3_8(x1s, tl, 16384, w10, w11, w12, a);
          conv3_8(vs, tl, 16384, w20, w21, w22, c);
#pragma unroll
          for (int i = 0; i < 8; ++i) a[i] *= c[i];
          *(u32x4*)(zs + tl) = pack8(a);
          const int n = tl >> 1;
#pragma unroll
          for (int i = 0; i < 4; ++i) { X[PX(n + i)] = make_float2(a[2 * i], a[2 * i + 1]); X[PX(8192 + n + i)] = make_float2(0.f, 0.f); }
        }
        fft_fwd_head(X);
#pragma unroll 1
        for (int u = 0; u < 2; ++u) {
          const int g = tid + 512 * u;
          float2 v[16];
#pragma unroll
          for (int r = 0; r < 16; ++r) v[r] = X[16 * g + (r ^ (g & 15))];
          fft16_fwd(v);
#pragma unroll
          for (int r = 0; r < 16; ++r) X[16 * g + (r ^ (g & 15))] = v[r];
        }
        __syncthreads();
#pragma unroll
        for (int m = 0; m < 17; ++m) {
          int k = (m < 16) ? (((tid & 31) << 8) | (m * 16 + ((tid >> 6) << 1) + ((tid >> 5) & 1))) : 8192;
          asm volatile("" : "+v"(k) :: "memory");
          if (m < 16 || tid == 0) {
            const int p1 = PX(pos14(k)), p2 = PX(pos14((16384 - k) & 16383));
            const float2 c1 = X[p1], c2 = X[p2];
            const float2 ae = make_float2(0.5f * (c1.x + c2.x), 0.5f * (c1.y - c2.y));
            const float2 ao = make_float2(0.5f * (c1.y + c2.y), -0.5f * (c1.x - c2.x));
            const float2 tw = twid((float)k * (1.f / 32768.f));
            const float2 tao = cmul(tw, ao);
            const float2 y1 = cmul(cadd(ae, tao), make_float2(lo_bf(KA[m]), hi_bf(KA[m])));
            const float2 y2 = cmul(cconj(csub(ae, tao)), make_float2(lo_bf(KB[m]), hi_bf(KB[m])));
            const float2 ye = make_float2(0.5f * (y1.x + y2.x), 0.5f * (y1.y - y2.y));
            const float2 yd = make_float2(0.5f * (y1.x - y2.x), 0.5f * (y1.y + y2.y));
            const float2 yo = cmulc(yd, tw);
            X[p1] = make_float2(ye.x - yo.y, ye.y + yo.x);
            if (k != 0) X[p2] = make_float2(ye.x + yo.y, -ye.y + yo.x);
          }
        }
        __syncthreads();
#pragma unroll 1
        for (int u = 0; u < 2; ++u) {
          const int g = tid + 512 * u;
          float2 v[16];
#pragma unroll
          for (int r = 0; r < 16; ++r) v[r] = X[16 * g + (r ^ (g & 15))];
          fft16_inv(v);
#pragma unroll
          for (int r = 0; r < 16; ++r) X[16 * g + (r ^ (g & 15))] = v[r];
        }
        fft_inv_tail(X);
        u16* orow = x1row + 16384;
        const u16* x0s = x0row + 16384;
#pragma unroll 1
        for (int u = 0; u < 4; ++u) {
          const int tl = 8 * (tid + 512 * u);
          const int n = tl >> 1;
          float y[8], g0[8], zz[8];
          unpack8(*(const u32x4*)(zs + tl), zz);
#pragma unroll
          for (int i = 0; i < 4; ++i) { const float2 xv = X[PX(n + i)]; y[2 * i] = xv.x * SCL + bias * zz[2 * i]; y[2 * i + 1] = xv.y * SCL + bias * zz[2 * i + 1]; }
          conv3_8(x0s, tl, 16384, w00, w01, w02, g0);
#pragma unroll
          for (int i = 0; i < 8; ++i) y[i] *= g0[i];
          *(u32x4*)(orow + tl) = pack8(y);
        }
      }
    }
  }
  grid_bar(barcnt, bar_target, (unsigned)G);

  if (PHM & (1 << 10)) {
    PHASE_IDS
    const u16* src = (const u16*)dsc;
    u16* yg = (u16*)(ws + C_YG);
    u16* tl = (u16*)smem;
    for (int tile = vb; tile < 16 * 512; tile += G) {
      const int tc = tile & 15, tt = tile >> 4;
      {
        const int cr = tid >> 3, c8 = tid & 7;
        const u32x4 v = *(const u32x4*)(src + (long)(tc * 64 + cr) * T_TOK + tt * 64 + c8 * 8);
        *(u32x4*)(tl + cr * 72 + c8 * 8) = v;
      }
      __syncthreads();
      {
        const int tr = tid >> 3, c8 = tid & 7;
        u32x4 o;
#pragma unroll
        for (int i = 0; i < 4; ++i) {
          const unsigned a = tl[(c8 * 8 + 2 * i) * 72 + tr], b = tl[(c8 * 8 + 2 * i + 1) * 72 + tr];
          o[i] = a | (b << 16);
        }
        *(u32x4*)(yg + (long)(tt * 64 + tr) * DM + tc * 64 + c8 * 8) = o;
      }
      __syncthreads();
    }
  }
  grid_bar(barcnt, bar_target, (unsigned)G);

  if (PHM & (1 << 11)) {
    pg8::Gemm g{(const u16*)(ws + C_YG), (const u16*)(ws + W1_COUT), T_TOK, DM, DM};
    pg8::StaticOrder S; S.init(T_TOK, DM, G, bid);
    EpiResid E{XB, rowss + 3 * T_TOK};
    pg8::gemm_phase<EpiResid, pg8::StaticOrder>(lds, g, S, E, nullptr);
  }
  grid_bar(barcnt, bar_target, (unsigned)G);

  if (PHM & (1 << 12)) {
    u16* actC = (u16*)(ws + OFF_C);
    pg8::Gemm g{XB + (size_t)0 * 16384 * DM, (const u16*)(ws + W1_GU), 16384, 5632, DM};
    pg8::StaticOrder S; S.init(16384, 5632, G, bid);
    EpiGU E{actC - (size_t)0 * 16384 * DFF, actC, 1 << 30, rowss + 3 * T_TOK, 0 * 16384};
    pg8::gemm_phase<EpiGU, pg8::StaticOrder>(lds, g, S, E, nullptr);
  }
  grid_bar(barcnt, bar_target, (unsigned)G);
  if (PHM & (1 << 12)) {
    pg8::Gemm g{(const u16*)(ws + OFF_C), (const u16*)(ws + W1_D), 16384, DM, DFF};
    pg8::StaticOrder S; S.init(16384, DM, G, bid);
    EpiFinal E{XB, p.out, 0 * 16384};
    pg8::gemm_phase<EpiFinal, pg8::StaticOrder>(lds, g, S, E, nullptr);
  }
  grid_bar(barcnt, bar_target, (unsigned)G);
  if (PHM & (1 << 12)) {
    u16* actC = (u16*)(ws + OFF_C);
    pg8::Gemm g{XB + (size_t)1 * 16384 * DM, (const u16*)(ws + W1_GU), 16384, 5632, DM};
    pg8::StaticOrder S; S.init(16384, 5632, G, bid);
    EpiGU E{actC - (size_t)1 * 16384 * DFF, actC, 1 << 30, rowss + 3 * T_TOK, 1 * 16384};
    pg8::gemm_phase<EpiGU, pg8::StaticOrder>(lds, g, S, E, nullptr);
  }
  grid_bar(barcnt, bar_target, (unsigned)G);
  if (PHM & (1 << 12)) {
    pg8::Gemm g{(const u16*)(ws + OFF_C), (const u16*)(ws + W1_D), 16384, DM, DFF};
    pg8::StaticOrder S; S.init(16384, DM, G, bid);
    EpiFinal E{XB, p.out, 1 * 16384};
    pg8::gemm_phase<EpiFinal, pg8::StaticOrder>(lds, g, S, E, nullptr);
  }
}

extern "C" void kernel_launch(void* const* d_in, const int* in_sizes, int n_in, void* d_out, int out_size,
                              void* d_ws, size_t ws_size, hipStream_t stream) {
  static int grid_blocks = 0;
  if (!grid_blocks) {
    int dev = 0, cus = 0, per_cu = 0;
    hipGetDevice(&dev);
    hipDeviceGetAttribute(&cus, hipDeviceAttributeMultiprocessorCount, dev);
    hipOccupancyMaxActiveBlocksPerMultiprocessor(&per_cu, fwd_kernel, NTHR, 0);
    if (per_cu < 1) per_cu = 1;
    grid_blocks = cus;
    if (grid_blocks % 8) grid_blocks -= grid_blocks % 8;
  }
  if (ws_size < WS_NEED || n_in < 28) { fprintf(stderr, "workspace too small\n"); return; }
  Params p{};
  for (int i = 0; i < 28; ++i) p.in[i] = (const float*)d_in[i];
  p.out = (float*)d_out;
  p.ws = (char*)d_ws;
  hipMemsetAsync(d_ws, 0, 4096, stream);
  void* args[] = {&p};
  hipError_t e = hipLaunchCooperativeKernel((void*)fwd_kernel, dim3(grid_blocks), dim3(NTHR), args, 0, stream);
  if (e != hipSuccess) fprintf(stderr, "cooperative launch failed: %s (grid %d)\n", hipGetErrorString(e), grid_blocks);
}
```

```cpp
#include <hip/hip_runtime.h>
#include <hip/hip_cooperative_groups.h>
#include <cstdio>
#include <cstdint>
namespace cg = cooperative_groups;

typedef unsigned short u16;
typedef __attribute__((ext_vector_type(8))) short bf16x8;
typedef __attribute__((ext_vector_type(4))) short s16x4;
typedef __attribute__((ext_vector_type(4))) float f32x4;
typedef __attribute__((ext_vector_type(16))) float f32x16;
typedef __attribute__((ext_vector_type(4))) unsigned u32x4;
typedef __attribute__((ext_vector_type(2))) unsigned u32x2;

#define DI __device__ __forceinline__
#define NTHR 512
#ifndef FFTP
#define FFTP 3
#endif
#ifndef REP1
#define REP1 1
#endif
#ifndef REP5
#define REP5 1
#endif
#ifndef REP7
#define REP7 1
#endif
#ifndef REP8
#define REP8 1
#endif
#ifndef PHM
#define PHM 0xffff
#endif


DI float2 mk2(float x, float y) { float2 r; r.x = x; r.y = y; return r; }
DI void bsync() { __builtin_amdgcn_fence(__ATOMIC_RELEASE, "workgroup"); __builtin_amdgcn_s_barrier(); __builtin_amdgcn_fence(__ATOMIC_ACQUIRE, "workgroup"); }
DI float i2f(int v) { return __builtin_bit_cast(float, v); }
DI int f2i(float v) { return __builtin_bit_cast(int, v); }
DI float4 mk4(float x, float y, float z, float w) { float4 r; r.x = x; r.y = y; r.z = z; r.w = w; return r; }
#define make_float4 mk4
#define make_float2 mk2
#define __syncthreads bsync
#define __int_as_float i2f
#define __float_as_int f2i

constexpr int T_TOK = 32768;
constexpr int DM = 1024;
constexpr int DFF = 2816;
constexpr float EPSN = 1e-6f;

constexpr size_t SM_ROWSS = 4096;
constexpr size_t SM_Z3    = 1048576;
constexpr size_t OFF_W1   = 4194304;
constexpr size_t W1_CIN   = OFF_W1;
constexpr size_t W1_COUT  = W1_CIN + 6291456;
constexpr size_t W1_W4    = W1_COUT + 2097152;
constexpr size_t W1_GU    = W1_W4 + 262144;
constexpr size_t W1_D     = W1_GU + 11534336;
constexpr size_t OFF_XB   = W1_D + 5767168;
constexpr size_t OFF_C    = OFF_XB + 67108864;
constexpr size_t W0_IN    = OFF_C;
constexpr size_t W0_Q     = W0_IN + 4194304;
constexpr size_t W0_K     = W0_Q + 393216;
constexpr size_t W0_V     = W0_K + 131072;
constexpr size_t W0_OUT   = W0_V + 131072;
constexpr size_t W0_GU    = W0_OUT + 2097152;
constexpr size_t W0_D     = W0_GU + 11534336;
constexpr size_t OFF_R    = W0_D + 5767168;
constexpr size_t WS_NEED  = 268435456;
static_assert(OFF_R == 121503744, "map");
constexpr size_t R_CQN  = OFF_R;
constexpr size_t R_CKVN = R_CQN + 16777216;
constexpr size_t R_KPE  = R_CKVN + 8388608;
constexpr size_t R_MIX  = R_KPE + 2097152;
constexpr size_t R_K    = R_MIX + 67108864;
constexpr size_t R_ROPE = R_K + 50331648;
constexpr size_t SM_SSKPE = 528384;
static_assert(R_ROPE + 2097152 <= WS_NEED, "map");
constexpr size_t D_QRAW = 0;
constexpr size_t D_KN   = 50331648;
constexpr size_t D_VT   = D_KN + 33554432;
constexpr size_t D_ROPE = D_VT + 33554432;
static_assert(D_ROPE + 2097152 <= 134217728, "map");
constexpr size_t C_X0T  = OFF_C;
constexpr size_t C_KP   = C_X0T + 67108864;
constexpr size_t C_KS   = C_KP + 33554432;
constexpr size_t C_YG   = C_KS;
static_assert(C_KS + 67108864 <= WS_NEED, "map");

struct Params {
  const float* in[28];
  float* out;
  char* ws;
};

typedef __bf16 bf16v2_t __attribute__((ext_vector_type(2)));
typedef float f32v2_t __attribute__((ext_vector_type(2)));
DI unsigned pack2(float a, float b) { f32v2_t v = {a, b}; bf16v2_t r = __builtin_convertvector(v, bf16v2_t); return __builtin_bit_cast(unsigned, r); }
DI u16 f2bf(float x) { return (u16)(pack2(x, 0.f) & 0xffffu); }
DI float bf2f(u16 v) { return __uint_as_float(((unsigned)v) << 16); }
DI float lo_bf(unsigned w) { return __uint_as_float(w << 16); }
DI float hi_bf(unsigned w) { return __uint_as_float(w & 0xffff0000u); }
DI void unpack8(const u32x4& v, float* f) {
  f[0] = lo_bf(v[0]); f[1] = hi_bf(v[0]); f[2] = lo_bf(v[1]); f[3] = hi_bf(v[1]);
  f[4] = lo_bf(v[2]); f[5] = hi_bf(v[2]); f[6] = lo_bf(v[3]); f[7] = hi_bf(v[3]);
}
DI u32x4 pack8(const float* f) {
  u32x4 v; v[0] = pack2(f[0], f[1]); v[1] = pack2(f[2], f[3]); v[2] = pack2(f[4], f[5]); v[3] = pack2(f[6], f[7]); return v;
}
DI float wave_sum(float v) {
  v += __shfl_xor(v, 32); v += __shfl_xor(v, 16); v += __shfl_xor(v, 8);
  v += __shfl_xor(v, 4); v += __shfl_xor(v, 2); v += __shfl_xor(v, 1); return v;
}
DI void seq_of(int t, int& t0, int& L) {
  if (t < 8192) { t0 = 0; L = 8192; } else if (t < 16384) { t0 = 8192; L = 8192; } else { t0 = 16384; L = 16384; }
}

namespace pg8 {
#define PG8_LAS __attribute__((address_space(3)))
typedef unsigned short bf16_t;
typedef short bf16x8 __attribute__((ext_vector_type(8)));
typedef float f32x4 __attribute__((ext_vector_type(4)));
typedef unsigned u32x4 __attribute__((ext_vector_type(4)));
constexpr int BM = 256, BK = 64, HALF = 128, HTB = HALF * BK * 2  , STAGE_BYTES = 8 * HTB, NXCD = 8, WGM = 8;

__host__ __device__ __forceinline__ int lds_byte(int r, int c) { const int st = (r >> 4) * 2 + (c >> 5), rr = r & 15, cc = c & 31, ob = rr * 64 + cc * 2; return st * 1024 + (ob ^ (((ob >> 9) & 1) << 5)); }
__host__ __device__ __forceinline__ void stage_rc(int b, int& R, int& C) { const int st = b / 1024, sb = b % 1024, swz = sb ^ (((sb >> 9) & 1) << 5); R = (st >> 1) * 16 + swz / 64; C = (st & 1) * 32 + (swz % 64) / 2; }
__host__ __device__ __forceinline__ int perm32(int rho) { const int n = rho >> 4, i = rho & 15; return 8 * (i >> 2) + 4 * n + (i & 3); }

struct Unit { int pm, pn; };
struct Gemm { const bf16_t* A; const bf16_t* Bt; int M, N, K; };

struct StaticOrder {
    int nM, nN, nwg, G, c;
    __host__ __device__ __forceinline__ void init(int M, int N, int G_, int c_) { nM = M / BM; nN = N / BM; nwg = nM * nN; G = G_; c = c_; }
    __host__ __device__ __forceinline__ bool next(int i, Unit& u) const {
        const long L = (long)i * G + c; if (L >= nwg) return false;
        int wgid = (int)L; { const int q = nwg / NXCD, r = nwg % NXCD, xcd = wgid % NXCD, off = wgid / NXCD; wgid = (xcd < r ? xcd * (q + 1) : r * (q + 1) + (xcd - r) * q) + off; }
        const int nig = WGM * nN, gid = wgid / nig, fm = gid * WGM, gsz = (nM - fm) < WGM ? (nM - fm) : WGM;
        u.pm = fm + ((wgid % nig) % gsz); u.pn = (wgid % nig) / gsz; return true;
    }
    __device__ __forceinline__ void a_ready(const Unit&) const {}
    __device__ __forceinline__ void done(const Unit&) const {}
    __device__ __forceinline__ const char* a_ptr(const char* base, int pm, size_t tstep) const { return base + (size_t)pm * tstep; }
};
__device__ __forceinline__ unsigned cvt_pk_bf16(float lo, float hi) { unsigned r; asm volatile("v_cvt_pk_bf16_f32 %0, %1, %2" : "=v"(r) : "v"(lo), "v"(hi)); return r; }
template <class Epi, class Sched, bool STAMP = false>
__device__ __forceinline__ void gemm_phase(PG8_LAS unsigned char* lds, const Gemm g, const Sched& S, const Epi& E, unsigned long long* stamps) {
    int tid = threadIdx.x; asm volatile("" : "+v"(tid));
    const int wid = __builtin_amdgcn_readfirstlane(tid >> 6), lane = tid & 63, wr = wid >> 2, wc = wid & 3, fr = lane & 15, fq = lane >> 4;
    const int K = g.K, nt = K / BK;
    int ts_lo = 0, ts_hi = 0, nts = 0; const unsigned long long rt_entry = STAMP ? (unsigned long long)wall_clock64() : 0ull;
#define PG8_STAMP() do { if (STAMP && wid == 0 && nts < 64) { const unsigned long long _c = (unsigned long long)clock64(); \
        ts_lo = (lane == nts) ? (int)(unsigned)_c : ts_lo; ts_hi = (lane == nts) ? (int)(unsigned)(_c >> 32) : ts_hi; ++nts; } } while (0)
    PG8_STAMP();
    unsigned voffA[2], voffB[2];
#pragma unroll
    for (int i = 0; i < 2; ++i) { int R, C; stage_rc(tid * 16 + i * 8192, R, C); const int Rb = Epi::PERM ? ((R & ~31) + perm32(R & 31)) : R;
        voffA[i] = (unsigned)(R * K + C) * 2u; voffB[i] = (unsigned)(Rb * K + C) * 2u; }
    const size_t kstep = (size_t)(BK * 2);
    const size_t hstep = (size_t)HALF * K * 2;
    const size_t tstep = 2 * hstep;
    const unsigned ldsw = (unsigned)wid * 1024u;
    const int aoff = lds_byte(wr * 64 + fr, fq * 8), boff = lds_byte(wc * 32 + fr, fq * 8);
#define PG8_SA(b, h) (((b) * 2 + (h)) * HTB)
#define PG8_SB(b, h) ((4 + (b) * 2 + (h)) * HTB)
#define PG8_STAGE(bufoff, gbase, voff) do { _Pragma("unroll") for (int _i = 0; _i < 2; ++_i) \
        __builtin_amdgcn_global_load_lds((const unsigned*)((const char*)(gbase) + (voff)[_i]), (PG8_LAS unsigned*)(lds + (bufoff) + ldsw + _i * 8192), 16, 0, 0); } while (0)
#define PG8_LDA(dst, b, h) do { _Pragma("unroll") for (int m = 0; m < 4; ++m) _Pragma("unroll") for (int k = 0; k < 2; ++k) dst[m][k] = *(const PG8_LAS bf16x8*)(lds + PG8_SA(b, h) + aoff + m * 2048 + k * 1024); } while (0)
#define PG8_LDB(dst, b, h) do { _Pragma("unroll") for (int n = 0; n < 2; ++n) _Pragma("unroll") for (int k = 0; k < 2; ++k) dst[n][k] = *(const PG8_LAS bf16x8*)(lds + PG8_SB(b, h) + boff + n * 2048 + k * 1024); } while (0)
#define PG8_MMA(ai, bj, At, Bt) do { __builtin_amdgcn_s_setprio(1); _Pragma("unroll") for (int m = 0; m < 4; ++m) _Pragma("unroll") for (int n = 0; n < 2; ++n) _Pragma("unroll") for (int k = 0; k < 2; ++k) \
        acc[ai][bj][m][n] = __builtin_amdgcn_mfma_f32_16x16x32_bf16(Bt[n][k], At[m][k], acc[ai][bj][m][n], 0, 0, 0); __builtin_amdgcn_s_setprio(0); } while (0)
#define PG8_WAIT_V(n) asm volatile("s_waitcnt vmcnt(" #n ")" ::: "memory")
#define PG8_WAIT_L(n) asm volatile("s_waitcnt lgkmcnt(" #n ")" ::: "memory")
#define PG8_BAR __builtin_amdgcn_s_barrier()
#define PG8_SCHED __builtin_amdgcn_sched_barrier(0)
    Unit cur, nxt; int ui = 0;
    if (!S.next(0, cur)) return;
    f32x4 acc[2][2][4][2];
#pragma unroll
    for (int a = 0; a < 2; ++a)
#pragma unroll
        for (int b = 0; b < 2; ++b)
#pragma unroll
            for (int m = 0; m < 4; ++m)
#pragma unroll
                for (int n = 0; n < 2; ++n) acc[a][b][m][n] = (f32x4){0.f, 0.f, 0.f, 0.f};
    bf16x8 At[4][2], B0[2][2], B1[2][2];
    const char* cA = S.a_ptr((const char*)g.A, cur.pm, tstep); const char* cB = (const char*)g.Bt + (size_t)cur.pn * tstep;
    S.a_ready(cur);
    PG8_STAGE(PG8_SB(0, 0), cB, voffB); PG8_STAGE(PG8_SA(0, 0), cA, voffA); PG8_STAGE(PG8_SB(0, 1), cB + hstep, voffB); PG8_STAGE(PG8_SA(0, 1), cA + hstep, voffA);
    if (wr == 1) PG8_BAR;
    PG8_WAIT_V(4); PG8_BAR;
    PG8_STAGE(PG8_SB(1, 0), cB + kstep, voffB); PG8_STAGE(PG8_SA(1, 0), cA + kstep, voffA); PG8_STAGE(PG8_SB(1, 1), cB + hstep + kstep, voffB);
    PG8_WAIT_V(6); PG8_BAR;
    PG8_STAMP();
    for (;;) {
        const bool has_next = S.next(ui + 1, nxt);
        const char* nA = has_next ? S.a_ptr((const char*)g.A, nxt.pm, tstep) : cA; const char* nB = has_next ? (const char*)g.Bt + (size_t)nxt.pn * tstep : cB;
        for (int t = 0; t < nt; t += 2) {
            const bool last = (t == nt - 2);
            const char* a1 = cA + (size_t)(t + 1) * kstep;
            const char* a2 = last ? nA : cA + (size_t)(t + 2) * kstep; const char* b2 = last ? nB : cB + (size_t)(t + 2) * kstep;
            const char* a3 = a2 + kstep; const char* b3 = b2 + kstep;
            if (last && has_next) S.a_ready(nxt);
            PG8_LDB(B0, 0, 0); PG8_SCHED; PG8_LDA(At, 0, 0); PG8_STAGE(PG8_SA(1, 1), a1 + hstep, voffA);
            PG8_WAIT_L(8); PG8_BAR; PG8_WAIT_L(0); PG8_MMA(0, 0, At, B0); PG8_BAR; PG8_SCHED;
            PG8_LDB(B1, 0, 1); PG8_STAGE(PG8_SB(0, 0), b2, voffB);
            PG8_BAR; PG8_WAIT_L(0); PG8_MMA(0, 1, At, B1); PG8_BAR;
            PG8_LDA(At, 0, 1); PG8_STAGE(PG8_SA(0, 0), a2, voffA);
            PG8_BAR; PG8_WAIT_L(0); PG8_MMA(1, 0, At, B0); PG8_BAR; PG8_SCHED;
            PG8_STAGE(PG8_SB(0, 1), b2 + hstep, voffB);
            PG8_WAIT_V(6); PG8_BAR; PG8_MMA(1, 1, At, B1); PG8_BAR;
            PG8_LDB(B0, 1, 0); PG8_SCHED; PG8_LDA(At, 1, 0); PG8_STAGE(PG8_SA(0, 1), a2 + hstep, voffA);
            PG8_WAIT_L(8); PG8_BAR; PG8_WAIT_L(0); PG8_MMA(0, 0, At, B0); PG8_BAR; PG8_SCHED;
            PG8_LDB(B1, 1, 1); PG8_STAGE(PG8_SB(1, 0), b3, voffB);
            PG8_BAR; PG8_WAIT_L(0); PG8_MMA(0, 1, At, B1); PG8_BAR;
            PG8_LDA(At, 1, 1); PG8_STAGE(PG8_SA(1, 0), a3, voffA);
            PG8_BAR; PG8_WAIT_L(0); PG8_MMA(1, 0, At, B0); PG8_BAR; PG8_SCHED;
            PG8_STAGE(PG8_SB(1, 1), b3 + hstep, voffB);
            PG8_WAIT_V(6); PG8_BAR; PG8_MMA(1, 1, At, B1); PG8_BAR;
        }
        PG8_STAMP();
        if constexpr (!Epi::AFTER_DRAIN) { E(acc, cur, wr, wc, fr, fq); S.done(cur); }
        PG8_STAMP();
        if (!has_next) break;
#pragma unroll
        for (int a = 0; a < 2; ++a)
#pragma unroll
            for (int b = 0; b < 2; ++b)
#pragma unroll
                for (int m = 0; m < 4; ++m)
#pragma unroll
                    for (int n = 0; n < 2; ++n) acc[a][b][m][n] = (f32x4){0.f, 0.f, 0.f, 0.f};
        cur = nxt; cA = nA; cB = nB; ++ui;
    }
    PG8_WAIT_V(0);
    if (wr == 0) PG8_BAR;
    PG8_BAR;
    if constexpr (Epi::AFTER_DRAIN) { E.fused(acc, cur, wr, wc, fr, fq, lds, wid, lane); S.done(cur); }
    PG8_STAMP();
    if (STAMP && wid == 0) { stamps[lane] = lane < nts ? (((unsigned long long)(unsigned)ts_hi << 32) | (unsigned)ts_lo) : 0ull;
        if (lane == 62) stamps[62] = rt_entry; if (lane == 63) stamps[63] = (unsigned long long)wall_clock64(); }
#undef PG8_STAMP
#undef PG8_SA
#undef PG8_SB
#undef PG8_STAGE
#undef PG8_LDA
#undef PG8_LDB
#undef PG8_MMA
#undef PG8_WAIT_V
#undef PG8_WAIT_L
#undef PG8_BAR
#undef PG8_SCHED
}
}

struct SplitOrder : pg8::StaticOrder {
  const char* base2; int split;
  DI const char* a_ptr(const char* base, int pm, size_t tstep) const { return pm < split ? base + (size_t)pm * tstep : base2 + (size_t)(pm - split) * tstep; }
};
struct EpiRowScaleBf16 {
  static constexpr bool PERM = true, AFTER_DRAIN = false;
  u16* O; int ldc; const float* ssq;
  DI void operator()(const f32x4 (&acc)[2][2][4][2], const pg8::Unit& u, int wr, int wc, int fr, int fq) const {
    const int row0 = u.pm * 256 + wr * 64 + fr, col0 = u.pn * 256 + wc * 32 + 8 * fq;
#pragma unroll
    for (int ai = 0; ai < 2; ++ai)
#pragma unroll
      for (int m = 0; m < 4; ++m) {
        const int row = row0 + ai * 128 + m * 16;
        const float rs = rsqrtf(ssq[row] * (1.f / 1024.f) + EPSN);
        u16* rp = O + (size_t)row * ldc + col0;
#pragma unroll
        for (int bj = 0; bj < 2; ++bj) {
          const f32x4 v0 = acc[ai][bj][m][0] * rs, v1 = acc[ai][bj][m][1] * rs;
          u32x4 w; w[0] = pack2(v0[0], v0[1]); w[1] = pack2(v0[2], v0[3]); w[2] = pack2(v1[0], v1[1]); w[3] = pack2(v1[2], v1[3]);
          *(u32x4*)(rp + bj * 128) = w;
        }
      }
  }
};
struct EpiResid {
  static constexpr bool PERM = true, AFTER_DRAIN = false;
  u16* X; float* ssq;
  DI void operator()(const f32x4 (&acc)[2][2][4][2], const pg8::Unit& u, int wr, int wc, int fr, int fq) const {
    const int row0 = u.pm * 256 + wr * 64 + fr, col0 = u.pn * 256 + wc * 32 + 8 * fq;
#pragma unroll
    for (int ai = 0; ai < 2; ++ai)
#pragma unroll
      for (int m = 0; m < 4; ++m) {
        const int row = row0 + ai * 128 + m * 16;
        u16* rp = X + (size_t)row * DM + col0;
        float part = 0.f;
#pragma unroll
        for (int bj = 0; bj < 2; ++bj) {
          float f[8]; unpack8(*(const u32x4*)(rp + bj * 128), f);
#pragma unroll
          for (int e = 0; e < 4; ++e) { f[e] += acc[ai][bj][m][0][e]; f[4 + e] += acc[ai][bj][m][1][e]; }
#pragma unroll
          for (int e = 0; e < 8; ++e) part += f[e] * f[e];
          *(u32x4*)(rp + bj * 128) = pack8(f);
        }
        part += __shfl_xor(part, 16); part += __shfl_xor(part, 32);
        if (fq == 0) atomicAdd(ssq + row, part);
      }
  }
};
struct EpiGU {
  static constexpr bool PERM = false, AFTER_DRAIN = false;
  u16* actA; u16* actB; int split_row; const float* ssq; int row_off;
  DI void operator()(const f32x4 (&acc)[2][2][4][2], const pg8::Unit& u, int wr, int wc, int fr, int fq) const {
    const int row0 = row_off + u.pm * 256 + wr * 64 + fr;
#pragma unroll
    for (int ai = 0; ai < 2; ++ai)
#pragma unroll
      for (int m = 0; m < 4; ++m) {
        const int row = row0 + ai * 128 + m * 16;
        const float rs = rsqrtf(ssq[row] * (1.f / 1024.f) + EPSN);
        u16* ap = (row < split_row) ? (actA + (size_t)row * DFF) : (actB + (size_t)(row - split_row) * DFF);
#pragma unroll
        for (int bj = 0; bj < 2; ++bj) {
          const f32x4 gv = acc[ai][bj][m][0] * rs, uv = acc[ai][bj][m][1] * rs;
          float o[4];
#pragma unroll
          for (int e = 0; e < 4; ++e) o[e] = gv[e] * uv[e] * __builtin_amdgcn_rcpf(1.f + __builtin_amdgcn_exp2f(-1.4426950408889634f * gv[e]));
          u32x2 w; w[0] = pack2(o[0], o[1]); w[1] = pack2(o[2], o[3]);
          *(u32x2*)(ap + 16 * (8 * u.pn + 4 * bj + wc) + 4 * fq) = w;
        }
      }
  }
};
struct EpiFinal {
  static constexpr bool PERM = false, AFTER_DRAIN = false;
  const u16* X; float* out; int row_off;
  DI void operator()(const f32x4 (&acc)[2][2][4][2], const pg8::Unit& u, int wr, int wc, int fr, int fq) const {
    const int row0 = row_off + u.pm * 256 + wr * 64 + fr, col0 = u.pn * 256 + wc * 32 + 4 * fq;
#pragma unroll
    for (int ai = 0; ai < 2; ++ai)
#pragma unroll
      for (int m = 0; m < 4; ++m) {
        const size_t rb = (size_t)(row0 + ai * 128 + m * 16) * DM + col0;
#pragma unroll
        for (int bj = 0; bj < 2; ++bj)
#pragma unroll
          for (int n = 0; n < 2; ++n) {
            const u32x2 xv = *(const u32x2*)(X + rb + bj * 128 + n * 16);
            f32x4 o = acc[ai][bj][m][n];
            o[0] += lo_bf(xv[0]); o[1] += hi_bf(xv[0]); o[2] += lo_bf(xv[1]); o[3] += hi_bf(xv[1]);
            __builtin_nontemporal_store(o, (f32x4*)(out + rb + bj * 128 + n * 16));
          }
      }
  }
};
struct EpiCin {
  static constexpr bool PERM = true, AFTER_DRAIN = false;
  u16* x0t; u16* x1vt; const float* ssq;
  DI void operator()(const f32x4 (&acc)[2][2][4][2], const pg8::Unit& u, int wr, int wc, int fr, int fq) const {
    const int row0 = u.pm * 256 + wr * 64 + fr, col0 = u.pn * 256 + wc * 32 + 8 * fq;
    float rs[2][8];
#pragma unroll
    for (int bj = 0; bj < 2; ++bj)
#pragma unroll
      for (int e = 0; e < 8; ++e) rs[bj][e] = rsqrtf(ssq[col0 + bj * 128 + e] * (1.f / 1024.f) + EPSN);
#pragma unroll
    for (int ai = 0; ai < 2; ++ai)
#pragma unroll
      for (int m = 0; m < 4; ++m) {
        const int ch = row0 + ai * 128 + m * 16;
        u16* rp = ((ch < 1024) ? (x0t + (size_t)ch * T_TOK) : (x1vt + (size_t)(ch - 1024) * T_TOK)) + col0;
#pragma unroll
        for (int bj = 0; bj < 2; ++bj) {
          const f32x4 v0 = acc[ai][bj][m][0], v1 = acc[ai][bj][m][1];
          u32x4 w;
          w[0] = pack2(v0[0] * rs[bj][0], v0[1] * rs[bj][1]); w[1] = pack2(v0[2] * rs[bj][2], v0[3] * rs[bj][3]);
          w[2] = pack2(v1[0] * rs[bj][4], v1[1] * rs[bj][5]); w[3] = pack2(v1[2] * rs[bj][6], v1[3] * rs[bj][7]);
          *(u32x4*)(rp + bj * 128) = w;
        }
      }
  }
};

DI int swz(int row, int chunk) { return row * 128 + ((chunk ^ (row & 7)) << 4); }

template <int NI = 4, class Epi>
DI void gemm_tile(const u16* __restrict__ A, long lda, const u16* __restrict__ B, long ldb, int K, char* smem, Epi&& epi) {
  int tid = threadIdx.x; asm volatile("" : "+v"(tid));
  const int lane = tid & 63, wid = tid >> 6;
  const int wr = wid >> 1, wc = wid & 1;
  const int fr = lane & 15, fq = lane >> 4;
  constexpr int NBL = NI / 2;
  constexpr int BUFB = 32768 + NI * 32 * 128;
  f32x4 acc[4][NI];
#pragma unroll
  for (int i = 0; i < 4; ++i)
#pragma unroll
    for (int j = 0; j < NI; ++j) acc[i][j] = (f32x4){0.f, 0.f, 0.f, 0.f};
  const int lrow = tid >> 3, lch = tid & 7;
  const u16* Ap = A + (long)lrow * lda + lch * 8;
  const u16* Bp = B + (long)lrow * ldb + lch * 8;
  u32x4 ra[4], rb[NBL];
  const int nk = K >> 6;
#pragma unroll
  for (int i = 0; i < 4; ++i) ra[i] = *(const u32x4*)(Ap + (long)(i * 64) * lda);
#pragma unroll
  for (int i = 0; i < NBL; ++i) rb[i] = *(const u32x4*)(Bp + (long)(i * 64) * ldb);
#pragma unroll
  for (int i = 0; i < 4; ++i) *(u32x4*)(smem + swz(lrow + i * 64, lch)) = ra[i];
#pragma unroll
  for (int i = 0; i < NBL; ++i) *(u32x4*)(smem + 32768 + swz(lrow + i * 64, lch)) = rb[i];
  __syncthreads();
  for (int kt = 0; kt < nk; ++kt) {
    if (kt + 1 < nk) {
#pragma unroll
      for (int i = 0; i < 4; ++i) ra[i] = *(const u32x4*)(Ap + (long)(i * 64) * lda + (kt + 1) * 64);
#pragma unroll
      for (int i = 0; i < NBL; ++i) rb[i] = *(const u32x4*)(Bp + (long)(i * 64) * ldb + (kt + 1) * 64);
    }
    const char* sa = smem + (kt & 1) * BUFB;
    const char* sb = sa + 32768;
#pragma unroll
    for (int ks = 0; ks < 2; ++ks) {
      bf16x8 af[4], bfr[NI];
#pragma unroll
      for (int mi = 0; mi < 4; ++mi) af[mi] = *(const bf16x8*)(sa + swz(wr * 64 + mi * 16 + fr, ks * 4 + fq));
#pragma unroll
      for (int ni = 0; ni < NI; ++ni) bfr[ni] = *(const bf16x8*)(sb + swz(wc * (NI * 16) + ni * 16 + fr, ks * 4 + fq));
#pragma unroll
      for (int mi = 0; mi < 4; ++mi)
#pragma unroll
        for (int ni = 0; ni < NI; ++ni)
          acc[mi][ni] = __builtin_amdgcn_mfma_f32_16x16x32_bf16(af[mi], bfr[ni], acc[mi][ni], 0, 0, 0);
    }
    if (kt + 1 < nk) {
      char* da = smem + ((kt + 1) & 1) * BUFB;
#pragma unroll
      for (int i = 0; i < 4; ++i) *(u32x4*)(da + swz(lrow + i * 64, lch)) = ra[i];
#pragma unroll
      for (int i = 0; i < NBL; ++i) *(u32x4*)(da + 32768 + swz(lrow + i * 64, lch)) = rb[i];
    }
    __syncthreads();
  }
  epi(acc, wr * 64 + fq * 4, wc * (NI * 16) + fr);
}

template <int KIND>
DI void convert_w(const float* __restrict__ src, const float* __restrict__ src2, int Nsrc, int K, int Np,
                  u16* __restrict__ dst, const float* __restrict__ gain, long gtid, long GT) {
  const int items = Np * (K >> 3);
#pragma unroll 4
  for (int it = (int)gtid; it < items; it += (int)GT) {
    const int np = it % Np, kc = it / Np;
    const float* sp = src; int n = np; bool valid = true;
    if (KIND == 0) { valid = np < Nsrc; }
    else if (KIND == 1) { n = (np >> 6) * 128 + (np & 63); }
    else if (KIND == 2) { n = (np >> 6) * 128 + 64 + (np & 63); }
    else { const int g = np >> 5, w = np & 31; sp = (w < 16) ? src : src2; n = g * 16 + (w & 15); }
    float f[8];
#pragma unroll
    for (int j = 0; j < 8; ++j) {
      const int k = kc * 8 + j;
      float v = valid ? sp[(long)k * Nsrc + n] : 0.f;
      if (gain) v *= gain[k];
      f[j] = v;
    }
    *(u32x4*)(dst + (long)np * K + kc * 8) = pack8(f);
  }
}

DI float2 cadd(float2 a, float2 b) { return make_float2(a.x + b.x, a.y + b.y); }
DI float2 csub(float2 a, float2 b) { return make_float2(a.x - b.x, a.y - b.y); }
DI float2 cmul(float2 a, float2 b) { return make_float2(a.x * b.x - a.y * b.y, a.x * b.y + a.y * b.x); }
DI float2 cmulc(float2 a, float2 b) { return make_float2(a.x * b.x + a.y * b.y, a.y * b.x - a.x * b.y); }
DI float2 cconj(float2 a) { return make_float2(a.x, -a.y); }
DI float2 twid(float rev) {
  return make_float2(__builtin_amdgcn_cosf(rev), -__builtin_amdgcn_sinf(rev));
}
DI void r4f(float2& a0, float2& a1, float2& a2, float2& a3) {
  const float2 s02 = cadd(a0, a2), d02 = csub(a0, a2), s13 = cadd(a1, a3), d13 = csub(a1, a3);
  a0 = cadd(s02, s13); a2 = csub(s02, s13);
  a1 = make_float2(d02.x + d13.y, d02.y - d13.x);
  a3 = make_float2(d02.x - d13.y, d02.y + d13.x);
}
DI void r4i(float2& a0, float2& a1, float2& a2, float2& a3) {
  const float2 s02 = cadd(a0, a2), d02 = csub(a0, a2), s13 = cadd(a1, a3), d13 = csub(a1, a3);
  a0 = cadd(s02, s13); a2 = csub(s02, s13);
  a1 = make_float2(d02.x - d13.y, d02.y + d13.x);
  a3 = make_float2(d02.x + d13.y, d02.y - d13.x);
}
#define C8 0.9238795325112867f
#define S8 0.3826834323650898f
#define R2 0.7071067811865476f
DI void fft16_fwd(float2 (&v)[16]) {
#pragma unroll
  for (int r0 = 0; r0 < 4; ++r0) r4f(v[r0], v[r0 + 4], v[r0 + 8], v[r0 + 12]);
  v[5]  = cmul(v[5],  make_float2(C8, -S8));
  v[9]  = cmul(v[9],  make_float2(R2, -R2));
  v[13] = cmul(v[13], make_float2(S8, -C8));
  v[6]  = cmul(v[6],  make_float2(R2, -R2));
  v[10] = make_float2(v[10].y, -v[10].x);
  v[14] = cmul(v[14], make_float2(-R2, -R2));
  v[7]  = cmul(v[7],  make_float2(S8, -C8));
  v[11] = cmul(v[11], make_float2(-R2, -R2));
  v[15] = cmul(v[15], make_float2(-C8, S8));
#pragma unroll
  for (int q1 = 0; q1 < 4; ++q1) r4f(v[4 * q1], v[4 * q1 + 1], v[4 * q1 + 2], v[4 * q1 + 3]);
}
DI void fft16_inv(float2 (&v)[16]) {
#pragma unroll
  for (int q1 = 0; q1 < 4; ++q1) r4i(v[4 * q1], v[4 * q1 + 1], v[4 * q1 + 2], v[4 * q1 + 3]);
  v[5]  = cmulc(v[5],  make_float2(C8, -S8));
  v[9]  = cmulc(v[9],  make_float2(R2, -R2));
  v[13] = cmulc(v[13], make_float2(S8, -C8));
  v[6]  = cmulc(v[6],  make_float2(R2, -R2));
  v[10] = make_float2(-v[10].y, v[10].x);
  v[14] = cmulc(v[14], make_float2(-R2, -R2));
  v[7]  = cmulc(v[7],  make_float2(S8, -C8));
  v[11] = cmulc(v[11], make_float2(-R2, -R2));
  v[15] = cmulc(v[15], make_float2(-C8, S8));
#pragma unroll
  for (int r0 = 0; r0 < 4; ++r0) r4i(v[r0], v[r0 + 4], v[r0 + 8], v[r0 + 12]);
}
template <int M, bool INV>
DI void fft_pass16(float2* X) {
  constexpr int S = M / 16;
  static_assert(S == 1024 || S == 64, "addressing below assumes these two sizes");
  const int tid = threadIdx.x;
#pragma unroll 1
  for (int u = 0; u < 2; ++u) {
    const int bf = tid + 512 * u;
    int j = bf % S; const int b = (bf / S) * M;
    asm volatile("" : "+v"(j));
    int pa4[4];
    if (S >= 256) { pa4[0] = b + (j ^ ((j >> 4) & 15)); pa4[1] = pa4[0]; pa4[2] = pa4[0]; pa4[3] = pa4[0]; }
    else {
      const int low = (j & 15) ^ ((j >> 4) & 3);
#pragma unroll
      for (int q = 0; q < 4; ++q) pa4[q] = b + (j & 48) + (low ^ (q << 2));
    }
    float2 v[16];
#pragma unroll
    for (int r = 0; r < 16; ++r) v[r] = X[pa4[r & 3] + r * S];
    const float2 w1 = twid((float)j * (1.0f / (float)M));
    if (!INV) {
      fft16_fwd(v);
      float2 cur = w1;
#pragma unroll
      for (int f = 1; f < 16; ++f) {
        const int slot = ((f & 3) << 2) | (f >> 2);
        v[slot] = cmul(v[slot], cur);
        cur = cmul(cur, w1);
      }
    } else {
      float2 cur = w1;
#pragma unroll
      for (int f = 1; f < 16; ++f) {
        const int slot = ((f & 3) << 2) | (f >> 2);
        v[slot] = cmulc(v[slot], cur);
        cur = cmul(cur, w1);
      }
      fft16_inv(v);
    }
#pragma unroll
    for (int r = 0; r < 16; ++r) X[pa4[r & 3] + r * S] = v[r];
  }
}
template <bool INV>
DI void fft_pass4_64(float2* X) {
  const int tid = threadIdx.x;
#pragma unroll 1
  for (int u = 0; u < 8; ++u) {
    const int bf = tid + 512 * u;
    int j = bf & 15; const int b = (bf >> 4) * 64;
    asm volatile("" : "+v"(j));
    const int xb = ((bf >> 4) & 3) << 2;
    float2* p0 = X + b + (j ^ xb); float2* p1 = X + b + 16 + (j ^ (xb | 1)); float2* p2 = X + b + 32 + (j ^ (xb | 2)); float2* p3 = X + b + 48 + (j ^ (xb | 3));
    float2 a0 = *p0, a1 = *p1, a2 = *p2, a3 = *p3;
    const float2 w1 = twid((float)j * (1.0f / 64.f));
    const float2 w2 = cmul(w1, w1), w3 = cmul(w2, w1);
    if (!INV) {
      r4f(a0, a1, a2, a3);
      a1 = cmul(a1, w1); a2 = cmul(a2, w2); a3 = cmul(a3, w3);
    } else {
      a1 = cmulc(a1, w1); a2 = cmulc(a2, w2); a3 = cmulc(a3, w3);
      r4i(a0, a1, a2, a3);
    }
    *p0 = a0; *p1 = a1; *p2 = a2; *p3 = a3;
  }
}
DI void fft_fwd_head(float2* X) {
  __syncthreads();
  fft_pass16<16384, false>(X); __syncthreads();
  fft_pass16<1024, false>(X);  __syncthreads();
  fft_pass4_64<false>(X);      __syncthreads();
}
DI void fft_inv_tail(float2* X) {
  __syncthreads();
  fft_pass4_64<true>(X);       __syncthreads();
  fft_pass16<1024, true>(X);   __syncthreads();
  fft_pass16<16384, true>(X);  __syncthreads();
}
DI int PX(int idx) { return idx ^ ((idx >> 4) & 15); }
DI int pos14(int k) {
  unsigned r = __brev((unsigned)k) >> 18;
  return (int)(((r & 0x1555u) << 1) | ((r >> 1) & 0x1555u));
}
DI void conv3_8(const u16* row, int tl, int L, float w0, float w1, float w2, float* out) {
  const u32x4 c = *(const u32x4*)(row + tl);
  float f[10];
  unpack8(c, f + 1);
  f[0] = (tl > 0) ? bf2f(row[tl - 1]) : 0.f;
  f[9] = (tl + 8 < L) ? bf2f(row[tl + 8]) : 0.f;
#pragma unroll
  for (int i = 0; i < 8; ++i) out[i] = w0 * f[i] + w1 * f[i + 1] + w2 * f[i + 2];
}


template <int I> struct IC { static constexpr int v = I; };
template <bool FIXED>
DI void attn_item(const u16* __restrict__ Q, const u16* __restrict__ Kb, const u16* __restrict__ Vt, u16* __restrict__ mix,
                  int t0, int L, int h, int qb, float M0, char* smem, int tid) {
  const int lane = tid & 63, wid = tid >> 6, l31 = lane & 31, hh = lane >> 5;
  const int tq = t0 + qb * 256 + wid * 32 + l31;
  bf16x8 qf[6];
#pragma unroll
  for (int ks = 0; ks < 6; ++ks) qf[ks] = *(const bf16x8*)(Q + (long)tq * 768 + h * 96 + ks * 16 + hh * 8);
  f32x16 o[2];
#pragma unroll
  for (int i = 0; i < 16; ++i) { o[0][i] = 0.f; o[1][i] = 0.f; }
  float m_run = FIXED ? M0 : -1e30f, l_run = 0.f;
  u32x4 rk[3], rv[2];
  const u16* gK[3]; int sK[3];
#pragma unroll
  for (int i = 0; i < 3; ++i) {
    const int id = tid + 512 * i, row = id / 12, c = id % 12;
    gK[i] = Kb + (long)(t0 + row) * 768 + h * 96 + c * 8;
    sK[i] = row * 208 + c * 16;
  }
  const u16* gV[2]; int sV[2];
#pragma unroll
  for (int i = 0; i < 2; ++i) {
    const int id = tid + 512 * i, dv = id >> 4, c = id & 15;
    gV[i] = Vt + (long)(h * 64 + dv) * T_TOK + t0 + c * 8;
    sV[i] = 26624 + dv * 264 + c * 16;
  }
  const int ntile = L >> 7;
#pragma unroll
  for (int i = 0; i < 3; ++i) rk[i] = *(const u32x4*)(gK[i]);
#pragma unroll
  for (int i = 0; i < 2; ++i) rv[i] = *(const u32x4*)(gV[i]);
#pragma unroll
  for (int i = 0; i < 3; ++i) *(u32x4*)(smem + sK[i]) = rk[i];
#pragma unroll
  for (int i = 0; i < 2; ++i) { u32x2 a, b; a[0] = rv[i][0]; a[1] = rv[i][1]; b[0] = rv[i][2]; b[1] = rv[i][3];
    *(u32x2*)(smem + sV[i]) = a; *(u32x2*)(smem + sV[i] + 8) = b; }
  __syncthreads();
#define AT_QK(S, half, k2, ks) S[k2] = __builtin_amdgcn_mfma_f32_32x32x16_bf16( \
    *(const bf16x8*)(Ks + ((half) * 64 + (k2) * 32 + l31) * 208 + ((ks) * 2 + hh) * 16), qf[ks], S[k2], 0, 0, 0)
#define AT_PV(half, k2, st, dvt, PB) do { const char* ad_ = Vs + ((dvt) * 32 + l31) * 264 + ((half) * 64 + (k2) * 32 + (st) * 16 + hh * 4) * 2; \
    const s16x4 lo_ = *(const s16x4*)(ad_); const s16x4 hi_ = *(const s16x4*)(ad_ + 16); \
    o[dvt] = __builtin_amdgcn_mfma_f32_32x32x16_bf16(__builtin_shufflevector(lo_, hi_, 0, 1, 2, 3, 4, 5, 6, 7), PB, o[dvt], 0, 0, 0); } while (0)
#define AT_PACK(S, k2, st) __builtin_bit_cast(bf16x8, (u32x4){pack2(S[k2][8 * (st) + 0], S[k2][8 * (st) + 1]), pack2(S[k2][8 * (st) + 2], S[k2][8 * (st) + 3]), \
    pack2(S[k2][8 * (st) + 4], S[k2][8 * (st) + 5]), pack2(S[k2][8 * (st) + 6], S[k2][8 * (st) + 7])})
  for (int kt = 0; kt < ntile; ++kt) {
    if (kt + 1 < ntile) {
#pragma unroll
      for (int i = 0; i < 3; ++i) rk[i] = *(const u32x4*)(gK[i] + (long)(kt + 1) * 128 * 768);
#pragma unroll
      for (int i = 0; i < 2; ++i) rv[i] = *(const u32x4*)(gV[i] + (kt + 1) * 128);
    }
    const char* Ks = smem + (kt & 1) * 43520;
    const char* Vs = Ks + 26624;
    if (FIXED) {
#define AT_D 3
#define AT_KF(half, k2, ks) (*(const bf16x8*)(Ks + ((half) * 64 + (k2) * 32 + l31) * 208 + ((ks) * 2 + hh) * 16))
#define AT_VADDR(half, step) (Vs + (((step) & 1) * 32 + l31) * 264 + ((half) * 64 + ((step) >> 2) * 32 + (((step) >> 1) & 1) * 16 + hh * 4) * 2)
#define AT_VF(half, step) __builtin_shufflevector(*(const s16x4*)(AT_VADDR(half, step)), *(const s16x4*)(AT_VADDR(half, step) + 16), 0, 1, 2, 3, 4, 5, 6, 7)
#define AT_RD(i) (((i) < 12) ? AT_KF(0, (i) & 1, (i) >> 1) : ((i) < 24) ? AT_KF(1, ((i) - 12) & 1, ((i) - 12) >> 1) : ((i) < 32) ? AT_VF(0, (i) - 24) : AT_VF(1, (i) - 32))
      f32x16 sa[2], sb[2];
      const float ninit = -M0;
#pragma unroll
      for (int i = 0; i < 16; ++i) { sa[0][i] = ninit; sa[1][i] = ninit; sb[0][i] = ninit; sb[1][i] = ninit; }
      bf16x8 fr[40];
      bf16x8 pa[2][2];
      float rsum = 0.f;
#pragma unroll
      for (int i = 0; i < AT_D; ++i) fr[i] = AT_RD(i);
      auto at_step = [&](auto ic) {
        constexpr int i = decltype(ic)::v;
        if (i + AT_D < 40) fr[(i + AT_D) % 40] = AT_RD(i + AT_D);
        if (i < 12) {
          sa[i & 1] = __builtin_amdgcn_mfma_f32_32x32x16_bf16(fr[i], qf[i >> 1], sa[i & 1], 0, 0, 0);
        } else if (i < 24) {
          const int j = i - 12;
          sb[j & 1] = __builtin_amdgcn_mfma_f32_32x32x16_bf16(fr[i], qf[j >> 1], sb[j & 1], 0, 0, 0);
#pragma unroll
          for (int e = j * 3; e < j * 3 + 3; ++e) if (e < 32) { const float pv = __builtin_amdgcn_exp2f(sa[e >> 4][e & 15]); sa[e >> 4][e & 15] = pv; rsum += pv; }
          if (j == 11) {
#pragma unroll
            for (int k2 = 0; k2 < 2; ++k2)
#pragma unroll
              for (int st = 0; st < 2; ++st) pa[k2][st] = AT_PACK(sa, k2, st);
          }
        } else if (i < 32) {
          const int j = i - 24;
          o[j & 1] = __builtin_amdgcn_mfma_f32_32x32x16_bf16(fr[i], pa[j >> 2][(j >> 1) & 1], o[j & 1], 0, 0, 0);
#pragma unroll
          for (int e = j * 4; e < j * 4 + 4; ++e) { const float pv = __builtin_amdgcn_exp2f(sb[e >> 4][e & 15]); sb[e >> 4][e & 15] = pv; rsum += pv; }
        } else {
          const int j = i - 32;
          if (j == 0) {
#pragma unroll
            for (int k2 = 0; k2 < 2; ++k2)
#pragma unroll
              for (int st = 0; st < 2; ++st) pa[k2][st] = AT_PACK(sb, k2, st);
          }
          o[j & 1] = __builtin_amdgcn_mfma_f32_32x32x16_bf16(fr[i], pa[j >> 2][(j >> 1) & 1], o[j & 1], 0, 0, 0);
        }
#ifdef AT_PIN
        __builtin_amdgcn_sched_barrier(0);
#endif
      };
#define AT_S4(b) at_step(IC<(b)>{}); at_step(IC<(b) + 1>{}); at_step(IC<(b) + 2>{}); at_step(IC<(b) + 3>{});
      AT_S4(0) AT_S4(4) AT_S4(8) AT_S4(12) AT_S4(16) AT_S4(20) AT_S4(24) AT_S4(28) AT_S4(32) AT_S4(36)
#undef AT_S4
      l_run += rsum;
#undef AT_D
#undef AT_KF
#undef AT_VADDR
#undef AT_VF
#undef AT_RD
    } else {
#pragma unroll
      for (int half = 0; half < 2; ++half) {
        f32x16 s[2];
#pragma unroll
        for (int i = 0; i < 16; ++i) { s[0][i] = 0.f; s[1][i] = 0.f; }
#pragma unroll
        for (int ks = 0; ks < 6; ++ks) { AT_QK(s, half, 0, ks); AT_QK(s, half, 1, ks); }
        float mloc = s[0][0];
#pragma unroll
        for (int i = 1; i < 16; ++i) mloc = fmaxf(mloc, s[0][i]);
#pragma unroll
        for (int i = 0; i < 16; ++i) mloc = fmaxf(mloc, s[1][i]);
        mloc = fmaxf(mloc, __shfl_xor(mloc, 32));
        const bool need = mloc > m_run + 8.f;
        if (__builtin_amdgcn_ballot_w64(need) != 0ull) {
          const float mnew = need ? mloc : m_run;
          const float alpha = __builtin_amdgcn_exp2f(m_run - mnew);
          m_run = mnew;
          l_run *= alpha;
#pragma unroll
          for (int i = 0; i < 16; ++i) { o[0][i] *= alpha; o[1][i] *= alpha; }
        }
        float rsum = 0.f;
#pragma unroll
        for (int k2 = 0; k2 < 2; ++k2)
#pragma unroll
          for (int i = 0; i < 16; ++i) { const float pv = __builtin_amdgcn_exp2f(s[k2][i] - m_run); s[k2][i] = pv; rsum += pv; }
        l_run += rsum;
#pragma unroll
        for (int k2 = 0; k2 < 2; ++k2)
#pragma unroll
          for (int st = 0; st < 2; ++st) {
            const bf16x8 pb = AT_PACK(s, k2, st);
            AT_PV(half, k2, st, 0, pb);
            AT_PV(half, k2, st, 1, pb);
          }
      }
    }
    if (kt + 1 < ntile) {
      char* d = smem + ((kt + 1) & 1) * 43520;
#pragma unroll
      for (int i = 0; i < 3; ++i) *(u32x4*)(d + sK[i]) = rk[i];
#pragma unroll
      for (int i = 0; i < 2; ++i) { u32x2 a, b; a[0] = rv[i][0]; a[1] = rv[i][1]; b[0] = rv[i][2]; b[1] = rv[i][3];
        *(u32x2*)(d + sV[i]) = a; *(u32x2*)(d + sV[i] + 8) = b; }
    }
    __syncthreads();
  }
#undef AT_QK
#undef AT_PV
#undef AT_PACK
  const float ltot = l_run + __shfl_xor(l_run, 32);
  const float inv = 1.f / ltot;
#pragma unroll
  for (int dvt = 0; dvt < 2; ++dvt)
#pragma unroll
    for (int g = 0; g < 4; ++g) {
      u32x2 w;
      w[0] = pack2(o[dvt][4 * g] * inv, o[dvt][4 * g + 1] * inv);
      w[1] = pack2(o[dvt][4 * g + 2] * inv, o[dvt][4 * g + 3] * inv);
      *(u32x2*)(mix + (long)tq * 1024 + 512 + h * 64 + dvt * 32 + 8 * g + 4 * hh) = w;
    }
}

DI void grid_bar(unsigned* bw, unsigned& epoch, unsigned G) {
  asm volatile("s_waitcnt vmcnt(0)" ::: "memory");
  __syncthreads();
  if (threadIdx.x == 0) {
    __builtin_amdgcn_fence(__ATOMIC_RELEASE, "agent");
    asm volatile("s_waitcnt vmcnt(0)" ::: "memory");
    epoch += 1u;
    const unsigned g = blockIdx.x & 7u, ng = (G + 7u - g) >> 3;
    const unsigned old = __hip_atomic_fetch_add(bw + 64 * g, 1u, __ATOMIC_RELAXED, __HIP_MEMORY_SCOPE_AGENT);
    if (old + 1u == ng * epoch) {
      const unsigned ngrp = G < 8u ? G : 8u;
      const unsigned t = __hip_atomic_fetch_add(bw + 64 * 8, 1u, __ATOMIC_RELAXED, __HIP_MEMORY_SCOPE_AGENT);
      if (t + 1u == ngrp * epoch) __hip_atomic_store(bw + 64 * 9, epoch, __ATOMIC_RELAXED, __HIP_MEMORY_SCOPE_AGENT);
    }
    unsigned spins = 0;
    while (__hip_atomic_load(bw + 64 * 9, __ATOMIC_RELAXED, __HIP_MEMORY_SCOPE_AGENT) < epoch) {
      __builtin_amdgcn_s_sleep(1);
      if (++spins > (1u << 24)) break;
    }
    __builtin_amdgcn_fence(__ATOMIC_ACQUIRE, "agent");
    asm volatile("s_waitcnt vmcnt(0)" ::: "memory");
  }
  __syncthreads();
}


__global__ void __launch_bounds__(NTHR) __attribute__((target("no-packed-fp32-ops"))) fwd_kernel(Params p) {
  __shared__ __attribute__((aligned(16))) char smem[163840];
  cg::grid_group grid = cg::this_grid();
  const int G = gridDim.x, bid = blockIdx.x;
  const int vb = (bid & 7) * (G >> 3) + (bid >> 3);
  const int NW = G * 8;
  const long GT = (long)G * NTHR;
#define PHASE_IDS int tid = threadIdx.x; asm volatile("" : "+v"(tid)); const int lane = tid & 63, wid = tid >> 6; \
  const int gw = bid * 8 + wid; const long gtid = (long)bid * NTHR + tid; (void)lane; (void)gw; (void)gtid;
  char* ws = p.ws;
  char* dsc = (char*)p.out;
  float* rowss = (float*)(ws + SM_ROWSS);
  u16* XB = (u16*)(ws + OFF_XB);
  unsigned* barcnt = (unsigned*)ws;
  unsigned bar_target = 0;
  if (p.ws == nullptr) grid.sync();
  PG8_LAS unsigned char* lds = (PG8_LAS unsigned char*)smem;

  if (PHM & (1 << 0)) {
    PHASE_IDS
    {
#define CW_LIST(X) \
      X(0, p.in[7], p.in[7], 1952, 1024, 2048, W0_IN, p.in[2], 0) \
      X(1, p.in[11], p.in[11], 768, 256, 768, W0_Q, p.in[2], 4) \
      X(2, p.in[12], p.in[12], 1024, 128, 512, W0_K, p.in[2], 5) \
      X(3, p.in[12], p.in[12], 1024, 128, 512, W0_V, p.in[2], 6) \
      X(4, p.in[15], p.in[15], 1024, 1024, 1024, W0_OUT, p.in[2], 4) \
      X(5, p.in[4], p.in[5], 2816, 1024, 5632, W0_GU, p.in[3], 3) \
      X(6, p.in[6], p.in[6], 1024, 2816, 1024, W0_D, p.in[2], 4) \
      X(7, p.in[16], p.in[16], 3072, 1024, 3072, W1_CIN, (p.in[2] + 1024), 0) \
      X(8, p.in[27], p.in[27], 1024, 1024, 1024, W1_COUT, p.in[2], 4) \
      X(9, p.in[25], p.in[25], 2048, 64, 2048, W1_W4, p.in[2], 4) \
      X(10, (p.in[4] + 1024 * 2816), (p.in[5] + 1024 * 2816), 2816, 1024, 5632, W1_GU, (p.in[3] + 1024), 3) \
      X(11, (p.in[6] + 2816 * 1024), (p.in[6] + 2816 * 1024), 1024, 2816, 1024, W1_D, p.in[2], 4)
      int total = 0;
#define CW_CNT(i, s1, s2, ns, k, np, off, g, kind) const int cw_start##i = total; total += (np) * ((k) >> 3);
      CW_LIST(CW_CNT)
#undef CW_CNT
#pragma unroll 4
      for (int it = (int)gtid; it < total; it += (int)GT) {
        const float* s1 = nullptr; const float* s2 = nullptr; const float* gp = nullptr; u16* dst = nullptr;
        int Nsrc = 0, K = 0, Np = 1, kind = 0, st = 0;
#define CW_SEL(i, a1, a2, ns, k, np, off, g, kd) if (it >= cw_start##i) { s1 = a1; s2 = a2; gp = g; dst = (u16*)(ws + off); Nsrc = ns; K = k; Np = np; kind = kd; st = cw_start##i; }
        CW_LIST(CW_SEL)
#undef CW_SEL
        const int li = it - st;
        const int np = li % Np, kc = li / Np;
        const float* sp = s1; int n = np; bool valid = true;
        if (kind == 0) valid = np < Nsrc;
        else if (kind == 5) n = (np >> 6) * 128 + (np & 63);
        else if (kind == 6) n = (np >> 6) * 128 + 64 + (np & 63);
        else if (kind == 3) { const int g = np >> 5, w = np & 31; sp = (w < 16) ? s1 : s2; n = g * 16 + (w & 15); }
        const bool hasg = (kind == 0) || (kind == 3);
        float f[8];
#pragma unroll
        for (int j = 0; j < 8; ++j) {
          const int k = kc * 8 + j;
          float v = valid ? __builtin_nontemporal_load(sp + (long)k * Nsrc + n) : 0.f;
          const float gv = hasg ? gp[k] : 1.f;
          f[j] = v * gv;
        }
        *(u32x4*)(dst + (long)np * K + kc * 8) = pack8(f);
      }
#undef CW_LIST
    }
    for (int row0 = gw * 4; row0 < T_TOK; row0 += NW * 4) {
      float4 va[4][4];
#pragma unroll
      for (int r = 0; r < 4; ++r) {
        const int row = row0 + r;
        const float* xr = (row < 16384) ? (p.in[0] + (long)row * DM) : (p.in[1] + (long)(row - 16384) * DM);
#pragma unroll
        for (int hb = 0; hb < 2; ++hb) {
          const f32x4 q0 = __builtin_nontemporal_load((const f32x4*)(xr + hb * 512 + lane * 8));
          const f32x4 q1 = __builtin_nontemporal_load((const f32x4*)(xr + hb * 512 + lane * 8 + 4));
          va[r][2 * hb] = make_float4(q0[0], q0[1], q0[2], q0[3]); va[r][2 * hb + 1] = make_float4(q1[0], q1[1], q1[2], q1[3]);
        }
      }
#pragma unroll
      for (int r = 0; r < 4; ++r) {
        const int row = row0 + r;
        float ss = 0.f;
#pragma unroll
        for (int hb = 0; hb < 2; ++hb) {
          const float4 a = va[r][2 * hb], b = va[r][2 * hb + 1];
          ss += a.x * a.x + a.y * a.y + a.z * a.z + a.w * a.w + b.x * b.x + b.y * b.y + b.z * b.z + b.w * b.w;
          u32x4 o; o[0] = pack2(a.x, a.y); o[1] = pack2(a.z, a.w); o[2] = pack2(b.x, b.y); o[3] = pack2(b.z, b.w);
          *(u32x4*)(XB + (long)row * DM + hb * 512 + lane * 8) = o;
        }
        ss = wave_sum(ss);
        if (lane == 0) rowss[row] = ss;
      }
    }
    for (long i = gtid; i < 3 * T_TOK; i += GT) rowss[T_TOK + i] = 0.f;
    float2* rope = (float2*)(ws + R_ROPE);
    for (long e = gtid; e < 16384 * 16; e += GT) {
      const int pos = (int)(e >> 4), i = (int)(e & 15);
      const int lo = i & 3, hi = i >> 2;
      const double base = (lo == 0) ? 1.0 : (lo == 1) ? 0.5623413251903491 : (lo == 2) ? 0.31622776601683794 : 0.1778279410038923;
      const double sc = (hi == 0) ? 1.0 : (hi == 1) ? 0.1 : (hi == 2) ? 0.01 : 0.001;
      double rev = (double)pos * (base * sc) * 0.15915494309189535;
      rev -= floor(rev);
      const float rf = (float)rev;
      rope[e] = make_float2(__builtin_amdgcn_cosf(rf), __builtin_amdgcn_sinf(rf));
    }

    {
      const float* w1 = p.in[18]; const float* b1 = p.in[19];
      const float* w2 = p.in[20]; const float* b2 = p.in[21];
      const float* w3 = p.in[22]; const float* b3 = p.in[23];
      const float* fq = p.in[24];
      const float INV2PI = 0.15915494309189535f;
      float w1c[33], w2c[64], w3c[64];
#pragma unroll
      for (int k = 0; k < 33; ++k) w1c[k] = w1[k * 64 + lane];
#pragma unroll
      for (int k = 0; k < 64; ++k) { w2c[k] = w2[k * 64 + lane]; w3c[k] = w3[k * 64 + lane]; }
      const float bb1 = b1[lane], bb2 = b2[lane], bb3 = b3[lane];
      const float f1 = fq[lane] * INV2PI, f2 = fq[64 + lane] * INV2PI, f3 = fq[128 + lane] * INV2PI;
#pragma unroll 1
      for (int rg = 0; rg < 3; ++rg) {
        const int rbase = gw * 12 + rg * 4;
        if (rbase < 24576) {
          float zr[4], acc[4];
#pragma unroll
          for (int r = 0; r < 4; ++r) {
            const int rr = rbase + r;
            const int Lf = (rr < 8192) ? 8192 : 16384;
            const int l = (rr < 8192) ? rr : (rr - 8192);
            const float tpos = (float)l / (float)(Lf - 1);
            const float frac = (float)l / (float)Lf;
            const int bi = (lane >= 17) ? (lane - 17) : (lane - 1);
            const float band = 1e-4f + (float)bi * ((15.f - 1e-4f) / 15.f);
            const float rev = frac * band;
            zr[r] = (lane == 0) ? tpos : ((lane <= 16) ? __builtin_amdgcn_cosf(rev) : -__builtin_amdgcn_sinf(rev));
            acc[r] = bb1;
          }
#pragma unroll
          for (int k = 0; k < 33; ++k)
#pragma unroll
            for (int r = 0; r < 4; ++r) acc[r] += __int_as_float(__builtin_amdgcn_readlane(__float_as_int(zr[r]), k)) * w1c[k];
#pragma unroll
          for (int r = 0; r < 4; ++r) { zr[r] = __builtin_amdgcn_sinf(f1 * acc[r]); acc[r] = bb2; }
#pragma unroll
          for (int k = 0; k < 64; ++k)
#pragma unroll
            for (int r = 0; r < 4; ++r) acc[r] += __int_as_float(__builtin_amdgcn_readlane(__float_as_int(zr[r]), k)) * w2c[k];
#pragma unroll
          for (int r = 0; r < 4; ++r) { zr[r] = __builtin_amdgcn_sinf(f2 * acc[r]); acc[r] = bb3; }
#pragma unroll
          for (int k = 0; k < 64; ++k)
#pragma unroll
            for (int r = 0; r < 4; ++r) acc[r] += __int_as_float(__builtin_amdgcn_readlane(__float_as_int(zr[r]), k)) * w3c[k];
          u16* z3 = (u16*)(ws + SM_Z3);
#pragma unroll
          for (int r = 0; r < 4; ++r) z3[(long)(rbase + r) * 64 + lane] = f2bf(__builtin_amdgcn_sinf(f3 * acc[r]));
        }
      }
    }
  }
  grid_bar(barcnt, bar_target, (unsigned)G);

  for (int rep = 0; rep < REP1; ++rep) if (PHM & (1 << 1)) {
    pg8::Gemm g{XB, (const u16*)(ws + W0_IN), T_TOK, 2048, DM};
    pg8::StaticOrder S; S.init(T_TOK, 2048, G, bid);
    EpiRowScaleBf16 E{(u16*)dsc, 2048, rowss};
    pg8::gemm_phase<EpiRowScaleBf16, pg8::StaticOrder>(lds, g, S, E, nullptr);
  }
  grid_bar(barcnt, bar_target, (unsigned)G);

  if (PHM & (1 << 2)) {
    PHASE_IDS
    const u16* proj = (const u16*)dsc;
    u16* mix = (u16*)(ws + R_MIX);
    u16* cqn = (u16*)(ws + R_CQN);
    u16* ckvn = (u16*)(ws + R_CKVN);
    u16* kpe = (u16*)(ws + R_KPE);
    float* sskpe = (float*)(ws + SM_SSKPE);
    const float* cw = p.in[8];
    float w0[8], w1[8], w2[8];
#pragma unroll
    for (int i = 0; i < 8; ++i) { w0[i] = cw[(lane * 8 + i) * 3]; w1[i] = cw[(lane * 8 + i) * 3 + 1]; w2[i] = cw[(lane * 8 + i) * 3 + 2]; }
    float gq[4], gk[2];
#pragma unroll
    for (int i = 0; i < 4; ++i) gq[i] = p.in[9][lane * 4 + i];
    gk[0] = p.in[10][lane * 2]; gk[1] = p.in[10][lane * 2 + 1];
    for (int t = gw; t < T_TOK; t += NW) {
      int t0, L; seq_of(t, t0, L);
      const u16* pr = proj + (long)t * 2048;
      const int c = lane * 8;
      float gb[8], mc[8], mp[8], mn[8], a[8], b[8];
      unpack8(*(const u32x4*)(pr + c), gb);
      unpack8(*(const u32x4*)(pr + 512 + c), a); unpack8(*(const u32x4*)(pr + 1024 + c), b);
#pragma unroll
      for (int i = 0; i < 8; ++i) mc[i] = a[i] * b[i];
      if (t > t0) {
        unpack8(*(const u32x4*)(pr - 2048 + 512 + c), a); unpack8(*(const u32x4*)(pr - 2048 + 1024 + c), b);
#pragma unroll
        for (int i = 0; i < 8; ++i) mp[i] = a[i] * b[i];
      } else {
#pragma unroll
        for (int i = 0; i < 8; ++i) mp[i] = 0.f;
      }
      if (t < t0 + L - 1) {
        unpack8(*(const u32x4*)(pr + 2048 + 512 + c), a); unpack8(*(const u32x4*)(pr + 2048 + 1024 + c), b);
#pragma unroll
        for (int i = 0; i < 8; ++i) mn[i] = a[i] * b[i];
      } else {
#pragma unroll
        for (int i = 0; i < 8; ++i) mn[i] = 0.f;
      }
      float y[8];
#pragma unroll
      for (int i = 0; i < 8; ++i) y[i] = gb[i] * (w0[i] * mp[i] + w1[i] * mc[i] + w2[i] * mn[i]);
      *(u32x4*)(mix + (long)t * 1024 + c) = pack8(y);
      {
        const u32x2 v = *(const u32x2*)(pr + 1536 + lane * 4);
        float f0 = lo_bf(v[0]), f1 = hi_bf(v[0]), f2 = lo_bf(v[1]), f3 = hi_bf(v[1]);
        const float ss = wave_sum(f0 * f0 + f1 * f1 + f2 * f2 + f3 * f3);
        const float rs = rsqrtf(ss * (1.f / 256.f) + EPSN);
        u32x2 o; o[0] = pack2(f0 * rs * gq[0], f1 * rs * gq[1]); o[1] = pack2(f2 * rs * gq[2], f3 * rs * gq[3]);
        *(u32x2*)(cqn + (long)t * 256 + lane * 4) = o;
      }
      {
        const unsigned v = *(const unsigned*)(pr + 1792 + lane * 2);
        float f0 = lo_bf(v), f1 = hi_bf(v);
        const float ss = wave_sum(f0 * f0 + f1 * f1);
        const float rs = rsqrtf(ss * (1.f / 128.f) + EPSN);
        *(unsigned*)(ckvn + (long)t * 128 + lane * 2) = pack2(f0 * rs * gk[0], f1 * rs * gk[1]);
      }
      {
        const unsigned v = (lane < 16) ? *(const unsigned*)(pr + 1920 + lane * 2) : 0u;
        if (lane < 16) *(unsigned*)(kpe + (long)t * 32 + lane * 2) = v;
        const float f0 = lo_bf(v), f1 = hi_bf(v);
        const float ss = wave_sum(f0 * f0 + f1 * f1);
        if (lane == 0) sskpe[t] = ss;
      }
    }
  }
  grid_bar(barcnt, bar_target, (unsigned)G);

  if (PHM & (1 << 3)) {
    PHASE_IDS
    const u16* cqn = (const u16*)(ws + R_CQN);
    const u16* ckvn = (const u16*)(ws + R_CKVN);
    const u16* kpe = (const u16*)(ws + R_KPE);
    const float* sskpe = (const float*)(ws + SM_SSKPE);
    const float2* rope = (const float2*)(ws + R_ROPE);
    u16* Qo = (u16*)(dsc + D_QRAW);
    u16* Kb = (u16*)(ws + R_K);
    u16* Vt = (u16*)(dsc + D_VT);
    const float* qn = p.in[13]; const float* kn = p.in[14];
    const float qscale = 0.10206207261596577f * 1.4426950408889634f;
    for (int tile = vb; tile < 512 + 512 + 512; tile += G) {
      if (tile < 512) {
        const int tm = tile >> 2, tn = tile & 3;
        gemm_tile<6>(cqn + (long)tm * 256 * 256, 256, (const u16*)(ws + W0_Q) + (long)tn * 192 * 256, 256, 256, smem,
          [&](f32x4 (&acc)[4][6], int r0, int c0) {
            const int fr_ = c0 % 96, h = tn * 2 + c0 / 96;
#pragma unroll
            for (int mi = 0; mi < 4; ++mi)
#pragma unroll
              for (int j = 0; j < 4; ++j) {
                const int row = tm * 256 + r0 + mi * 16 + j;
                float ss = 0.f;
#pragma unroll
                for (int ni = 0; ni < 6; ++ni) ss += acc[mi][ni][j] * acc[mi][ni][j];
                ss += __shfl_xor(ss, 8); ss += __shfl_xor(ss, 4); ss += __shfl_xor(ss, 2); ss += __shfl_xor(ss, 1);
                const float rs = rsqrtf(ss * (1.f / 96.f) + EPSN) * qscale;
                int t0, L; seq_of(row, t0, L);
                const float2 cs = rope[(long)(row - t0) * 16 + fr_];
                u16* qp = Qo + (long)row * 768 + h * 96 + fr_;
#pragma unroll
                for (int ni = 0; ni < 4; ++ni) qp[ni * 16] = f2bf(acc[mi][ni][j] * rs * qn[ni * 16 + fr_]);
                const float x1 = acc[mi][4][j] * rs * qn[64 + fr_], x2 = acc[mi][5][j] * rs * qn[80 + fr_];
                qp[64] = f2bf(x1 * cs.x - x2 * cs.y);
                qp[80] = f2bf(x1 * cs.y + x2 * cs.x);
              }
          });
      } else if (tile < 1024) {
        const int tt = tile - 512, tm = tt >> 2, tn = tt & 3;
        gemm_tile<4>(ckvn + (long)tm * 256 * 128, 128, (const u16*)(ws + W0_K) + (long)tn * 128 * 128, 128, 128, smem,
          [&](f32x4 (&acc)[4][4], int r0, int c0) {
            const int fr_ = c0 & 63, h = tn * 2 + (c0 >> 6);
#pragma unroll
            for (int mi = 0; mi < 4; ++mi)
#pragma unroll
              for (int j = 0; j < 4; ++j) {
                const int row = tm * 256 + r0 + mi * 16 + j;
                float ss = 0.f;
#pragma unroll
                for (int ni = 0; ni < 4; ++ni) ss += acc[mi][ni][j] * acc[mi][ni][j];
                ss += __shfl_xor(ss, 8); ss += __shfl_xor(ss, 4); ss += __shfl_xor(ss, 2); ss += __shfl_xor(ss, 1);
                const float rs = rsqrtf((ss + sskpe[row]) * (1.f / 96.f) + EPSN);
                int t0, L; seq_of(row, t0, L);
                const float2 cs = rope[(long)(row - t0) * 16 + fr_];
                u16* kp = Kb + (long)row * 768 + h * 96 + fr_;
#pragma unroll
                for (int ni = 0; ni < 4; ++ni) kp[ni * 16] = f2bf(acc[mi][ni][j] * rs * kn[ni * 16 + fr_]);
                const float x1 = bf2f(kpe[(long)row * 32 + fr_]) * rs * kn[64 + fr_], x2 = bf2f(kpe[(long)row * 32 + 16 + fr_]) * rs * kn[80 + fr_];
                kp[64] = f2bf(x1 * cs.x - x2 * cs.y);
                kp[80] = f2bf(x1 * cs.y + x2 * cs.x);
              }
          });
      } else {
        const int tt = tile - 1024, tm = tt & 1, tn = tt >> 1;
        gemm_tile<4>((const u16*)(ws + W0_V) + (long)tm * 256 * 128, 128, ckvn + (long)tn * 128 * 128, 128, 128, smem,
          [&](f32x4 (&acc)[4][4], int r0, int c0) {
#pragma unroll
            for (int mi = 0; mi < 4; ++mi)
#pragma unroll
              for (int j = 0; j < 4; ++j)
#pragma unroll
                for (int ni = 0; ni < 4; ++ni)
                  Vt[(long)(tm * 256 + r0 + mi * 16 + j) * T_TOK + tn * 128 + c0 + ni * 16] = f2bf(acc[mi][ni][j]);
          });
      }
    }
  }
  grid_bar(barcnt, bar_target, (unsigned)G);

  for (int rep = 0; rep < REP5; ++rep) if (PHM & (1 << 5)) {
    PHASE_IDS
    const u16* Q = (const u16*)(dsc + D_QRAW);
    const u16* Kb = (const u16*)(ws + R_K);
    const u16* Vt = (const u16*)(dsc + D_VT);
    u16* mix = (u16*)(ws + R_MIX);
    float mq = 0.f, mk = 0.f;
    for (int i = 0; i < 96; ++i) { mq = fmaxf(mq, fabsf(p.in[13][i])); mk = fmaxf(mk, fabsf(p.in[14][i])); }
    const float M0 = 96.f * mq * mk * (0.10206207261596577f * 1.4426950408889634f) * 1.02f + 0.5f;
    const bool fixed_ref = M0 < 40.f;
    for (int item = vb; item < 1024; item += G) {
      int t0, L, h, qb;
      if (item < 512) { t0 = 16384; L = 16384; h = item >> 6; qb = item & 63; }
      else { const int it = item - 512; const int sq = it >> 8; t0 = sq * 8192; L = 8192; h = (it >> 5) & 7; qb = it & 31; }
      if (fixed_ref) attn_item<true>(Q, Kb, Vt, mix, t0, L, h, qb, M0, smem, tid);
      else attn_item<false>(Q, Kb, Vt, mix, t0, L, h, qb, M0, smem, tid);
    }
  }
  grid_bar(barcnt, bar_target, (unsigned)G);

  if (PHM & (1 << 6)) {
    pg8::Gemm g{(const u16*)(ws + R_MIX), (const u16*)(ws + W0_OUT), T_TOK, DM, DM};
    pg8::StaticOrder S; S.init(T_TOK, DM, G, bid);
    EpiResid E{XB, rowss + T_TOK};
    pg8::gemm_phase<EpiResid, pg8::StaticOrder>(lds, g, S, E, nullptr);
  }
  grid_bar(barcnt, bar_target, (unsigned)G);
  for (int rep = 0; rep < REP7; ++rep) if (PHM & (1 << 7)) {
    pg8::Gemm g{XB, (const u16*)(ws + W0_GU), T_TOK, 5632, DM};
    pg8::StaticOrder S; S.init(T_TOK, 5632, G, bid);
    EpiGU E{(u16*)(ws + OFF_R), (u16*)dsc, 16384, rowss + T_TOK, 0};
    pg8::gemm_phase<EpiGU, pg8::StaticOrder>(lds, g, S, E, nullptr);
  }
  grid_bar(barcnt, bar_target, (unsigned)G);
  if (PHM & (1 << 7)) {
    pg8::Gemm g{(const u16*)(ws + OFF_R), (const u16*)(ws + W0_D), T_TOK, DM, DFF};
    SplitOrder S; S.init(T_TOK, DM, G, bid); S.base2 = (const char*)dsc; S.split = 64;
    EpiResid E{XB, rowss + 2 * T_TOK};
    pg8::gemm_phase<EpiResid, SplitOrder>(lds, g, S, E, nullptr);
  }
  grid_bar(barcnt, bar_target, (unsigned)G);

  for (int rep = 0; rep < REP8; ++rep) if (PHM & (1 << 8)) {
    const u16* Wt = (const u16*)(ws + W1_CIN);
    u16* x0t = (u16*)(ws + C_X0T);
    u16* x1vt = (u16*)dsc;
    const float* ssq = rowss + 2 * T_TOK;
    {
      pg8::Gemm g{Wt, XB, 3072, T_TOK, DM};
      pg8::StaticOrder S; S.init(3072, T_TOK, G, bid);
      EpiCin E{x0t, x1vt, ssq};
      pg8::gemm_phase<EpiCin, pg8::StaticOrder>(lds, g, S, E, nullptr);
    }
    for (int tile = 3072 + vb; tile < 3072 + 1536; tile += G) {
      {
        const int tt = tile - 3072;
        const bool smp = tt >= 512;
        const int t2 = smp ? tt - 512 : tt;
        const int tm = t2 & 7, tn = t2 >> 3;
        const int Lf = smp ? 16384 : 8192;
        const u16* z3 = (const u16*)(ws + SM_Z3) + (smp ? (long)8192 * 64 : 0);
        u16* kern = smp ? (u16*)(ws + C_KS) : (u16*)(ws + C_KP);
        gemm_tile((const u16*)(ws + W1_W4) + (long)tm * 256 * 64, 64, z3 + (long)tn * 128 * 64, 64, 64, smem,
          [&](f32x4 (&acc)[4][4], int r0, int c0) {
            const float invLm1 = 1.f / (float)(Lf - 1);
#pragma unroll
            for (int mi = 0; mi < 4; ++mi)
#pragma unroll
              for (int j = 0; j < 4; ++j) {
                const int cp = tm * 256 + r0 + mi * 16 + j;
                const int ch = cp & 1023;
                const bool bwd = cp >= 1024;
                const float ad = 3.0701134573253945f + (float)ch * (12.280453829301578f / 1023.f);
                u16* kr = kern + (long)ch * (2 * Lf);
#pragma unroll
                for (int ni = 0; ni < 4; ++ni) {
                  const int l = tn * 128 + c0 + ni * 16;
                  const float wv = __expf(-(float)l * invLm1 * ad);
                  const float val = acc[mi][ni][j] * wv;
                  if (!bwd) kr[l] = f2bf(val);
                  else if (l > 0) kr[2 * Lf - l] = f2bf(val);
                  else kr[Lf] = 0;
                }
              }
          });
      }
    }
  }
  grid_bar(barcnt, bar_target, (unsigned)G);

  if (PHM & (1 << 9)) {
    PHASE_IDS
    float2* X = (float2*)smem;
    u16* zs = (u16*)(smem + 131072);
    const u16* x0t = (const u16*)(ws + C_X0T);
    u16* x1vt = (u16*)dsc;
    const float* sw = p.in[17];
    const float SCL = 1.f / 16384.f;
    for (int job = vb; job < 2048; job += G) {
      int tidj = threadIdx.x; asm volatile("" : "+v"(tidj));
      const int tid = tidj;
      const bool smp = job >= 1024;
      const int ch = job & 1023;
      const float w00 = sw[ch * 3], w01 = sw[ch * 3 + 1], w02 = sw[ch * 3 + 2];
      const float w10 = sw[(1024 + ch) * 3], w11 = sw[(1024 + ch) * 3 + 1], w12 = sw[(1024 + ch) * 3 + 2];
      const float w20 = sw[(2048 + ch) * 3], w21 = sw[(2048 + ch) * 3 + 1], w22 = sw[(2048 + ch) * 3 + 2];
      const float bias = p.in[26][ch];
      u16* x1row = x1vt + (long)ch * T_TOK;
      const u16* vrow = x1vt + (long)(1024 + ch) * T_TOK;
      const u16* x0row = x0t + (long)ch * T_TOK;
      __syncthreads();
      if (!smp && (FFTP & 1)) {
        const u16* kr = (const u16*)(ws + C_KP) + (long)ch * 16384;
#pragma unroll
        for (int u = 0; u < 4; ++u) {
          const int n = 8 * (tid + 512 * u);
          float f[8]; unpack8(__builtin_nontemporal_load((const u32x4*)(kr + n)), f);
#pragma unroll
          for (int i = 0; i < 8; ++i) X[PX(n + i)] = make_float2(f[i], 0.f);
        }
        fft_fwd_head(X);
        unsigned Kf[2][16];
#pragma unroll
        for (int u = 0; u < 2; ++u) {
          const int g = tid + 512 * u;
          float2 v[16];
#pragma unroll
          for (int r = 0; r < 16; ++r) v[r] = X[16 * g + (r ^ (g & 15))];
          fft16_fwd(v);
#pragma unroll
          for (int r = 0; r < 16; ++r) Kf[u][r] = pack2(v[r].x, v[r].y);
          asm volatile("" ::: "memory");
        }
        __syncthreads();
#pragma unroll 1
        for (int u = 0; u < 2; ++u) {
          const int n = 8 * (tid + 512 * u);
          float z0[8], z1[8];
          {
            float a[8], c[8];
            conv3_8(x1row, n, 8192, w10, w11, w12, a);
            conv3_8(vrow, n, 8192, w20, w21, w22, c);
#pragma unroll
            for (int i = 0; i < 8; ++i) z0[i] = a[i] * c[i];
            conv3_8(x1row + 8192, n, 8192, w10, w11, w12, a);
            conv3_8(vrow + 8192, n, 8192, w20, w21, w22, c);
#pragma unroll
            for (int i = 0; i < 8; ++i) z1[i] = a[i] * c[i];
          }
          *(u32x4*)(zs + n) = pack8(z0);
          *(u32x4*)(zs + 8192 + n) = pack8(z1);
#pragma unroll
          for (int i = 0; i < 8; ++i) { X[PX(n + i)] = make_float2(z0[i], z1[i]); X[PX(8192 + n + i)] = make_float2(0.f, 0.f); }
        }
        fft_fwd_head(X);
#pragma unroll
        for (int u = 0; u < 2; ++u) {
          const int g = tid + 512 * u;
          float2 v[16];
#pragma unroll
          for (int r = 0; r < 16; ++r) v[r] = X[16 * g + (r ^ (g & 15))];
          fft16_fwd(v);
#pragma unroll
          for (int r = 0; r < 16; ++r) v[r] = cmul(v[r], make_float2(lo_bf(Kf[u][r]), hi_bf(Kf[u][r])));
          fft16_inv(v);
#pragma unroll
          for (int r = 0; r < 16; ++r) X[16 * g + (r ^ (g & 15))] = v[r];
          asm volatile("" ::: "memory");
        }
        fft_inv_tail(X);
#pragma unroll 1
        for (int u = 0; u < 2; ++u) {
          const int n = 8 * (tid + 512 * u);
          float yr[8], yi[8], z0[8], z1[8];
          unpack8(*(const u32x4*)(zs + n), z0);
          unpack8(*(const u32x4*)(zs + 8192 + n), z1);
#pragma unroll
          for (int i = 0; i < 8; ++i) { const float2 xv = X[PX(n + i)]; yr[i] = xv.x * SCL + bias * z0[i]; yi[i] = xv.y * SCL + bias * z1[i]; }
          float g0[8];
          conv3_8(x0row, n, 8192, w00, w01, w02, g0);
#pragma unroll
          for (int i = 0; i < 8; ++i) yr[i] *= g0[i];
          conv3_8(x0row + 8192, n, 8192, w00, w01, w02, g0);
#pragma unroll
          for (int i = 0; i < 8; ++i) yi[i] *= g0[i];
          *(u32x4*)(x1row + n) = pack8(yr);
          *(u32x4*)(x1row + 8192 + n) = pack8(yi);
        }
      } else if (smp && (FFTP & 2)) {
        const u16* kr = (const u16*)(ws + C_KS) + (long)ch * 32768;
#pragma unroll
        for (int u = 0; u < 8; ++u) {
          const int n = 4 * (tid + 512 * u);
          float f[8]; unpack8(__builtin_nontemporal_load((const u32x4*)(kr + 2 * n)), f);
#pragma unroll
          for (int i = 0; i < 4; ++i) X[PX(n + i)] = make_float2(f[2 * i], f[2 * i + 1]);
        }
        fft_fwd_head(X);
#pragma unroll 1
        for (int u = 0; u < 2; ++u) {
          const int g = tid + 512 * u;
          float2 v[16];
#pragma unroll
          for (int r = 0; r < 16; ++r) v[r] = X[16 * g + (r ^ (g & 15))];
          fft16_fwd(v);
#pragma unroll
          for (int r = 0; r < 16; ++r) X[16 * g + (r ^ (g & 15))] = v[r];
        }
        __syncthreads();
        unsigned KA[17], KB[17];
#pragma unroll
        for (int m = 0; m < 17; ++m) {
          int k = (m < 16) ? (((tid & 31) << 8) | (m * 16 + ((tid >> 6) << 1) + ((tid >> 5) & 1))) : 8192;
          asm volatile("" : "+v"(k) :: "memory");
          if (m < 16 || tid == 0) {
            const float2 c1 = X[PX(pos14(k))], c2 = X[PX(pos14((16384 - k) & 16383))];
            const float2 ae = make_float2(0.5f * (c1.x + c2.x), 0.5f * (c1.y - c2.y));
            const float2 ao = make_float2(0.5f * (c1.y + c2.y), -0.5f * (c1.x - c2.x));
            const float2 tw = twid((float)k * (1.f / 32768.f));
            const float2 tao = cmul(tw, ao);
            const float2 ka = cadd(ae, tao), kb = cconj(csub(ae, tao));
            KA[m] = pack2(ka.x, ka.y);
            KB[m] = pack2(kb.x, kb.y);
          } else { KA[m] = 0u; KB[m] = 0u; }
        }
        __syncthreads();
        const u16* x1s = x1row + 16384; const u16* vs = vrow + 16384;
#pragma unroll 1
        for (int u = 0; u < 4; ++u) {
          const int tl = 8 * (tid + 512 * u);
          float a[8], c[8];
          conv3_8(x1s, tl, 16384, w10, w11, w12, a);
          conv3_8(vs, tl, 16384, w20, w21, w22, c);
#pragma unroll
          for (int i = 0; i < 8; ++i) a[i] *= c[i];
          *(u32x4*)(zs + tl) = pack8(a);
          const int n = tl >> 1;
#pragma unroll
          for (int i = 0; i < 4; ++i) { X[PX(n + i)] = make_float2(a[2 * i], a[2 * i + 1]); X[PX(8192 + n + i)] = make_float2(0.f, 0.f); }
        }
        fft_fwd_head(X);
#pragma unroll 1
        for (int u = 0; u < 2; ++u) {
          const int g = tid + 512 * u;
          float2 v[16];
#pragma unroll
          for (int r = 0; r < 16; ++r) v[r] = X[16 * g + (r ^ (g & 15))];
          fft16_fwd(v);
#pragma unroll
          for (int r = 0; r < 16; ++r) X[16 * g + (r ^ (g & 15))] = v[r];
        }
        __syncthreads();
#pragma unroll
        for (int m = 0; m < 17; ++m) {
          int k = (m < 16) ? (((tid & 31) << 8) | (m * 16 + ((tid >> 6) << 1) + ((tid >> 5) & 1))) : 8192;
          asm volatile("" : "+v"(k) :: "memory");
          if (m < 16 || tid == 0) {
            const int p1 = PX(pos14(k)), p2 = PX(pos14((16384 - k) & 16383));
            const float2 c1 = X[p1], c2 = X[p2];
            const float2 ae = make_float2(0.5f * (c1.x + c2.x), 0.5f * (c1.y - c2.y));
            const float2 ao = make_float2(0.5f * (c1.y + c2.y), -0.5f * (c1.x - c2.x));
            const float2 tw = twid((float)k * (1.f / 32768.f));
            const float2 tao = cmul(tw, ao);
            const float2 y1 = cmul(cadd(ae, tao), make_float2(lo_bf(KA[m]), hi_bf(KA[m])));
            const float2 y2 = cmul(cconj(csub(ae, tao)), make_float2(lo_bf(KB[m]), hi_bf(KB[m])));
            const float2 ye = make_float2(0.5f * (y1.x + y2.x), 0.5f * (y1.y - y2.y));
            const float2 yd = make_float2(0.5f * (y1.x - y2.x), 0.5f * (y1.y + y2.y));
            const float2 yo = cmulc(yd, tw);
            X[p1] = make_float2(ye.x - yo.y, ye.y + yo.x);
            if (k != 0) X[p2] = make_float2(ye.x + yo.y, -ye.y + yo.x);
          }
        }
        __syncthreads();
#pragma unroll 1
        for (int u = 0; u < 2; ++u) {
          const int g = tid + 512 * u;
          float2 v[16];
#pragma unroll
          for (int r = 0; r < 16; ++r) v[r] = X[16 * g + (r ^ (g & 15))];
          fft16_inv(v);
#pragma unroll
          for (int r = 0; r < 16; ++r) X[16 * g + (r ^ (g & 15))] = v[r];
        }
        fft_inv_tail(X);
        u16* orow = x1row + 16384;
        const u16* x0s = x0row + 16384;
#pragma unroll 1
        for (int u = 0; u < 4; ++u) {
          const int tl = 8 * (tid + 512 * u);
          const int n = tl >> 1;
          float y[8], g0[8], zz[8];
          unpack8(*(const u32x4*)(zs + tl), zz);
#pragma unroll
          for (int i = 0; i < 4; ++i) { const float2 xv = X[PX(n + i)]; y[2 * i] = xv.x * SCL + bias * zz[2 * i]; y[2 * i + 1] = xv.y * SCL + bias * zz[2 * i + 1]; }
          conv3_8(x0s, tl, 16384, w00, w01, w02, g0);
#pragma unroll
          for (int i = 0; i < 8; ++i) y[i] *= g0[i];
          *(u32x4*)(orow + tl) = pack8(y);
        }
      }
    }
  }
  grid_bar(barcnt, bar_target, (unsigned)G);

  if (PHM & (1 << 10)) {
    PHASE_IDS
    const u16* src = (const u16*)dsc;
    u16* yg = (u16*)(ws + C_YG);
    u16* tl = (u16*)smem;
    for (int tile = vb; tile < 16 * 512; tile += G) {
      const int tc = tile & 15, tt = tile >> 4;
      {
        const int cr = tid >> 3, c8 = tid & 7;
        const u32x4 v = __builtin_nontemporal_load((const u32x4*)(src + (long)(tc * 64 + cr) * T_TOK + tt * 64 + c8 * 8));
        *(u32x4*)(tl + cr * 72 + c8 * 8) = v;
      }
      __syncthreads();
      {
        const int tr = tid >> 3, c8 = tid & 7;
        u32x4 o;
#pragma unroll
        for (int i = 0; i < 4; ++i) {
          const unsigned a = tl[(c8 * 8 + 2 * i) * 72 + tr], b = tl[(c8 * 8 + 2 * i + 1) * 72 + tr];
          o[i] = a | (b << 16);
        }
        *(u32x4*)(yg + (long)(tt * 64 + tr) * DM + tc * 64 + c8 * 8) = o;
      }
      __syncthreads();
    }
  }
  grid_bar(barcnt, bar_target, (unsigned)G);

  if (PHM & (1 << 11)) {
    pg8::Gemm g{(const u16*)(ws + C_YG), (const u16*)(ws + W1_COUT), T_TOK, DM, DM};
    pg8::StaticOrder S; S.init(T_TOK, DM, G, bid);
    EpiResid E{XB, rowss + 3 * T_TOK};
    pg8::gemm_phase<EpiResid, pg8::StaticOrder>(lds, g, S, E, nullptr);
  }
  grid_bar(barcnt, bar_target, (unsigned)G);

  if (PHM & (1 << 12)) {
    u16* actC = (u16*)(ws + OFF_C);
    pg8::Gemm g{XB + (size_t)0 * 16384 * DM, (const u16*)(ws + W1_GU), 16384, 5632, DM};
    pg8::StaticOrder S; S.init(16384, 5632, G, bid);
    EpiGU E{actC - (size_t)0 * 16384 * DFF, actC, 1 << 30, rowss + 3 * T_TOK, 0 * 16384};
    pg8::gemm_phase<EpiGU, pg8::StaticOrder>(lds, g, S, E, nullptr);
  }
  grid_bar(barcnt, bar_target, (unsigned)G);
  if (PHM & (1 << 12)) {
    pg8::Gemm g{(const u16*)(ws + OFF_C), (const u16*)(ws + W1_D), 16384, DM, DFF};
    pg8::StaticOrder S; S.init(16384, DM, G, bid);
    EpiFinal E{XB, p.out, 0 * 16384};
    pg8::gemm_phase<EpiFinal, pg8::StaticOrder>(lds, g, S, E, nullptr);
  }
  grid_bar(barcnt, bar_target, (unsigned)G);
  if (PHM & (1 << 12)) {
    u16* actC = (u16*)(ws + OFF_C);
    pg8::Gemm g{XB + (size_t)1 * 16384 * DM, (const u16*)(ws + W1_GU), 16384, 5632, DM};
    pg8::StaticOrder S; S.init(16384, 5632, G, bid);
    EpiGU E{actC - (size_t)1 * 16384 * DFF, actC, 1 << 30, rowss + 3 * T_TOK, 1 * 16384};
    pg8::gemm_phase<EpiGU, pg8::StaticOrder>(lds, g, S, E, nullptr);
  }
  grid_bar(barcnt, bar_target, (unsigned)G);
  if (PHM & (1 << 12)) {
    pg8::Gemm g{(const u16*)(ws + OFF_C), (const u16*)(ws + W1_D), 16384, DM, DFF};
    pg8::StaticOrder S; S.init(16384, DM, G, bid);
    EpiFinal E{XB, p.out, 1 * 16384};
    pg8::gemm_phase<EpiFinal, pg8::StaticOrder>(lds, g, S, E, nullptr);
  }
}

extern "C" void kernel_launch(void* const* d_in, const int* in_sizes, int n_in, void* d_out, int out_size,
                              void* d_ws, size_t ws_size, hipStream_t stream) {
  static int grid_blocks = 0;
  if (!grid_blocks) {
    int dev = 0, cus = 0, per_cu = 0;
    hipGetDevice(&dev);
    hipDeviceGetAttribute(&cus, hipDeviceAttributeMultiprocessorCount, dev);
    hipOccupancyMaxActiveBlocksPerMultiprocessor(&per_cu, fwd_kernel, NTHR, 0);
    if (per_cu < 1) per_cu = 1;
    grid_blocks = cus;
    if (grid_blocks % 8) grid_blocks -= grid_blocks % 8;
  }
  if (ws_size < WS_NEED || n_in < 28) { fprintf(stderr, "workspace too small\n"); return; }
  Params p{};
  for (int i = 0; i < 28; ++i) p.in[i] = (const float*)d_in[i];
  p.out = (float*)d_out;
  p.ws = (char*)d_ws;
  hipMemsetAsync(d_ws, 0, 4096, stream);
  void* args[] = {&p};
  hipError_t e = hipLaunchCooperativeKernel((void*)fwd_kernel, dim3(grid_blocks), dim3(NTHR), args, 0, stream);
  if (e != hipSuccess) fprintf(stderr, "cooperative launch failed: %s (grid %d)\n", hipGetErrorString(e), grid_blocks);
}
```

```cpp
#include <hip/hip_runtime.h>
#include <hip/hip_cooperative_groups.h>
#include <cstdio>
#include <cstdint>
namespace cg = cooperative_groups;

typedef unsigned short u16;
typedef __attribute__((ext_vector_type(8))) short bf16x8;
typedef __attribute__((ext_vector_type(4))) short s16x4;
typedef __attribute__((ext_vector_type(4))) float f32x4;
typedef __attribute__((ext_vector_type(16))) float f32x16;
typedef __attribute__((ext_vector_type(4))) unsigned u32x4;
typedef __attribute__((ext_vector_type(2))) unsigned u32x2;

#define DI __device__ __forceinline__
#define NTHR 512
#ifndef FFTP
#define FFTP 3
#endif
#ifndef REP1
#define REP1 1
#endif
#ifndef REP5
#define REP5 1
#endif
#ifndef REP7
#define REP7 1
#endif
#ifndef REP8
#define REP8 1
#endif
#ifndef PHM
#define PHM 0xffff
#endif


DI float2 mk2(float x, float y) { float2 r; r.x = x; r.y = y; return r; }
DI void bsync() { __builtin_amdgcn_fence(__ATOMIC_RELEASE, "workgroup"); __builtin_amdgcn_s_barrier(); __builtin_amdgcn_fence(__ATOMIC_ACQUIRE, "workgroup"); }
DI float i2f(int v) { return __builtin_bit_cast(float, v); }
DI int f2i(float v) { return __builtin_bit_cast(int, v); }
DI float4 mk4(float x, float y, float z, float w) { float4 r; r.x = x; r.y = y; r.z = z; r.w = w; return r; }
#define make_float4 mk4
#define make_float2 mk2
#define __syncthreads bsync
#define __int_as_float i2f
#define __float_as_int f2i

constexpr int T_TOK = 32768;
constexpr int DM = 1024;
constexpr int DFF = 2816;
constexpr float EPSN = 1e-6f;

constexpr size_t SM_ROWSS = 4096;
constexpr size_t SM_Z3    = 1048576;
constexpr size_t OFF_W1   = 4194304;
constexpr size_t W1_CIN   = OFF_W1;
constexpr size_t W1_COUT  = W1_CIN + 6291456;
constexpr size_t W1_W4    = W1_COUT + 2097152;
constexpr size_t W1_GU    = W1_W4 + 262144;
constexpr size_t W1_D     = W1_GU + 11534336;
constexpr size_t OFF_XB   = W1_D + 5767168;
constexpr size_t OFF_C    = OFF_XB + 67108864;
constexpr size_t W0_IN    = OFF_C;
constexpr size_t W0_Q     = W0_IN + 4194304;
constexpr size_t W0_K     = W0_Q + 393216;
constexpr size_t W0_V     = W0_K + 131072;
constexpr size_t W0_OUT   = W0_V + 131072;
constexpr size_t W0_GU    = W0_OUT + 2097152;
constexpr size_t W0_D     = W0_GU + 11534336;
constexpr size_t OFF_R    = W0_D + 5767168;
constexpr size_t WS_NEED  = 268435456;
static_assert(OFF_R == 121503744, "map");
constexpr size_t R_CQN  = OFF_R;
constexpr size_t R_CKVN = R_CQN + 16777216;
constexpr size_t R_KPE  = R_CKVN + 8388608;
constexpr size_t R_MIX  = R_KPE + 2097152;
constexpr size_t R_K    = R_MIX + 67108864;
constexpr size_t R_ROPE = R_K + 50331648;
constexpr size_t SM_SSKPE = 528384;
static_assert(R_ROPE + 2097152 <= WS_NEED, "map");
constexpr size_t D_QRAW = 0;
constexpr size_t D_KN   = 50331648;
constexpr size_t D_VT   = D_KN + 33554432;
constexpr size_t D_ROPE = D_VT + 33554432;
static_assert(D_ROPE + 2097152 <= 134217728, "map");
constexpr size_t C_X0T  = OFF_C;
constexpr size_t C_KP   = C_X0T + 67108864;
constexpr size_t C_KS   = C_KP + 33554432;
constexpr size_t C_YG   = C_KS;
static_assert(C_KS + 67108864 <= WS_NEED, "map");

struct Params {
  const float* in[28];
  float* out;
  char* ws;
};

typedef __bf16 bf16v2_t __attribute__((ext_vector_type(2)));
typedef float f32v2_t __attribute__((ext_vector_type(2)));
DI unsigned pack2(float a, float b) { f32v2_t v = {a, b}; bf16v2_t r = __builtin_convertvector(v, bf16v2_t); return __builtin_bit_cast(unsigned, r); }
DI u16 f2bf(float x) { return (u16)(pack2(x, 0.f) & 0xffffu); }
DI float bf2f(u16 v) { return __uint_as_float(((unsigned)v) << 16); }
DI float lo_bf(unsigned w) { return __uint_as_float(w << 16); }
DI float hi_bf(unsigned w) { return __uint_as_float(w & 0xffff0000u); }
DI void unpack8(const u32x4& v, float* f) {
  f[0] = lo_bf(v[0]); f[1] = hi_bf(v[0]); f[2] = lo_bf(v[1]); f[3] = hi_bf(v[1]);
  f[4] = lo_bf(v[2]); f[5] = hi_bf(v[2]); f[6] = lo_bf(v[3]); f[7] = hi_bf(v[3]);
}
DI u32x4 pack8(const float* f) {
  u32x4 v; v[0] = pack2(f[0], f[1]); v[1] = pack2(f[2], f[3]); v[2] = pack2(f[4], f[5]); v[3] = pack2(f[6], f[7]); return v;
}
DI float wave_sum(float v) {
  v += __shfl_xor(v, 32); v += __shfl_xor(v, 16); v += __shfl_xor(v, 8);
  v += __shfl_xor(v, 4); v += __shfl_xor(v, 2); v += __shfl_xor(v, 1); return v;
}
DI void seq_of(int t, int& t0, int& L) {
  if (t < 8192) { t0 = 0; L = 8192; } else if (t < 16384) { t0 = 8192; L = 8192; } else { t0 = 16384; L = 16384; }
}

namespace pg8 {
#define PG8_LAS __attribute__((address_space(3)))
typedef unsigned short bf16_t;
typedef short bf16x8 __attribute__((ext_vector_type(8)));
typedef float f32x4 __attribute__((ext_vector_type(4)));
typedef unsigned u32x4 __attribute__((ext_vector_type(4)));
constexpr int BM = 256, BK = 64, HALF = 128, HTB = HALF * BK * 2  , STAGE_BYTES = 8 * HTB, NXCD = 8, WGM = 8;

__host__ __device__ __forceinline__ int lds_byte(int r, int c) { const int st = (r >> 4) * 2 + (c >> 5), rr = r & 15, cc = c & 31, ob = rr * 64 + cc * 2; return st * 1024 + (ob ^ (((ob >> 9) & 1) << 5)); }
__host__ __device__ __forceinline__ void stage_rc(int b, int& R, int& C) { const int st = b / 1024, sb = b % 1024, swz = sb ^ (((sb >> 9) & 1) << 5); R = (st >> 1) * 16 + swz / 64; C = (st & 1) * 32 + (swz % 64) / 2; }
__host__ __device__ __forceinline__ int perm32(int rho) { const int n = rho >> 4, i = rho & 15; return 8 * (i >> 2) + 4 * n + (i & 3); }

struct Unit { int pm, pn; };
struct Gemm { const bf16_t* A; const bf16_t* Bt; int M, N, K; };

struct StaticOrder {
    int nM, nN, nwg, G, c;
    __host__ __device__ __forceinline__ void init(int M, int N, int G_, int c_) { nM = M / BM; nN = N / BM; nwg = nM * nN; G = G_; c = c_; }
    __host__ __device__ __forceinline__ bool next(int i, Unit& u) const {
        const long L = (long)i * G + c; if (L >= nwg) return false;
        int wgid = (int)L; { const int q = nwg / NXCD, r = nwg % NXCD, xcd = wgid % NXCD, off = wgid / NXCD; wgid = (xcd < r ? xcd * (q + 1) : r * (q + 1) + (xcd - r) * q) + off; }
        const int nig = WGM * nN, gid = wgid / nig, fm = gid * WGM, gsz = (nM - fm) < WGM ? (nM - fm) : WGM;
        u.pm = fm + ((wgid % nig) % gsz); u.pn = (wgid % nig) / gsz; return true;
    }
    __device__ __forceinline__ void a_ready(const Unit&) const {}
    __device__ __forceinline__ void done(const Unit&) const {}
    __device__ __forceinline__ const char* a_ptr(const char* base, int pm, size_t tstep) const { return base + (size_t)pm * tstep; }
};
__device__ __forceinline__ unsigned cvt_pk_bf16(float lo, float hi) { unsigned r; asm volatile("v_cvt_pk_bf16_f32 %0, %1, %2" : "=v"(r) : "v"(lo), "v"(hi)); return r; }
template <class Epi, class Sched, bool STAMP = false>
__device__ __forceinline__ void gemm_phase(PG8_LAS unsigned char* lds, const Gemm g, const Sched& S, const Epi& E, unsigned long long* stamps) {
    int tid = threadIdx.x; asm volatile("" : "+v"(tid));
    const int wid = __builtin_amdgcn_readfirstlane(tid >> 6), lane = tid & 63, wr = wid >> 2, wc = wid & 3, fr = lane & 15, fq = lane >> 4;
    const int K = g.K, nt = K / BK;
    int ts_lo = 0, ts_hi = 0, nts = 0; const unsigned long long rt_entry = STAMP ? (unsigned long long)wall_clock64() : 0ull;
#define PG8_STAMP() do { if (STAMP && wid == 0 && nts < 64) { const unsigned long long _c = (unsigned long long)clock64(); \
        ts_lo = (lane == nts) ? (int)(unsigned)_c : ts_lo; ts_hi = (lane == nts) ? (int)(unsigned)(_c >> 32) : ts_hi; ++nts; } } while (0)
    PG8_STAMP();
    unsigned voffA[2], voffB[2];
#pragma unroll
    for (int i = 0; i < 2; ++i) { int R, C; stage_rc(tid * 16 + i * 8192, R, C); const int Rb = Epi::PERM ? ((R & ~31) + perm32(R & 31)) : R;
        voffA[i] = (unsigned)(R * K + C) * 2u; voffB[i] = (unsigned)(Rb * K + C) * 2u; }
    const size_t kstep = (size_t)(BK * 2);
    const size_t hstep = (size_t)HALF * K * 2;
    const size_t tstep = 2 * hstep;
    const unsigned ldsw = (unsigned)wid * 1024u;
    const int aoff = lds_byte(wr * 64 + fr, fq * 8), boff = lds_byte(wc * 32 + fr, fq * 8);
#define PG8_SA(b, h) (((b) * 2 + (h)) * HTB)
#define PG8_SB(b, h) ((4 + (b) * 2 + (h)) * HTB)
#define PG8_STAGE(bufoff, gbase, voff) do { _Pragma("unroll") for (int _i = 0; _i < 2; ++_i) \
        __builtin_amdgcn_global_load_lds((const unsigned*)((const char*)(gbase) + (voff)[_i]), (PG8_LAS unsigned*)(lds + (bufoff) + ldsw + _i * 8192), 16, 0, 0); } while (0)
#define PG8_LDA(dst, b, h) do { _Pragma("unroll") for (int m = 0; m < 4; ++m) _Pragma("unroll") for (int k = 0; k < 2; ++k) dst[m][k] = *(const PG8_LAS bf16x8*)(lds + PG8_SA(b, h) + aoff + m * 2048 + k * 1024); } while (0)
#define PG8_LDB(dst, b, h) do { _Pragma("unroll") for (int n = 0; n < 2; ++n) _Pragma("unroll") for (int k = 0; k < 2; ++k) dst[n][k] = *(const PG8_LAS bf16x8*)(lds + PG8_SB(b, h) + boff + n * 2048 + k * 1024); } while (0)
#define PG8_MMA(ai, bj, At, Bt) do { __builtin_amdgcn_s_setprio(1); _Pragma("unroll") for (int m = 0; m < 4; ++m) _Pragma("unroll") for (int n = 0; n < 2; ++n) _Pragma("unroll") for (int k = 0; k < 2; ++k) \
        acc[ai][bj][m][n] = __builtin_amdgcn_mfma_f32_16x16x32_bf16(Bt[n][k], At[m][k], acc[ai][bj][m][n], 0, 0, 0); __builtin_amdgcn_s_setprio(0); } while (0)
#define PG8_WAIT_V(n) asm volatile("s_waitcnt vmcnt(" #n ")" ::: "memory")
#define PG8_WAIT_L(n) asm volatile("s_waitcnt lgkmcnt(" #n ")" ::: "memory")
#define PG8_BAR __builtin_amdgcn_s_barrier()
#define PG8_SCHED __builtin_amdgcn_sched_barrier(0)
    Unit cur, nxt; int ui = 0;
    if (!S.next(0, cur)) return;
    f32x4 acc[2][2][4][2];
#pragma unroll
    for (int a = 0; a < 2; ++a)
#pragma unroll
        for (int b = 0; b < 2; ++b)
#pragma unroll
            for (int m = 0; m < 4; ++m)
#pragma unroll
                for (int n = 0; n < 2; ++n) acc[a][b][m][n] = (f32x4){0.f, 0.f, 0.f, 0.f};
    bf16x8 At[4][2], B0[2][2], B1[2][2];
    const char* cA = S.a_ptr((const char*)g.A, cur.pm, tstep); const char* cB = (const char*)g.Bt + (size_t)cur.pn * tstep;
    S.a_ready(cur);
    PG8_STAGE(PG8_SB(0, 0), cB, voffB); PG8_STAGE(PG8_SA(0, 0), cA, voffA); PG8_STAGE(PG8_SB(0, 1), cB + hstep, voffB); PG8_STAGE(PG8_SA(0, 1), cA + hstep, voffA);
    if (wr == 1) PG8_BAR;
    PG8_WAIT_V(4); PG8_BAR;
    PG8_STAGE(PG8_SB(1, 0), cB + kstep, voffB); PG8_STAGE(PG8_SA(1, 0), cA + kstep, voffA); PG8_STAGE(PG8_SB(1, 1), cB + hstep + kstep, voffB);
    PG8_WAIT_V(6); PG8_BAR;
    PG8_STAMP();
    for (;;) {
        const bool has_next = S.next(ui + 1, nxt);
        const char* nA = has_next ? S.a_ptr((const char*)g.A, nxt.pm, tstep) : cA; const char* nB = has_next ? (const char*)g.Bt + (size_t)nxt.pn * tstep : cB;
        for (int t = 0; t < nt; t += 2) {
            const bool last = (t == nt - 2);
            const char* a1 = cA + (size_t)(t + 1) * kstep;
            const char* a2 = last ? nA : cA + (size_t)(t + 2) * kstep; const char* b2 = last ? nB : cB + (size_t)(t + 2) * kstep;
            const char* a3 = a2 + kstep; const char* b3 = b2 + kstep;
            if (last && has_next) S.a_ready(nxt);
            PG8_LDB(B0, 0, 0); PG8_SCHED; PG8_LDA(At, 0, 0); PG8_STAGE(PG8_SA(1, 1), a1 + hstep, voffA);
            PG8_WAIT_L(8); PG8_BAR; PG8_WAIT_L(0); PG8_MMA(0, 0, At, B0); PG8_BAR; PG8_SCHED;
            PG8_LDB(B1, 0, 1); PG8_STAGE(PG8_SB(0, 0), b2, voffB);
            PG8_BAR; PG8_WAIT_L(0); PG8_MMA(0, 1, At, B1); PG8_BAR;
            PG8_LDA(At, 0, 1); PG8_STAGE(PG8_SA(0, 0), a2, voffA);
            PG8_BAR; PG8_WAIT_L(0); PG8_MMA(1, 0, At, B0); PG8_BAR; PG8_SCHED;
            PG8_STAGE(PG8_SB(0, 1), b2 + hstep, voffB);
            PG8_WAIT_V(6); PG8_BAR; PG8_MMA(1, 1, At, B1); PG8_BAR;
            PG8_LDB(B0, 1, 0); PG8_SCHED; PG8_LDA(At, 1, 0); PG8_STAGE(PG8_SA(0, 1), a2 + hstep, voffA);
            PG8_WAIT_L(8); PG8_BAR; PG8_WAIT_L(0); PG8_MMA(0, 0, At, B0); PG8_BAR; PG8_SCHED;
            PG8_LDB(B1, 1, 1); PG8_STAGE(PG8_SB(1, 0), b3, voffB);
            PG8_BAR; PG8_WAIT_L(0); PG8_MMA(0, 1, At, B1); PG8_BAR;
            PG8_LDA(At, 1, 1); PG8_STAGE(PG8_SA(1, 0), a3, voffA);
            PG8_BAR; PG8_WAIT_L(0); PG8_MMA(1, 0, At, B0); PG8_BAR; PG8_SCHED;
            PG8_STAGE(PG8_SB(1, 1), b3 + hstep, voffB);
            PG8_WAIT_V(6); PG8_BAR; PG8_MMA(1, 1, At, B1); PG8_BAR;
        }
        PG8_STAMP();
        if constexpr (!Epi::AFTER_DRAIN) { E(acc, cur, wr, wc, fr, fq); S.done(cur); }
        PG8_STAMP();
        if (!has_next) break;
#pragma unroll
        for (int a = 0; a < 2; ++a)
#pragma unroll
            for (int b = 0; b < 2; ++b)
#pragma unroll
                for (int m = 0; m < 4; ++m)
#pragma unroll
                    for (int n = 0; n < 2; ++n) acc[a][b][m][n] = (f32x4){0.f, 0.f, 0.f, 0.f};
        cur = nxt; cA = nA; cB = nB; ++ui;
    }
    PG8_WAIT_V(0);
    if (wr == 0) PG8_BAR;
    PG8_BAR;
    if constexpr (Epi::AFTER_DRAIN) { E.fused(acc, cur, wr, wc, fr, fq, lds, wid, lane); S.done(cur); }
    PG8_STAMP();
    if (STAMP && wid == 0) { stamps[lane] = lane < nts ? (((unsigned long long)(unsigned)ts_hi << 32) | (unsigned)ts_lo) : 0ull;
        if (lane == 62) stamps[62] = rt_entry; if (lane == 63) stamps[63] = (unsigned long long)wall_clock64(); }
#undef PG8_STAMP
#undef PG8_SA
#undef PG8_SB
#undef PG8_STAGE
#undef PG8_LDA
#undef PG8_LDB
#undef PG8_MMA
#undef PG8_WAIT_V
#undef PG8_WAIT_L
#undef PG8_BAR
#undef PG8_SCHED
}
}

struct SplitOrder : pg8::StaticOrder {
  const char* base2; int split;
  DI const char* a_ptr(const char* base, int pm, size_t tstep) const { return pm < split ? base + (size_t)pm * tstep : base2 + (size_t)(pm - split) * tstep; }
};
struct EpiRowScaleBf16 {
  static constexpr bool PERM = true, AFTER_DRAIN = false;
  u16* O; int ldc; const float* ssq;
  DI void operator()(const f32x4 (&acc)[2][2][4][2], const pg8::Unit& u, int wr, int wc, int fr, int fq) const {
    const int row0 = u.pm * 256 + wr * 64 + fr, col0 = u.pn * 256 + wc * 32 + 8 * fq;
#pragma unroll
    for (int ai = 0; ai < 2; ++ai)
#pragma unroll
      for (int m = 0; m < 4; ++m) {
        const int row = row0 + ai * 128 + m * 16;
        const float rs = rsqrtf(ssq[row] * (1.f / 1024.f) + EPSN);
        u16* rp = O + (size_t)row * ldc + col0;
#pragma unroll
        for (int bj = 0; bj < 2; ++bj) {
          const f32x4 v0 = acc[ai][bj][m][0] * rs, v1 = acc[ai][bj][m][1] * rs;
          u32x4 w; w[0] = pack2(v0[0], v0[1]); w[1] = pack2(v0[2], v0[3]); w[2] = pack2(v1[0], v1[1]); w[3] = pack2(v1[2], v1[3]);
          *(u32x4*)(rp + bj * 128) = w;
        }
      }
  }
};
struct EpiResid {
  static constexpr bool PERM = true, AFTER_DRAIN = false;
  u16* X; float* ssq;
  DI void operator()(const f32x4 (&acc)[2][2][4][2], const pg8::Unit& u, int wr, int wc, int fr, int fq) const {
    const int row0 = u.pm * 256 + wr * 64 + fr, col0 = u.pn * 256 + wc * 32 + 8 * fq;
#pragma unroll
    for (int ai = 0; ai < 2; ++ai)
#pragma unroll
      for (int m = 0; m < 4; ++m) {
        const int row = row0 + ai * 128 + m * 16;
        u16* rp = X + (size_t)row * DM + col0;
        float part = 0.f;
#pragma unroll
        for (int bj = 0; bj < 2; ++bj) {
          float f[8]; unpack8(*(const u32x4*)(rp + bj * 128), f);
#pragma unroll
          for (int e = 0; e < 4; ++e) { f[e] += acc[ai][bj][m][0][e]; f[4 + e] += acc[ai][bj][m][1][e]; }
#pragma unroll
          for (int e = 0; e < 8; ++e) part += f[e] * f[e];
          *(u32x4*)(rp + bj * 128) = pack8(f);
        }
        part += __shfl_xor(part, 16); part += __shfl_xor(part, 32);
        if (fq == 0) atomicAdd(ssq + row, part);
      }
  }
};
struct EpiGU {
  static constexpr bool PERM = false, AFTER_DRAIN = false;
  u16* actA; u16* actB; int split_row; const float* ssq; int row_off;
  DI void operator()(const f32x4 (&acc)[2][2][4][2], const pg8::Unit& u, int wr, int wc, int fr, int fq) const {
    const int row0 = row_off + u.pm * 256 + wr * 64 + fr;
#pragma unroll
    for (int ai = 0; ai < 2; ++ai)
#pragma unroll
      for (int m = 0; m < 4; ++m) {
        const int row = row0 + ai * 128 + m * 16;
        const float rs = rsqrtf(ssq[row] * (1.f / 1024.f) + EPSN);
        u16* ap = (row < split_row) ? (actA + (size_t)row * DFF) : (actB + (size_t)(row - split_row) * DFF);
#pragma unroll
        for (int bj = 0; bj < 2; ++bj) {
          const f32x4 gv = acc[ai][bj][m][0] * rs, uv = acc[ai][bj][m][1] * rs;
          float o[4];
#pragma unroll
          for (int e = 0; e < 4; ++e) o[e] = gv[e] * uv[e] * __builtin_amdgcn_rcpf(1.f + __builtin_amdgcn_exp2f(-1.4426950408889634f * gv[e]));
          u32x2 w; w[0] = pack2(o[0], o[1]); w[1] = pack2(o[2], o[3]);
          *(u32x2*)(ap + 16 * (8 * u.pn + 4 * bj + wc) + 4 * fq) = w;
        }
      }
  }
};
struct EpiFinal {
  static constexpr bool PERM = false, AFTER_DRAIN = false;
  const u16* X; float* out; int row_off;
  DI void operator()(const f32x4 (&acc)[2][2][4][2], const pg8::Unit& u, int wr, int wc, int fr, int fq) const {
    const int row0 = row_off + u.pm * 256 + wr * 64 + fr, col0 = u.pn * 256 + wc * 32 + 4 * fq;
#pragma unroll
    for (int ai = 0; ai < 2; ++ai)
#pragma unroll
      for (int m = 0; m < 4; ++m) {
        const size_t rb = (size_t)(row0 + ai * 128 + m * 16) * DM + col0;
#pragma unroll
        for (int bj = 0; bj < 2; ++bj)
#pragma unroll
          for (int n = 0; n < 2; ++n) {
            const u32x2 xv = *(const u32x2*)(X + rb + bj * 128 + n * 16);
            f32x4 o = acc[ai][bj][m][n];
            o[0] += lo_bf(xv[0]); o[1] += hi_bf(xv[0]); o[2] += lo_bf(xv[1]); o[3] += hi_bf(xv[1]);
            __builtin_nontemporal_store(o, (f32x4*)(out + rb + bj * 128 + n * 16));
          }
      }
  }
};
struct EpiCin {
  static constexpr bool PERM = true, AFTER_DRAIN = false;
  u16* x0t; u16* x1vt; const float* ssq;
  DI void operator()(const f32x4 (&acc)[2][2][4][2], const pg8::Unit& u, int wr, int wc, int fr, int fq) const {
    const int row0 = u.pm * 256 + wr * 64 + fr, col0 = u.pn * 256 + wc * 32 + 8 * fq;
    float rs[2][8];
#pragma unroll
    for (int bj = 0; bj < 2; ++bj)
#pragma unroll
      for (int e = 0; e < 8; ++e) rs[bj][e] = rsqrtf(ssq[col0 + bj * 128 + e] * (1.f / 1024.f) + EPSN);
#pragma unroll
    for (int ai = 0; ai < 2; ++ai)
#pragma unroll
      for (int m = 0; m < 4; ++m) {
        const int ch = row0 + ai * 128 + m * 16;
        u16* rp = ((ch < 1024) ? (x0t + (size_t)ch * T_TOK) : (x1vt + (size_t)(ch - 1024) * T_TOK)) + col0;
#pragma unroll
        for (int bj = 0; bj < 2; ++bj) {
          const f32x4 v0 = acc[ai][bj][m][0], v1 = acc[ai][bj][m][1];
          u32x4 w;
          w[0] = pack2(v0[0] * rs[bj][0], v0[1] * rs[bj][1]); w[1] = pack2(v0[2] * rs[bj][2], v0[3] * rs[bj][3]);
          w[2] = pack2(v1[0] * rs[bj][4], v1[1] * rs[bj][5]); w[3] = pack2(v1[2] * rs[bj][6], v1[3] * rs[bj][7]);
          *(u32x4*)(rp + bj * 128) = w;
        }
      }
  }
};

DI int swz(int row, int chunk) { return row * 128 + ((chunk ^ (row & 7)) << 4); }

template <int NI = 4, class Epi>
DI void gemm_tile(const u16* __restrict__ A, long lda, const u16* __restrict__ B, long ldb, int K, char* smem, Epi&& epi) {
  int tid = threadIdx.x; asm volatile("" : "+v"(tid));
  const int lane = tid & 63, wid = tid >> 6;
  const int wr = wid >> 1, wc = wid & 1;
  const int fr = lane & 15, fq = lane >> 4;
  constexpr int NBL = NI / 2;
  constexpr int BUFB = 32768 + NI * 32 * 128;
  f32x4 acc[4][NI];
#pragma unroll
  for (int i = 0; i < 4; ++i)
#pragma unroll
    for (int j = 0; j < NI; ++j) acc[i][j] = (f32x4){0.f, 0.f, 0.f, 0.f};
  const int lrow = tid >> 3, lch = tid & 7;
  const u16* Ap = A + (long)lrow * lda + lch * 8;
  const u16* Bp = B + (long)lrow * ldb + lch * 8;
  u32x4 ra[4], rb[NBL];
  const int nk = K >> 6;
#pragma unroll
  for (int i = 0; i < 4; ++i) ra[i] = *(const u32x4*)(Ap + (long)(i * 64) * lda);
#pragma unroll
  for (int i = 0; i < NBL; ++i) rb[i] = *(const u32x4*)(Bp + (long)(i * 64) * ldb);
#pragma unroll
  for (int i = 0; i < 4; ++i) *(u32x4*)(smem + swz(lrow + i * 64, lch)) = ra[i];
#pragma unroll
  for (int i = 0; i < NBL; ++i) *(u32x4*)(smem + 32768 + swz(lrow + i * 64, lch)) = rb[i];
  __syncthreads();
  for (int kt = 0; kt < nk; ++kt) {
    if (kt + 1 < nk) {
#pragma unroll
      for (int i = 0; i < 4; ++i) ra[i] = *(const u32x4*)(Ap + (long)(i * 64) * lda + (kt + 1) * 64);
#pragma unroll
      for (int i = 0; i < NBL; ++i) rb[i] = *(const u32x4*)(Bp + (long)(i * 64) * ldb + (kt + 1) * 64);
    }
    const char* sa = smem + (kt & 1) * BUFB;
    const char* sb = sa + 32768;
#pragma unroll
    for (int ks = 0; ks < 2; ++ks) {
      bf16x8 af[4], bfr[NI];
#pragma unroll
      for (int mi = 0; mi < 4; ++mi) af[mi] = *(const bf16x8*)(sa + swz(wr * 64 + mi * 16 + fr, ks * 4 + fq));
#pragma unroll
      for (int ni = 0; ni < NI; ++ni) bfr[ni] = *(const bf16x8*)(sb + swz(wc * (NI * 16) + ni * 16 + fr, ks * 4 + fq));
#pragma unroll
      for (int mi = 0; mi < 4; ++mi)
#pragma unroll
        for (int ni = 0; ni < NI; ++ni)
          acc[mi][ni] = __builtin_amdgcn_mfma_f32_16x16x32_bf16(af[mi], bfr[ni], acc[mi][ni], 0, 0, 0);
    }
    if (kt + 1 < nk) {
      char* da = smem + ((kt + 1) & 1) * BUFB;
#pragma unroll
      for (int i = 0; i < 4; ++i) *(u32x4*)(da + swz(lrow + i * 64, lch)) = ra[i];
#pragma unroll
      for (int i = 0; i < NBL; ++i) *(u32x4*)(da + 32768 + swz(lrow + i * 64, lch)) = rb[i];
    }
    __syncthreads();
  }
  epi(acc, wr * 64 + fq * 4, wc * (NI * 16) + fr);
}

template <int KIND>
DI void convert_w(const float* __restrict__ src, const float* __restrict__ src2, int Nsrc, int K, int Np,
                  u16* __restrict__ dst, const float* __restrict__ gain, long gtid, long GT) {
  const int items = Np * (K >> 3);
#pragma unroll 4
  for (int it = (int)gtid; it < items; it += (int)GT) {
    const int np = it % Np, kc = it / Np;
    const float* sp = src; int n = np; bool valid = true;
    if (KIND == 0) { valid = np < Nsrc; }
    else if (KIND == 1) { n = (np >> 6) * 128 + (np & 63); }
    else if (KIND == 2) { n = (np >> 6) * 128 + 64 + (np & 63); }
    else { const int g = np >> 5, w = np & 31; sp = (w < 16) ? src : src2; n = g * 16 + (w & 15); }
    float f[8];
#pragma unroll
    for (int j = 0; j < 8; ++j) {
      const int k = kc * 8 + j;
      float v = valid ? sp[(long)k * Nsrc + n] : 0.f;
      if (gain) v *= gain[k];
      f[j] = v;
    }
    *(u32x4*)(dst + (long)np * K + kc * 8) = pack8(f);
  }
}

DI float2 cadd(float2 a, float2 b) { return make_float2(a.x + b.x, a.y + b.y); }
DI float2 csub(float2 a, float2 b) { return make_float2(a.x - b.x, a.y - b.y); }
DI float2 cmul(float2 a, float2 b) { return make_float2(a.x * b.x - a.y * b.y, a.x * b.y + a.y * b.x); }
DI float2 cmulc(float2 a, float2 b) { return make_float2(a.x * b.x + a.y * b.y, a.y * b.x - a.x * b.y); }
DI float2 cconj(float2 a) { return make_float2(a.x, -a.y); }
DI float2 twid(float rev) {
  return make_float2(__builtin_amdgcn_cosf(rev), -__builtin_amdgcn_sinf(rev));
}
DI void r4f(float2& a0, float2& a1, float2& a2, float2& a3) {
  const float2 s02 = cadd(a0, a2), d02 = csub(a0, a2), s13 = cadd(a1, a3), d13 = csub(a1, a3);
  a0 = cadd(s02, s13); a2 = csub(s02, s13);
  a1 = make_float2(d02.x + d13.y, d02.y - d13.x);
  a3 = make_float2(d02.x - d13.y, d02.y + d13.x);
}
DI void r4i(float2& a0, float2& a1, float2& a2, float2& a3) {
  const float2 s02 = cadd(a0, a2), d02 = csub(a0, a2), s13 = cadd(a1, a3), d13 = csub(a1, a3);
  a0 = cadd(s02, s13); a2 = csub(s02, s13);
  a1 = make_float2(d02.x - d13.y, d02.y + d13.x);
  a3 = make_float2(d02.x + d13.y, d02.y - d13.x);
}
#define C8 0.9238795325112867f
#define S8 0.3826834323650898f
#define R2 0.7071067811865476f
DI void fft16_fwd(float2 (&v)[16]) {
#pragma unroll
  for (int r0 = 0; r0 < 4; ++r0) r4f(v[r0], v[r0 + 4], v[r0 + 8], v[r0 + 12]);
  v[5]  = cmul(v[5],  make_float2(C8, -S8));
  v[9]  = cmul(v[9],  make_float2(R2, -R2));
  v[13] = cmul(v[13], make_float2(S8, -C8));
  v[6]  = cmul(v[6],  make_float2(R2, -R2));
  v[10] = make_float2(v[10].y, -v[10].x);
  v[14] = cmul(v[14], make_float2(-R2, -R2));
  v[7]  = cmul(v[7],  make_float2(S8, -C8));
  v[11] = cmul(v[11], make_float2(-R2, -R2));
  v[15] = cmul(v[15], make_float2(-C8, S8));
#pragma unroll
  for (int q1 = 0; q1 < 4; ++q1) r4f(v[4 * q1], v[4 * q1 + 1], v[4 * q1 + 2], v[4 * q1 + 3]);
}
DI void fft16_inv(float2 (&v)[16]) {
#pragma unroll
  for (int q1 = 0; q1 < 4; ++q1) r4i(v[4 * q1], v[4 * q1 + 1], v[4 * q1 + 2], v[4 * q1 + 3]);
  v[5]  = cmulc(v[5],  make_float2(C8, -S8));
  v[9]  = cmulc(v[9],  make_float2(R2, -R2));
  v[13] = cmulc(v[13], make_float2(S8, -C8));
  v[6]  = cmulc(v[6],  make_float2(R2, -R2));
  v[10] = make_float2(-v[10].y, v[10].x);
  v[14] = cmulc(v[14], make_float2(-R2, -R2));
  v[7]  = cmulc(v[7],  make_float2(S8, -C8));
  v[11] = cmulc(v[11], make_float2(-R2, -R2));
  v[15] = cmulc(v[15], make_float2(-C8, S8));
#pragma unroll
  for (int r0 = 0; r0 < 4; ++r0) r4i(v[r0], v[r0 + 4], v[r0 + 8], v[r0 + 12]);
}
template <int M, bool INV>
DI void fft_pass16(float2* X) {
  constexpr int S = M / 16;
  static_assert(S == 1024 || S == 64, "addressing below assumes these two sizes");
  const int tid = threadIdx.x;
#pragma unroll 1
  for (int u = 0; u < 2; ++u) {
    const int bf = tid + 512 * u;
    int j = bf % S; const int b = (bf / S) * M;
    asm volatile("" : "+v"(j));
    int pa4[4];
    if (S >= 256) { pa4[0] = b + (j ^ ((j >> 4) & 15)); pa4[1] = pa4[0]; pa4[2] = pa4[0]; pa4[3] = pa4[0]; }
    else {
      const int low = (j & 15) ^ ((j >> 4) & 3);
#pragma unroll
      for (int q = 0; q < 4; ++q) pa4[q] = b + (j & 48) + (low ^ (q << 2));
    }
    float2 v[16];
#pragma unroll
    for (int r = 0; r < 16; ++r) v[r] = X[pa4[r & 3] + r * S];
    const float2 w1 = twid((float)j * (1.0f / (float)M));
    if (!INV) {
      fft16_fwd(v);
      float2 cur = w1;
#pragma unroll
      for (int f = 1; f < 16; ++f) {
        const int slot = ((f & 3) << 2) | (f >> 2);
        v[slot] = cmul(v[slot], cur);
        cur = cmul(cur, w1);
      }
    } else {
      float2 cur = w1;
#pragma unroll
      for (int f = 1; f < 16; ++f) {
        const int slot = ((f & 3) << 2) | (f >> 2);
        v[slot] = cmulc(v[slot], cur);
        cur = cmul(cur, w1);
      }
      fft16_inv(v);
    }
#pragma unroll
    for (int r = 0; r < 16; ++r) X[pa4[r & 3] + r * S] = v[r];
  }
}
template <bool INV>
DI void fft_pass4_64(float2* X) {
  const int tid = threadIdx.x;
#pragma unroll 1
  for (int u = 0; u < 8; ++u) {
    const int bf = tid + 512 * u;
    int j = bf & 15; const int b = (bf >> 4) * 64;
    asm volatile("" : "+v"(j));
    const int xb = ((bf >> 4) & 3) << 2;
    float2* p0 = X + b + (j ^ xb); float2* p1 = X + b + 16 + (j ^ (xb | 1)); float2* p2 = X + b + 32 + (j ^ (xb | 2)); float2* p3 = X + b + 48 + (j ^ (xb | 3));
    float2 a0 = *p0, a1 = *p1, a2 = *p2, a3 = *p3;
    const float2 w1 = twid((float)j * (1.0f / 64.f));
    const float2 w2 = cmul(w1, w1), w3 = cmul(w2, w1);
    if (!INV) {
      r4f(a0, a1, a2, a3);
      a1 = cmul(a1, w1); a2 = cmul(a2, w2); a3 = cmul(a3, w3);
    } else {
      a1 = cmulc(a1, w1); a2 = cmulc(a2, w2); a3 = cmulc(a3, w3);
      r4i(a0, a1, a2, a3);
    }
    *p0 = a0; *p1 = a1; *p2 = a2; *p3 = a3;
  }
}
DI void fft_fwd_head(float2* X) {
  __syncthreads();
  fft_pass16<16384, false>(X); __syncthreads();
  fft_pass16<1024, false>(X);  __syncthreads();
  fft_pass4_64<false>(X);      __syncthreads();
}
DI void fft_inv_tail(float2* X) {
  __syncthreads();
  fft_pass4_64<true>(X);       __syncthreads();
  fft_pass16<1024, true>(X);   __syncthreads();
  fft_pass16<16384, true>(X);  __syncthreads();
}
DI int PX(int idx) { return idx ^ ((idx >> 4) & 15); }
DI int pos14(int k) {
  unsigned r = __brev((unsigned)k) >> 18;
  return (int)(((r & 0x1555u) << 1) | ((r >> 1) & 0x1555u));
}
DI void conv3_8(const u16* row, int tl, int L, float w0, float w1, float w2, float* out) {
  const u32x4 c = *(const u32x4*)(row + tl);
  float f[10];
  unpack8(c, f + 1);
  f[0] = (tl > 0) ? bf2f(row[tl - 1]) : 0.f;
  f[9] = (tl + 8 < L) ? bf2f(row[tl + 8]) : 0.f;
#pragma unroll
  for (int i = 0; i < 8; ++i) out[i] = w0 * f[i] + w1 * f[i + 1] + w2 * f[i + 2];
}


template <int I> struct IC { static constexpr int v = I; };
template <bool FIXED>
DI void attn_item(const u16* __restrict__ Q, const u16* __restrict__ Kb, const u16* __restrict__ Vt, u16* __restrict__ mix,
                  int t0, int L, int h, int qb, float M0, char* smem, int tid) {
  const int lane = tid & 63, wid = tid >> 6, l31 = lane & 31, hh = lane >> 5;
  const int tq = t0 + qb * 256 + wid * 32 + l31;
  bf16x8 qf[6];
#pragma unroll
  for (int ks = 0; ks < 6; ++ks) qf[ks] = *(const bf16x8*)(Q + (long)tq * 768 + h * 96 + ks * 16 + hh * 8);
  f32x16 o[2];
#pragma unroll
  for (int i = 0; i < 16; ++i) { o[0][i] = 0.f; o[1][i] = 0.f; }
  float m_run = FIXED ? M0 : -1e30f, l_run = 0.f;
  u32x4 rk[3], rv[2];
  const u16* gK[3]; int sK[3];
#pragma unroll
  for (int i = 0; i < 3; ++i) {
    const int id = tid + 512 * i, row = id / 12, c = id % 12;
    gK[i] = Kb + ((long)h * T_TOK + t0 + row) * 96 + c * 8;
    sK[i] = row * 208 + c * 16;
  }
  const u16* gV[2]; int sV[2];
#pragma unroll
  for (int i = 0; i < 2; ++i) {
    const int id = tid + 512 * i, dv = id >> 4, c = id & 15;
    gV[i] = Vt + (long)(h * 64 + dv) * T_TOK + t0 + c * 8;
    sV[i] = 26624 + dv * 264 + c * 16;
  }
  const int ntile = L >> 7;
#pragma unroll
  for (int i = 0; i < 3; ++i) rk[i] = *(const u32x4*)(gK[i]);
#pragma unroll
  for (int i = 0; i < 2; ++i) rv[i] = *(const u32x4*)(gV[i]);
#pragma unroll
  for (int i = 0; i < 3; ++i) *(u32x4*)(smem + sK[i]) = rk[i];
#pragma unroll
  for (int i = 0; i < 2; ++i) { u32x2 a, b; a[0] = rv[i][0]; a[1] = rv[i][1]; b[0] = rv[i][2]; b[1] = rv[i][3];
    *(u32x2*)(smem + sV[i]) = a; *(u32x2*)(smem + sV[i] + 8) = b; }
  __syncthreads();
#define AT_QK(S, half, k2, ks) S[k2] = __builtin_amdgcn_mfma_f32_32x32x16_bf16( \
    *(const bf16x8*)(Ks + ((half) * 64 + (k2) * 32 + l31) * 208 + ((ks) * 2 + hh) * 16), qf[ks], S[k2], 0, 0, 0)
#define AT_PV(half, k2, st, dvt, PB) do { const char* ad_ = Vs + ((dvt) * 32 + l31) * 264 + ((half) * 64 + (k2) * 32 + (st) * 16 + hh * 4) * 2; \
    const s16x4 lo_ = *(const s16x4*)(ad_); const s16x4 hi_ = *(const s16x4*)(ad_ + 16); \
    o[dvt] = __builtin_amdgcn_mfma_f32_32x32x16_bf16(__builtin_shufflevector(lo_, hi_, 0, 1, 2, 3, 4, 5, 6, 7), PB, o[dvt], 0, 0, 0); } while (0)
#define AT_PACK(S, k2, st) __builtin_bit_cast(bf16x8, (u32x4){pack2(S[k2][8 * (st) + 0], S[k2][8 * (st) + 1]), pack2(S[k2][8 * (st) + 2], S[k2][8 * (st) + 3]), \
    pack2(S[k2][8 * (st) + 4], S[k2][8 * (st) + 5]), pack2(S[k2][8 * (st) + 6], S[k2][8 * (st) + 7])})
  for (int kt = 0; kt < ntile; ++kt) {
    if (kt + 1 < ntile) {
#pragma unroll
      for (int i = 0; i < 3; ++i) rk[i] = *(const u32x4*)(gK[i] + (long)(kt + 1) * 128 * 96);
#pragma unroll
      for (int i = 0; i < 2; ++i) rv[i] = *(const u32x4*)(gV[i] + (kt + 1) * 128);
    }
    const char* Ks = smem + (kt & 1) * 43520;
    const char* Vs = Ks + 26624;
    if (FIXED) {
#define AT_D 3
#define AT_KF(half, k2, ks) (*(const bf16x8*)(Ks + ((half) * 64 + (k2) * 32 + l31) * 208 + ((ks) * 2 + hh) * 16))
#define AT_VADDR(half, step) (Vs + (((step) & 1) * 32 + l31) * 264 + ((half) * 64 + ((step) >> 2) * 32 + (((step) >> 1) & 1) * 16 + hh * 4) * 2)
#define AT_VF(half, step) __builtin_shufflevector(*(const s16x4*)(AT_VADDR(half, step)), *(const s16x4*)(AT_VADDR(half, step) + 16), 0, 1, 2, 3, 4, 5, 6, 7)
#define AT_RD(i) (((i) < 12) ? AT_KF(0, (i) & 1, (i) >> 1) : ((i) < 24) ? AT_KF(1, ((i) - 12) & 1, ((i) - 12) >> 1) : ((i) < 32) ? AT_VF(0, (i) - 24) : AT_VF(1, (i) - 32))
      f32x16 sa[2], sb[2];
      const float ninit = -M0;
#pragma unroll
      for (int i = 0; i < 16; ++i) { sa[0][i] = ninit; sa[1][i] = ninit; sb[0][i] = ninit; sb[1][i] = ninit; }
      bf16x8 fr[40];
      bf16x8 pa[2][2];
      float rsum = 0.f;
#pragma unroll
      for (int i = 0; i < AT_D; ++i) fr[i] = AT_RD(i);
      auto at_step = [&](auto ic) {
        constexpr int i = decltype(ic)::v;
        if (i + AT_D < 40) fr[(i + AT_D) % 40] = AT_RD(i + AT_D);
        if (i < 12) {
          sa[i & 1] = __builtin_amdgcn_mfma_f32_32x32x16_bf16(fr[i], qf[i >> 1], sa[i & 1], 0, 0, 0);
        } else if (i < 24) {
          const int j = i - 12;
          sb[j & 1] = __builtin_amdgcn_mfma_f32_32x32x16_bf16(fr[i], qf[j >> 1], sb[j & 1], 0, 0, 0);
#pragma unroll
          for (int e = j * 3; e < j * 3 + 3; ++e) if (e < 32) { const float pv = __builtin_amdgcn_exp2f(sa[e >> 4][e & 15]); sa[e >> 4][e & 15] = pv; rsum += pv; }
          if (j == 11) {
#pragma unroll
            for (int k2 = 0; k2 < 2; ++k2)
#pragma unroll
              for (int st = 0; st < 2; ++st) pa[k2][st] = AT_PACK(sa, k2, st);
          }
        } else if (i < 32) {
          const int j = i - 24;
          o[j & 1] = __builtin_amdgcn_mfma_f32_32x32x16_bf16(fr[i], pa[j >> 2][(j >> 1) & 1], o[j & 1], 0, 0, 0);
#pragma unroll
          for (int e = j * 4; e < j * 4 + 4; ++e) { const float pv = __builtin_amdgcn_exp2f(sb[e >> 4][e & 15]); sb[e >> 4][e & 15] = pv; rsum += pv; }
        } else {
          const int j = i - 32;
          if (j == 0) {
#pragma unroll
            for (int k2 = 0; k2 < 2; ++k2)
#pragma unroll
              for (int st = 0; st < 2; ++st) pa[k2][st] = AT_PACK(sb, k2, st);
          }
          o[j & 1] = __builtin_amdgcn_mfma_f32_32x32x16_bf16(fr[i], pa[j >> 2][(j >> 1) & 1], o[j & 1], 0, 0, 0);
        }
#ifdef AT_PIN
        __builtin_amdgcn_sched_barrier(0);
#endif
      };
#define AT_S4(b) at_step(IC<(b)>{}); at_step(IC<(b) + 1>{}); at_step(IC<(b) + 2>{}); at_step(IC<(b) + 3>{});
      AT_S4(0) AT_S4(4) AT_S4(8) AT_S4(12) AT_S4(16) AT_S4(20) AT_S4(24) AT_S4(28) AT_S4(32) AT_S4(36)
#undef AT_S4
      l_run += rsum;
#undef AT_D
#undef AT_KF
#undef AT_VADDR
#undef AT_VF
#undef AT_RD
    } else {
#pragma unroll
      for (int half = 0; half < 2; ++half) {
        f32x16 s[2];
#pragma unroll
        for (int i = 0; i < 16; ++i) { s[0][i] = 0.f; s[1][i] = 0.f; }
#pragma unroll
        for (int ks = 0; ks < 6; ++ks) { AT_QK(s, half, 0, ks); AT_QK(s, half, 1, ks); }
        float mloc = s[0][0];
#pragma unroll
        for (int i = 1; i < 16; ++i) mloc = fmaxf(mloc, s[0][i]);
#pragma unroll
        for (int i = 0; i < 16; ++i) mloc = fmaxf(mloc, s[1][i]);
        mloc = fmaxf(mloc, __shfl_xor(mloc, 32));
        const bool need = mloc > m_run + 8.f;
        if (__builtin_amdgcn_ballot_w64(need) != 0ull) {
          const float mnew = need ? mloc : m_run;
          const float alpha = __builtin_amdgcn_exp2f(m_run - mnew);
          m_run = mnew;
          l_run *= alpha;
#pragma unroll
          for (int i = 0; i < 16; ++i) { o[0][i] *= alpha; o[1][i] *= alpha; }
        }
        float rsum = 0.f;
#pragma unroll
        for (int k2 = 0; k2 < 2; ++k2)
#pragma unroll
          for (int i = 0; i < 16; ++i) { const float pv = __builtin_amdgcn_exp2f(s[k2][i] - m_run); s[k2][i] = pv; rsum += pv; }
        l_run += rsum;
#pragma unroll
        for (int k2 = 0; k2 < 2; ++k2)
#pragma unroll
          for (int st = 0; st < 2; ++st) {
            const bf16x8 pb = AT_PACK(s, k2, st);
            AT_PV(half, k2, st, 0, pb);
            AT_PV(half, k2, st, 1, pb);
          }
      }
    }
    if (kt + 1 < ntile) {
      char* d = smem + ((kt + 1) & 1) * 43520;
#pragma unroll
      for (int i = 0; i < 3; ++i) *(u32x4*)(d + sK[i]) = rk[i];
#pragma unroll
      for (int i = 0; i < 2; ++i) { u32x2 a, b; a[0] = rv[i][0]; a[1] = rv[i][1]; b[0] = rv[i][2]; b[1] = rv[i][3];
        *(u32x2*)(d + sV[i]) = a; *(u32x2*)(d + sV[i] + 8) = b; }
    }
    __syncthreads();
  }
#undef AT_QK
#undef AT_PV
#undef AT_PACK
  const float ltot = l_run + __shfl_xor(l_run, 32);
  const float inv = 1.f / ltot;
#pragma unroll
  for (int dvt = 0; dvt < 2; ++dvt)
#pragma unroll
    for (int g = 0; g < 4; ++g) {
      u32x2 w;
      w[0] = pack2(o[dvt][4 * g] * inv, o[dvt][4 * g + 1] * inv);
      w[1] = pack2(o[dvt][4 * g + 2] * inv, o[dvt][4 * g + 3] * inv);
      *(u32x2*)(mix + (long)tq * 1024 + 512 + h * 64 + dvt * 32 + 8 * g + 4 * hh) = w;
    }
}

DI void grid_bar(unsigned* bw, unsigned& epoch, unsigned G) {
  asm volatile("s_waitcnt vmcnt(0)" ::: "memory");
  __syncthreads();
  if (threadIdx.x == 0) {
    __builtin_amdgcn_fence(__ATOMIC_RELEASE, "agent");
    asm volatile("s_waitcnt vmcnt(0)" ::: "memory");
    epoch += 1u;
    const unsigned g = blockIdx.x & 7u, ng = (G + 7u - g) >> 3;
    const unsigned old = __hip_atomic_fetch_add(bw + 64 * g, 1u, __ATOMIC_RELAXED, __HIP_MEMORY_SCOPE_AGENT);
    if (old + 1u == ng * epoch) {
      const unsigned ngrp = G < 8u ? G : 8u;
      const unsigned t = __hip_atomic_fetch_add(bw + 64 * 8, 1u, __ATOMIC_RELAXED, __HIP_MEMORY_SCOPE_AGENT);
      if (t + 1u == ngrp * epoch) __hip_atomic_store(bw + 64 * 9, epoch, __ATOMIC_RELAXED, __HIP_MEMORY_SCOPE_AGENT);
    }
    unsigned spins = 0;
    while (__hip_atomic_load(bw + 64 * 9, __ATOMIC_RELAXED, __HIP_MEMORY_SCOPE_AGENT) < epoch) {
      __builtin_amdgcn_s_sleep(1);
      if (++spins > (1u << 24)) break;
    }
    __builtin_amdgcn_fence(__ATOMIC_ACQUIRE, "agent");
    asm volatile("s_waitcnt vmcnt(0)" ::: "memory");
  }
  __syncthreads();
}


__global__ void __launch_bounds__(NTHR) __attribute__((target("no-packed-fp32-ops"))) fwd_kernel(Params p) {
  __shared__ __attribute__((aligned(16))) char smem[163840];
  cg::grid_group grid = cg::this_grid();
  const int G = gridDim.x, bid = blockIdx.x;
  const int vb = (bid & 7) * (G >> 3) + (bid >> 3);
  const int NW = G * 8;
  const long GT = (long)G * NTHR;
#define PHASE_IDS int tid = threadIdx.x; asm volatile("" : "+v"(tid)); const int lane = tid & 63, wid = tid >> 6; \
  const int gw = bid * 8 + wid; const long gtid = (long)bid * NTHR + tid; (void)lane; (void)gw; (void)gtid;
  char* ws = p.ws;
  char* dsc = (char*)p.out;
  float* rowss = (float*)(ws + SM_ROWSS);
  u16* XB = (u16*)(ws + OFF_XB);
  unsigned* barcnt = (unsigned*)ws;
  unsigned bar_target = 0;
  if (p.ws == nullptr) grid.sync();
  PG8_LAS unsigned char* lds = (PG8_LAS unsigned char*)smem;

  if (PHM & (1 << 0)) {
    PHASE_IDS
    {
#define CW_LIST(X) \
      X(0, p.in[7], p.in[7], 1952, 1024, 2048, W0_IN, p.in[2], 0) \
      X(1, p.in[11], p.in[11], 768, 256, 768, W0_Q, p.in[2], 4) \
      X(2, p.in[12], p.in[12], 1024, 128, 512, W0_K, p.in[2], 5) \
      X(3, p.in[12], p.in[12], 1024, 128, 512, W0_V, p.in[2], 6) \
      X(4, p.in[15], p.in[15], 1024, 1024, 1024, W0_OUT, p.in[2], 4) \
      X(5, p.in[4], p.in[5], 2816, 1024, 5632, W0_GU, p.in[3], 3) \
      X(6, p.in[6], p.in[6], 1024, 2816, 1024, W0_D, p.in[2], 4) \
      X(7, p.in[16], p.in[16], 3072, 1024, 3072, W1_CIN, (p.in[2] + 1024), 0) \
      X(8, p.in[27], p.in[27], 1024, 1024, 1024, W1_COUT, p.in[2], 4) \
      X(9, p.in[25], p.in[25], 2048, 64, 2048, W1_W4, p.in[2], 4) \
      X(10, (p.in[4] + 1024 * 2816), (p.in[5] + 1024 * 2816), 2816, 1024, 5632, W1_GU, (p.in[3] + 1024), 3) \
      X(11, (p.in[6] + 2816 * 1024), (p.in[6] + 2816 * 1024), 1024, 2816, 1024, W1_D, p.in[2], 4)
      int total = 0;
#define CW_CNT(i, s1, s2, ns, k, np, off, g, kind) const int cw_start##i = total; total += (np) * ((k) >> 3);
      CW_LIST(CW_CNT)
#undef CW_CNT
#pragma unroll 4
      for (int it = (int)gtid; it < total; it += (int)GT) {
        const float* s1 = nullptr; const float* s2 = nullptr; const float* gp = nullptr; u16* dst = nullptr;
        int Nsrc = 0, K = 0, Np = 1, kind = 0, st = 0;
#define CW_SEL(i, a1, a2, ns, k, np, off, g, kd) if (it >= cw_start##i) { s1 = a1; s2 = a2; gp = g; dst = (u16*)(ws + off); Nsrc = ns; K = k; Np = np; kind = kd; st = cw_start##i; }
        CW_LIST(CW_SEL)
#undef CW_SEL
        const int li = it - st;
        const int np = li % Np, kc = li / Np;
        const float* sp = s1; int n = np; bool valid = true;
        if (kind == 0) valid = np < Nsrc;
        else if (kind == 5) n = (np >> 6) * 128 + (np & 63);
        else if (kind == 6) n = (np >> 6) * 128 + 64 + (np & 63);
        else if (kind == 3) { const int g = np >> 5, w = np & 31; sp = (w < 16) ? s1 : s2; n = g * 16 + (w & 15); }
        const bool hasg = (kind == 0) || (kind == 3);
        float f[8];
#pragma unroll
        for (int j = 0; j < 8; ++j) {
          const int k = kc * 8 + j;
          float v = valid ? __builtin_nontemporal_load(sp + (long)k * Nsrc + n) : 0.f;
          const float gv = hasg ? gp[k] : 1.f;
          f[j] = v * gv;
        }
        *(u32x4*)(dst + (long)np * K + kc * 8) = pack8(f);
      }
#undef CW_LIST
    }
    for (int row0 = gw * 4; row0 < T_TOK; row0 += NW * 4) {
      float4 va[4][4];
#pragma unroll
      for (int r = 0; r < 4; ++r) {
        const int row = row0 + r;
        const float* xr = (row < 16384) ? (p.in[0] + (long)row * DM) : (p.in[1] + (long)(row - 16384) * DM);
#pragma unroll
        for (int hb = 0; hb < 2; ++hb) {
          const f32x4 q0 = __builtin_nontemporal_load((const f32x4*)(xr + hb * 512 + lane * 8));
          const f32x4 q1 = __builtin_nontemporal_load((const f32x4*)(xr + hb * 512 + lane * 8 + 4));
          va[r][2 * hb] = make_float4(q0[0], q0[1], q0[2], q0[3]); va[r][2 * hb + 1] = make_float4(q1[0], q1[1], q1[2], q1[3]);
        }
      }
#pragma unroll
      for (int r = 0; r < 4; ++r) {
        const int row = row0 + r;
        float ss = 0.f;
#pragma unroll
        for (int hb = 0; hb < 2; ++hb) {
          const float4 a = va[r][2 * hb], b = va[r][2 * hb + 1];
          ss += a.x * a.x + a.y * a.y + a.z * a.z + a.w * a.w + b.x * b.x + b.y * b.y + b.z * b.z + b.w * b.w;
          u32x4 o; o[0] = pack2(a.x, a.y); o[1] = pack2(a.z, a.w); o[2] = pack2(b.x, b.y); o[3] = pack2(b.z, b.w);
          *(u32x4*)(XB + (long)row * DM + hb * 512 + lane * 8) = o;
        }
        ss = wave_sum(ss);
        if (lane == 0) rowss[row] = ss;
      }
    }
    for (long i = gtid; i < 3 * T_TOK; i += GT) rowss[T_TOK + i] = 0.f;
    float2* rope = (float2*)(ws + R_ROPE);
    for (long e = gtid; e < 16384 * 16; e += GT) {
      const int pos = (int)(e >> 4), i = (int)(e & 15);
      const int lo = i & 3, hi = i >> 2;
      const double base = (lo == 0) ? 1.0 : (lo == 1) ? 0.5623413251903491 : (lo == 2) ? 0.31622776601683794 : 0.1778279410038923;
      const double sc = (hi == 0) ? 1.0 : (hi == 1) ? 0.1 : (hi == 2) ? 0.01 : 0.001;
      double rev = (double)pos * (base * sc) * 0.15915494309189535;
      rev -= floor(rev);
      const float rf = (float)rev;
      rope[e] = make_float2(__builtin_amdgcn_cosf(rf), __builtin_amdgcn_sinf(rf));
    }

    {
      const float* w1 = p.in[18]; const float* b1 = p.in[19];
      const float* w2 = p.in[20]; const float* b2 = p.in[21];
      const float* w3 = p.in[22]; const float* b3 = p.in[23];
      const float* fq = p.in[24];
      const float INV2PI = 0.15915494309189535f;
      float w1c[33], w2c[64], w3c[64];
#pragma unroll
      for (int k = 0; k < 33; ++k) w1c[k] = w1[k * 64 + lane];
#pragma unroll
      for (int k = 0; k < 64; ++k) { w2c[k] = w2[k * 64 + lane]; w3c[k] = w3[k * 64 + lane]; }
      const float bb1 = b1[lane], bb2 = b2[lane], bb3 = b3[lane];
      const float f1 = fq[lane] * INV2PI, f2 = fq[64 + lane] * INV2PI, f3 = fq[128 + lane] * INV2PI;
#pragma unroll 1
      for (int rg = 0; rg < 3; ++rg) {
        const int rbase = gw * 12 + rg * 4;
        if (rbase < 24576) {
          float zr[4], acc[4];
#pragma unroll
          for (int r = 0; r < 4; ++r) {
            const int rr = rbase + r;
            const int Lf = (rr < 8192) ? 8192 : 16384;
            const int l = (rr < 8192) ? rr : (rr - 8192);
            const float tpos = (float)l / (float)(Lf - 1);
            const float frac = (float)l / (float)Lf;
            const int bi = (lane >= 17) ? (lane - 17) : (lane - 1);
            const float band = 1e-4f + (float)bi * ((15.f - 1e-4f) / 15.f);
            const float rev = frac * band;
            zr[r] = (lane == 0) ? tpos : ((lane <= 16) ? __builtin_amdgcn_cosf(rev) : -__builtin_amdgcn_sinf(rev));
            acc[r] = bb1;
          }
#pragma unroll
          for (int k = 0; k < 33; ++k)
#pragma unroll
            for (int r = 0; r < 4; ++r) acc[r] += __int_as_float(__builtin_amdgcn_readlane(__float_as_int(zr[r]), k)) * w1c[k];
#pragma unroll
          for (int r = 0; r < 4; ++r) { zr[r] = __builtin_amdgcn_sinf(f1 * acc[r]); acc[r] = bb2; }
#pragma unroll
          for (int k = 0; k < 64; ++k)
#pragma unroll
            for (int r = 0; r < 4; ++r) acc[r] += __int_as_float(__builtin_amdgcn_readlane(__float_as_int(zr[r]), k)) * w2c[k];
#pragma unroll
          for (int r = 0; r < 4; ++r) { zr[r] = __builtin_amdgcn_sinf(f2 * acc[r]); acc[r] = bb3; }
#pragma unroll
          for (int k = 0; k < 64; ++k)
#pragma unroll
            for (int r = 0; r < 4; ++r) acc[r] += __int_as_float(__builtin_amdgcn_readlane(__float_as_int(zr[r]), k)) * w3c[k];
          u16* z3 = (u16*)(ws + SM_Z3);
#pragma unroll
          for (int r = 0; r < 4; ++r) z3[(long)(rbase + r) * 64 + lane] = f2bf(__builtin_amdgcn_sinf(f3 * acc[r]));
        }
      }
    }
  }
  grid_bar(barcnt, bar_target, (unsigned)G);

  for (int rep = 0; rep < REP1; ++rep) if (PHM & (1 << 1)) {
    pg8::Gemm g{XB, (const u16*)(ws + W0_IN), T_TOK, 2048, DM};
    pg8::StaticOrder S; S.init(T_TOK, 2048, G, bid);
    EpiRowScaleBf16 E{(u16*)dsc, 2048, rowss};
    pg8::gemm_phase<EpiRowScaleBf16, pg8::StaticOrder>(lds, g, S, E, nullptr);
  }
  grid_bar(barcnt, bar_target, (unsigned)G);

  if (PHM & (1 << 2)) {
    PHASE_IDS
    const u16* proj = (const u16*)dsc;
    u16* mix = (u16*)(ws + R_MIX);
    u16* cqn = (u16*)(ws + R_CQN);
    u16* ckvn = (u16*)(ws + R_CKVN);
    u16* kpe = (u16*)(ws + R_KPE);
    float* sskpe = (float*)(ws + SM_SSKPE);
    const float* cw = p.in[8];
    float w0[8], w1[8], w2[8];
#pragma unroll
    for (int i = 0; i < 8; ++i) { w0[i] = cw[(lane * 8 + i) * 3]; w1[i] = cw[(lane * 8 + i) * 3 + 1]; w2[i] = cw[(lane * 8 + i) * 3 + 2]; }
    float gq[4], gk[2];
#pragma unroll
    for (int i = 0; i < 4; ++i) gq[i] = p.in[9][lane * 4 + i];
    gk[0] = p.in[10][lane * 2]; gk[1] = p.in[10][lane * 2 + 1];
    for (int t = gw; t < T_TOK; t += NW) {
      int t0, L; seq_of(t, t0, L);
      const u16* pr = proj + (long)t * 2048;
      const int c = lane * 8;
      float gb[8], mc[8], mp[8], mn[8], a[8], b[8];
      unpack8(*(const u32x4*)(pr + c), gb);
      unpack8(*(const u32x4*)(pr + 512 + c), a); unpack8(*(const u32x4*)(pr + 1024 + c), b);
#pragma unroll
      for (int i = 0; i < 8; ++i) mc[i] = a[i] * b[i];
      if (t > t0) {
        unpack8(*(const u32x4*)(pr - 2048 + 512 + c), a); unpack8(*(const u32x4*)(pr - 2048 + 1024 + c), b);
#pragma unroll
        for (int i = 0; i < 8; ++i) mp[i] = a[i] * b[i];
      } else {
#pragma unroll
        for (int i = 0; i < 8; ++i) mp[i] = 0.f;
      }
      if (t < t0 + L - 1) {
        unpack8(*(const u32x4*)(pr + 2048 + 512 + c), a); unpack8(*(const u32x4*)(pr + 2048 + 1024 + c), b);
#pragma unroll
        for (int i = 0; i < 8; ++i) mn[i] = a[i] * b[i];
      } else {
#pragma unroll
        for (int i = 0; i < 8; ++i) mn[i] = 0.f;
      }
      float y[8];
#pragma unroll
      for (int i = 0; i < 8; ++i) y[i] = gb[i] * (w0[i] * mp[i] + w1[i] * mc[i] + w2[i] * mn[i]);
      *(u32x4*)(mix + (long)t * 1024 + c) = pack8(y);
      {
        const u32x2 v = *(const u32x2*)(pr + 1536 + lane * 4);
        float f0 = lo_bf(v[0]), f1 = hi_bf(v[0]), f2 = lo_bf(v[1]), f3 = hi_bf(v[1]);
        const float ss = wave_sum(f0 * f0 + f1 * f1 + f2 * f2 + f3 * f3);
        const float rs = rsqrtf(ss * (1.f / 256.f) + EPSN);
        u32x2 o; o[0] = pack2(f0 * rs * gq[0], f1 * rs * gq[1]); o[1] = pack2(f2 * rs * gq[2], f3 * rs * gq[3]);
        *(u32x2*)(cqn + (long)t * 256 + lane * 4) = o;
      }
      {
        const unsigned v = *(const unsigned*)(pr + 1792 + lane * 2);
        float f0 = lo_bf(v), f1 = hi_bf(v);
        const float ss = wave_sum(f0 * f0 + f1 * f1);
        const float rs = rsqrtf(ss * (1.f / 128.f) + EPSN);
        *(unsigned*)(ckvn + (long)t * 128 + lane * 2) = pack2(f0 * rs * gk[0], f1 * rs * gk[1]);
      }
      {
        const unsigned v = (lane < 16) ? *(const unsigned*)(pr + 1920 + lane * 2) : 0u;
        if (lane < 16) *(unsigned*)(kpe + (long)t * 32 + lane * 2) = v;
        const float f0 = lo_bf(v), f1 = hi_bf(v);
        const float ss = wave_sum(f0 * f0 + f1 * f1);
        if (lane == 0) sskpe[t] = ss;
      }
    }
  }
  grid_bar(barcnt, bar_target, (unsigned)G);

  if (PHM & (1 << 3)) {
    PHASE_IDS
    const u16* cqn = (const u16*)(ws + R_CQN);
    const u16* ckvn = (const u16*)(ws + R_CKVN);
    const u16* kpe = (const u16*)(ws + R_KPE);
    const float* sskpe = (const float*)(ws + SM_SSKPE);
    const float2* rope = (const float2*)(ws + R_ROPE);
    u16* Qo = (u16*)(dsc + D_QRAW);
    u16* Kb = (u16*)(ws + R_K);
    u16* Vt = (u16*)(dsc + D_VT);
    const float* qn = p.in[13]; const float* kn = p.in[14];
    const float qscale = 0.10206207261596577f * 1.4426950408889634f;
    for (int tile = vb; tile < 512 + 512 + 512; tile += G) {
      if (tile < 512) {
        const int tm = tile >> 2, tn = tile & 3;
        gemm_tile<6>(cqn + (long)tm * 256 * 256, 256, (const u16*)(ws + W0_Q) + (long)tn * 192 * 256, 256, 256, smem,
          [&](f32x4 (&acc)[4][6], int r0, int c0) {
            const int fr_ = c0 % 96, h = tn * 2 + c0 / 96;
#pragma unroll
            for (int mi = 0; mi < 4; ++mi)
#pragma unroll
              for (int j = 0; j < 4; ++j) {
                const int row = tm * 256 + r0 + mi * 16 + j;
                float ss = 0.f;
#pragma unroll
                for (int ni = 0; ni < 6; ++ni) ss += acc[mi][ni][j] * acc[mi][ni][j];
                ss += __shfl_xor(ss, 8); ss += __shfl_xor(ss, 4); ss += __shfl_xor(ss, 2); ss += __shfl_xor(ss, 1);
                const float rs = rsqrtf(ss * (1.f / 96.f) + EPSN) * qscale;
                int t0, L; seq_of(row, t0, L);
                const float2 cs = rope[(long)(row - t0) * 16 + fr_];
                u16* qp = Qo + (long)row * 768 + h * 96 + fr_;
#pragma unroll
                for (int ni = 0; ni < 4; ++ni) qp[ni * 16] = f2bf(acc[mi][ni][j] * rs * qn[ni * 16 + fr_]);
                const float x1 = acc[mi][4][j] * rs * qn[64 + fr_], x2 = acc[mi][5][j] * rs * qn[80 + fr_];
                qp[64] = f2bf(x1 * cs.x - x2 * cs.y);
                qp[80] = f2bf(x1 * cs.y + x2 * cs.x);
              }
          });
      } else if (tile < 1024) {
        const int tt = tile - 512, tm = tt >> 2, tn = tt & 3;
        gemm_tile<4>(ckvn + (long)tm * 256 * 128, 128, (const u16*)(ws + W0_K) + (long)tn * 128 * 128, 128, 128, smem,
          [&](f32x4 (&acc)[4][4], int r0, int c0) {
            const int fr_ = c0 & 63, h = tn * 2 + (c0 >> 6);
#pragma unroll
            for (int mi = 0; mi < 4; ++mi)
#pragma unroll
              for (int j = 0; j < 4; ++j) {
                const int row = tm * 256 + r0 + mi * 16 + j;
                float ss = 0.f;
#pragma unroll
                for (int ni = 0; ni < 4; ++ni) ss += acc[mi][ni][j] * acc[mi][ni][j];
                ss += __shfl_xor(ss, 8); ss += __shfl_xor(ss, 4); ss += __shfl_xor(ss, 2); ss += __shfl_xor(ss, 1);
                const float rs = rsqrtf((ss + sskpe[row]) * (1.f / 96.f) + EPSN);
                int t0, L; seq_of(row, t0, L);
                const float2 cs = rope[(long)(row - t0) * 16 + fr_];
                u16* kp = Kb + ((long)h * T_TOK + row) * 96 + fr_;
#pragma unroll
                for (int ni = 0; ni < 4; ++ni) kp[ni * 16] = f2bf(acc[mi][ni][j] * rs * kn[ni * 16 + fr_]);
                const float x1 = bf2f(kpe[(long)row * 32 + fr_]) * rs * kn[64 + fr_], x2 = bf2f(kpe[(long)row * 32 + 16 + fr_]) * rs * kn[80 + fr_];
                kp[64] = f2bf(x1 * cs.x - x2 * cs.y);
                kp[80] = f2bf(x1 * cs.y + x2 * cs.x);
              }
          });
      } else {
        const int tt = tile - 1024, tm = tt & 1, tn = tt >> 1;
        gemm_tile<4>((const u16*)(ws + W0_V) + (long)tm * 256 * 128, 128, ckvn + (long)tn * 128 * 128, 128, 128, smem,
          [&](f32x4 (&acc)[4][4], int r0, int c0) {
#pragma unroll
            for (int mi = 0; mi < 4; ++mi)
#pragma unroll
              for (int j = 0; j < 4; ++j)
#pragma unroll
                for (int ni = 0; ni < 4; ++ni)
                  Vt[(long)(tm * 256 + r0 + mi * 16 + j) * T_TOK + tn * 128 + c0 + ni * 16] = f2bf(acc[mi][ni][j]);
          });
      }
    }
  }
  grid_bar(barcnt, bar_target, (unsigned)G);

  for (int rep = 0; rep < REP5; ++rep) if (PHM & (1 << 5)) {
    PHASE_IDS
    const u16* Q = (const u16*)(dsc + D_QRAW);
    const u16* Kb = (const u16*)(ws + R_K);
    const u16* Vt = (const u16*)(dsc + D_VT);
    u16* mix = (u16*)(ws + R_MIX);
    float mq = 0.f, mk = 0.f;
    for (int i = 0; i < 96; ++i) { mq = fmaxf(mq, fabsf(p.in[13][i])); mk = fmaxf(mk, fabsf(p.in[14][i])); }
    const float M0 = 96.f * mq * mk * (0.10206207261596577f * 1.4426950408889634f) * 1.02f + 0.5f;
    const bool fixed_ref = M0 < 40.f;
    for (int item = vb; item < 1024; item += G) {
      int t0, L, h, qb;
      if (item < 512) { t0 = 16384; L = 16384; h = item >> 6; qb = item & 63; }
      else { const int it = item - 512; const int sq = it >> 8; t0 = sq * 8192; L = 8192; h = (it >> 5) & 7; qb = it & 31; }
      if (fixed_ref) attn_item<true>(Q, Kb, Vt, mix, t0, L, h, qb, M0, smem, tid);
      else attn_item<false>(Q, Kb, Vt, mix, t0, L, h, qb, M0, smem, tid);
    }
  }
  grid_bar(barcnt, bar_target, (unsigned)G);

  if (PHM & (1 << 6)) {
    pg8::Gemm g{(const u16*)(ws + R_MIX), (const u16*)(ws + W0_OUT), T_TOK, DM, DM};
    pg8::StaticOrder S; S.init(T_TOK, DM, G, bid);
    EpiResid E{XB, rowss + T_TOK};
    pg8::gemm_phase<EpiResid, pg8::StaticOrder>(lds, g, S, E, nullptr);
  }
  grid_bar(barcnt, bar_target, (unsigned)G);
  for (int rep = 0; rep < REP7; ++rep) if (PHM & (1 << 7)) {
    pg8::Gemm g{XB, (const u16*)(ws + W0_GU), T_TOK, 5632, DM};
    pg8::StaticOrder S; S.init(T_TOK, 5632, G, bid);
    EpiGU E{(u16*)(ws + OFF_R), (u16*)dsc, 16384, rowss + T_TOK, 0};
    pg8::gemm_phase<EpiGU, pg8::StaticOrder>(lds, g, S, E, nullptr);
  }
  grid_bar(barcnt, bar_target, (unsigned)G);
  if (PHM & (1 << 7)) {
    pg8::Gemm g{(const u16*)(ws + OFF_R), (const u16*)(ws + W0_D), T_TOK, DM, DFF};
    SplitOrder S; S.init(T_TOK, DM, G, bid); S.base2 = (const char*)dsc; S.split = 64;
    EpiResid E{XB, rowss + 2 * T_TOK};
    pg8::gemm_phase<EpiResid, SplitOrder>(lds, g, S, E, nullptr);
  }
  grid_bar(barcnt, bar_target, (unsigned)G);

  for (int rep = 0; rep < REP8; ++rep) if (PHM & (1 << 8)) {
    const u16* Wt = (const u16*)(ws + W1_CIN);
    u16* x0t = (u16*)(ws + C_X0T);
    u16* x1vt = (u16*)dsc;
    const float* ssq = rowss + 2 * T_TOK;
    {
      pg8::Gemm g{Wt, XB, 3072, T_TOK, DM};
      pg8::StaticOrder S; S.init(3072, T_TOK, G, bid);
      EpiCin E{x0t, x1vt, ssq};
      pg8::gemm_phase<EpiCin, pg8::StaticOrder>(lds, g, S, E, nullptr);
    }
    for (int tile = 3072 + vb; tile < 3072 + 1536; tile += G) {
      {
        const int tt = tile - 3072;
        const bool smp = tt >= 512;
        const int t2 = smp ? tt - 512 : tt;
        const int tm = t2 & 7, tn = t2 >> 3;
        const int Lf = smp ? 16384 : 8192;
        const u16* z3 = (const u16*)(ws + SM_Z3) + (smp ? (long)8192 * 64 : 0);
        u16* kern = smp ? (u16*)(ws + C_KS) : (u16*)(ws + C_KP);
        gemm_tile((const u16*)(ws + W1_W4) + (long)tm * 256 * 64, 64, z3 + (long)tn * 128 * 64, 64, 64, smem,
          [&](f32x4 (&acc)[4][4], int r0, int c0) {
            const float invLm1 = 1.f / (float)(Lf - 1);
#pragma unroll
            for (int mi = 0; mi < 4; ++mi)
#pragma unroll
              for (int j = 0; j < 4; ++j) {
                const int cp = tm * 256 + r0 + mi * 16 + j;
                const int ch = cp & 1023;
                const bool bwd = cp >= 1024;
                const float ad = 3.0701134573253945f + (float)ch * (12.280453829301578f / 1023.f);
                u16* kr = kern + (long)ch * (2 * Lf);
#pragma unroll
                for (int ni = 0; ni < 4; ++ni) {
                  const int l = tn * 128 + c0 + ni * 16;
                  const float wv = __expf(-(float)l * invLm1 * ad);
                  const float val = acc[mi][ni][j] * wv;
                  if (!bwd) kr[l] = f2bf(val);
                  else if (l > 0) kr[2 * Lf - l] = f2bf(val);
                  else kr[Lf] = 0;
                }
              }
          });
      }
    }
  }
  grid_bar(barcnt, bar_target, (unsigned)G);

  if (PHM & (1 << 9)) {
    PHASE_IDS
    float2* X = (float2*)smem;
    u16* zs = (u16*)(smem + 131072);
    const u16* x0t = (const u16*)(ws + C_X0T);
    u16* x1vt = (u16*)dsc;
    const float* sw = p.in[17];
    const float SCL = 1.f / 16384.f;
    for (int job = vb; job < 2048; job += G) {
      int tidj = threadIdx.x; asm volatile("" : "+v"(tidj));
      const int tid = tidj;
      const bool smp = job >= 1024;
      const int ch = job & 1023;
      const float w00 = sw[ch * 3], w01 = sw[ch * 3 + 1], w02 = sw[ch * 3 + 2];
      const float w10 = sw[(1024 + ch) * 3], w11 = sw[(1024 + ch) * 3 + 1], w12 = sw[(1024 + ch) * 3 + 2];
      const float w20 = sw[(2048 + ch) * 3], w21 = sw[(2048 + ch) * 3 + 1], w22 = sw[(2048 + ch) * 3 + 2];
      const float bias = p.in[26][ch];
      u16* x1row = x1vt + (long)ch * T_TOK;
      const u16* vrow = x1vt + (long)(1024 + ch) * T_TOK;
      const u16* x0row = x0t + (long)ch * T_TOK;
      __syncthreads();
      if (!smp && (FFTP & 1)) {
        const u16* kr = (const u16*)(ws + C_KP) + (long)ch * 16384;
#pragma unroll
        for (int u = 0; u < 4; ++u) {
          const int n = 8 * (tid + 512 * u);
          float f[8]; unpack8(__builtin_nontemporal_load((const u32x4*)(kr + n)), f);
#pragma unroll
          for (int i = 0; i < 8; ++i) X[PX(n + i)] = make_float2(f[i], 0.f);
        }
        fft_fwd_head(X);
        unsigned Kf[2][16];
#pragma unroll
        for (int u = 0; u < 2; ++u) {
          const int g = tid + 512 * u;
          float2 v[16];
#pragma unroll
          for (int r = 0; r < 16; ++r) v[r] = X[16 * g + (r ^ (g & 15))];
          fft16_fwd(v);
#pragma unroll
          for (int r = 0; r < 16; ++r) Kf[u][r] = pack2(v[r].x, v[r].y);
          asm volatile("" ::: "memory");
        }
        __syncthreads();
#pragma unroll 1
        for (int u = 0; u < 2; ++u) {
          const int n = 8 * (tid + 512 * u);
          float z0[8], z1[8];
          {
            float a[8], c[8];
            conv3_8(x1row, n, 8192, w10, w11, w12, a);
            conv3_8(vrow, n, 8192, w20, w21, w22, c);
#pragma unroll
            for (int i = 0; i < 8; ++i) z0[i] = a[i] * c[i];
            conv3_8(x1row + 8192, n, 8192, w10, w11, w12, a);
            conv3_8(vrow + 8192, n, 8192, w20, w21, w22, c);
#pragma unroll
            for (int i = 0; i < 8; ++i) z1[i] = a[i] * c[i];
          }
          *(u32x4*)(zs + n) = pack8(z0);
          *(u32x4*)(zs + 8192 + n) = pack8(z1);
#pragma unroll
          for (int i = 0; i < 8; ++i) { X[PX(n + i)] = make_float2(z0[i], z1[i]); X[PX(8192 + n + i)] = make_float2(0.f, 0.f); }
        }
        fft_fwd_head(X);
#pragma unroll
        for (int u = 0; u < 2; ++u) {
          const int g = tid + 512 * u;
          float2 v[16];
#pragma unroll
          for (int r = 0; r < 16; ++r) v[r] = X[16 * g + (r ^ (g & 15))];
          fft16_fwd(v);
#pragma unroll
          for (int r = 0; r < 16; ++r) v[r] = cmul(v[r], make_float2(lo_bf(Kf[u][r]), hi_bf(Kf[u][r])));
          fft16_inv(v);
#pragma unroll
          for (int r = 0; r < 16; ++r) X[16 * g + (r ^ (g & 15))] = v[r];
          asm volatile("" ::: "memory");
        }
        fft_inv_tail(X);
#pragma unroll 1
        for (int u = 0; u < 2; ++u) {
          const int n = 8 * (tid + 512 * u);
          float yr[8], yi[8], z0[8], z1[8];
          unpack8(*(const u32x4*)(zs + n), z0);
          unpack8(*(const u32x4*)(zs + 8192 + n), z1);
#pragma unroll
          for (int i = 0; i < 8; ++i) { const float2 xv = X[PX(n + i)]; yr[i] = xv.x * SCL + bias * z0[i]; yi[i] = xv.y * SCL + bias * z1[i]; }
          float g0[8];
          conv3_8(x0row, n, 8192, w00, w01, w02, g0);
#pragma unroll
          for (int i = 0; i < 8; ++i) yr[i] *= g0[i];
          conv3_8(x0row + 8192, n, 8192, w00, w01, w02, g0);
#pragma unroll
          for (int i = 0; i < 8; ++i) yi[i] *= g0[i];
          *(u32x4*)(x1row + n) = pack8(yr);
          *(u32x4*)(x1row + 8192 + n) = pack8(yi);
        }
      } else if (smp && (FFTP & 2)) {
        const u16* kr = (const u16*)(ws + C_KS) + (long)ch * 32768;
#pragma unroll
        for (int u = 0; u < 8; ++u) {
          const int n = 4 * (tid + 512 * u);
          float f[8]; unpack8(__builtin_nontemporal_load((const u32x4*)(kr + 2 * n)), f);
#pragma unroll
          for (int i = 0; i < 4; ++i) X[PX(n + i)] = make_float2(f[2 * i], f[2 * i + 1]);
        }
        fft_fwd_head(X);
#pragma unroll 1
        for (int u = 0; u < 2; ++u) {
          const int g = tid + 512 * u;
          float2 v[16];
#pragma unroll
          for (int r = 0; r < 16; ++r) v[r] = X[16 * g + (r ^ (g & 15))];
          fft16_fwd(v);
#pragma unroll
          for (int r = 0; r < 16; ++r) X[16 * g + (r ^ (g & 15))] = v[r];
        }
        __syncthreads();
        unsigned KA[17], KB[17];
#pragma unroll
        for (int m = 0; m < 17; ++m) {
          int k = (m < 16) ? (((tid & 31) << 8) | (m * 16 + ((tid >> 6) << 1) + ((tid >> 5) & 1))) : 8192;
          asm volatile("" : "+v"(k) :: "memory");
          if (m < 16 || tid == 0) {
            const float2 c1 = X[PX(pos14(k))], c2 = X[PX(pos14((16384 - k) & 16383))];
            const float2 ae = make_float2(0.5f * (c1.x + c2.x), 0.5f * (c1.y - c2.y));
            const float2 ao = make_float2(0.5f * (c1.y + c2.y), -0.5f * (c1.x - c2.x));
            const float2 tw = twid((float)k * (1.f / 32768.f));
            const float2 tao = cmul(tw, ao);
            const float2 ka = cadd(ae, tao), kb = cconj(csub(ae, tao));
            KA[m] = pack2(ka.x, ka.y);
            KB[m] = pack2(kb.x, kb.y);
          } else { KA[m] = 0u; KB[m] = 0u; }
        }
        __syncthreads();
        const u16* x1s = x1row + 16384; const u16* vs = vrow + 16384;
#pragma unroll 1
        for (int u = 0; u < 4; ++u) {
          const int tl = 8 * (tid + 512 * u);
          float a[8], c[8];
          conv3_8(x1s, tl, 16384, w10, w11, w12, a);
          conv3_8(vs, tl, 16384, w20, w21, w22, c);
#pragma unroll
          for (int i = 0; i < 8; ++i) a[i] *= c[i];
          *(u32x4*)(zs + tl) = pack8(a);
          const int n = tl >> 1;
#pragma unroll
          for (int i = 0; i < 4; ++i) { X[PX(n + i)] = make_float2(a[2 * i], a[2 * i + 1]); X[PX(8192 + n + i)] = make_float2(0.f, 0.f); }
        }
        fft_fwd_head(X);
#pragma unroll 1
        for (int u = 0; u < 2; ++u) {
          const int g = tid + 512 * u;
          float2 v[16];
#pragma unroll
          for (int r = 0; r < 16; ++r) v[r] = X[16 * g + (r ^ (g & 15))];
          fft16_fwd(v);
#pragma unroll
          for (int r = 0; r < 16; ++r) X[16 * g + (r ^ (g & 15))] = v[r];
        }
        __syncthreads();
#pragma unroll
        for (int m = 0; m < 17; ++m) {
          int k = (m < 16) ? (((tid & 31) << 8) | (m * 16 + ((tid >> 6) << 1) + ((tid >> 5) & 1))) : 8192;
          asm volatile("" : "+v"(k) :: "memory");
          if (m < 16 || tid == 0) {
            const int p1 = PX(pos14(k)), p2 = PX(pos14((16384 - k) & 16383));
            const float2 c1 = X[p1], c2 = X[p2];
            const float2 ae = make_float2(0.5f * (c1.x + c2.x), 0.5f * (c1.y - c2.y));
            const float2 ao = make_float2(0.5f * (c1.y + c2.y), -0.5f * (c1.x - c2.x));
            const float2 tw = twid((float)k * (1.f / 32768.f));
            const float2 tao = cmul(tw, ao);
            const float2 y1 = cmul(cadd(ae, tao), make_float2(lo_bf(KA[m]), hi_bf(KA[m])));
            const float2 y2 = cmul(cconj(csub(ae, tao)), make_float2(lo_bf(KB[m]), hi_bf(KB[m])));
            const float2 ye = make_float2(0.5f * (y1.x + y2.x), 0.5f * (y1.y - y2.y));
            const float2 yd = make_float2(0.5f * (y1.x - y2.x), 0.5f * (y1.y + y2.y));
            const float2 yo = cmulc(yd, tw);
            X[p1] = make_float2(ye.x - yo.y, ye.y + yo.x);
            if (k != 0) X[p2] = make_float2(ye.x + yo.y, -ye.y + yo.x);
          }
        }
        __syncthreads();
#pragma unroll 1
        for (int u = 0; u < 2; ++u) {
          const int g = tid + 512 * u;
          float2 v[16];
#pragma unroll
          for (int r = 0; r < 16; ++r) v[r] = X[16 * g + (r ^ (g & 15))];
          fft16_inv(v);
#pragma unroll
          for (int r = 0; r < 16; ++r) X[16 * g + (r ^ (g & 15))] = v[r];
        }
        fft_inv_tail(X);
        u16* orow = x1row + 16384;
        const u16* x0s = x0row + 16384;
#pragma unroll 1
        for (int u = 0; u < 4; ++u) {
          const int tl = 8 * (tid + 512 * u);
          const int n = tl >> 1;
          float y[8], g0[8], zz[8];
          unpack8(*(const u32x4*)(zs + tl), zz);
#pragma unroll
          for (int i = 0; i < 4; ++i) { const float2 xv = X[PX(n + i)]; y[2 * i] = xv.x * SCL + bias * zz[2 * i]; y[2 * i + 1] = xv.y * SCL + bias * zz[2 * i + 1]; }
          conv3_8(x0s, tl, 16384, w00, w01, w02, g0);
#pragma unroll
          for (int i = 0; i < 8; ++i) y[i] *= g0[i];
          *(u32x4*)(orow + tl) = pack8(y);
        }
      }
    }
  }
  grid_bar(barcnt, bar_target, (unsigned)G);

  if (PHM & (1 << 10)) {
    PHASE_IDS
    const u16* src = (const u16*)dsc;
    u16* yg = (u16*)(ws + C_YG);
    u16* tl = (u16*)smem;
    for (int tile = vb; tile < 16 * 512; tile += G) {
      const int tc = tile & 15, tt = tile >> 4;
      {
        const int cr = tid >> 3, c8 = tid & 7;
        const u32x4 v = __builtin_nontemporal_load((const u32x4*)(src + (long)(tc * 64 + cr) * T_TOK + tt * 64 + c8 * 8));
        *(u32x4*)(tl + cr * 72 + c8 * 8) = v;
      }
      __syncthreads();
      {
        const int tr = tid >> 3, c8 = tid & 7;
        u32x4 o;
#pragma unroll
        for (int i = 0; i < 4; ++i) {
          const unsigned a = tl[(c8 * 8 + 2 * i) * 72 + tr], b = tl[(c8 * 8 + 2 * i + 1) * 72 + tr];
          o[i] = a | (b << 16);
        }
        *(u32x4*)(yg + (long)(tt * 64 + tr) * DM + tc * 64 + c8 * 8) = o;
      }
      __syncthreads();
    }
  }
  grid_bar(barcnt, bar_target, (unsigned)G);

  if (PHM & (1 << 11)) {
    pg8::Gemm g{(const u16*)(ws + C_YG), (const u16*)(ws + W1_COUT), T_TOK, DM, DM};
    pg8::StaticOrder S; S.init(T_TOK, DM, G, bid);
    EpiResid E{XB, rowss + 3 * T_TOK};
    pg8::gemm_phase<EpiResid, pg8::StaticOrder>(lds, g, S, E, nullptr);
  }
  grid_bar(barcnt, bar_target, (unsigned)G);

  if (PHM & (1 << 12)) {
    u16* actC = (u16*)(ws + OFF_C);
    pg8::Gemm g{XB + (size_t)0 * 16384 * DM, (const u16*)(ws + W1_GU), 16384, 5632, DM};
    pg8::StaticOrder S; S.init(16384, 5632, G, bid);
    EpiGU E{actC - (size_t)0 * 16384 * DFF, actC, 1 << 30, rowss + 3 * T_TOK, 0 * 16384};
    pg8::gemm_phase<EpiGU, pg8::StaticOrder>(lds, g, S, E, nullptr);
  }
  grid_bar(barcnt, bar_target, (unsigned)G);
  if (PHM & (1 << 12)) {
    pg8::Gemm g{(const u16*)(ws + OFF_C), (const u16*)(ws + W1_D), 16384, DM, DFF};
    pg8::StaticOrder S; S.init(16384, DM, G, bid);
    EpiFinal E{XB, p.out, 0 * 16384};
    pg8::gemm_phase<EpiFinal, pg8::StaticOrder>(lds, g, S, E, nullptr);
  }
  grid_bar(barcnt, bar_target, (unsigned)G);
  if (PHM & (1 << 12)) {
    u16* actC = (u16*)(ws + OFF_C);
    pg8::Gemm g{XB + (size_t)1 * 16384 * DM, (const u16*)(ws + W1_GU), 16384, 5632, DM};
    pg8::StaticOrder S; S.init(16384, 5632, G, bid);
    EpiGU E{actC - (size_t)1 * 16384 * DFF, actC, 1 << 30, rowss + 3 * T_TOK, 1 * 16384};
    pg8::gemm_phase<EpiGU, pg8::StaticOrder>(lds, g, S, E, nullptr);
  }
  grid_bar(barcnt, bar_target, (unsigned)G);
  if (PHM & (1 << 12)) {
    pg8::Gemm g{(const u16*)(ws + OFF_C), (const u16*)(ws + W1_D), 16384, DM, DFF};
    pg8::StaticOrder S; S.init(16384, DM, G, bid);
    EpiFinal E{XB, p.out, 1 * 16384};
    pg8::gemm_phase<EpiFinal, pg8::StaticOrder>(lds, g, S, E, nullptr);
  }
}

extern "C" void kernel_launch(void* const* d_in, const int* in_sizes, int n_in, void* d_out, int out_size,
                              void* d_ws, size_t ws_size, hipStream_t stream) {
  static int grid_blocks = 0;
  if (!grid_blocks) {
    int dev = 0, cus = 0, per_cu = 0;
    hipGetDevice(&dev);
    hipDeviceGetAttribute(&cus, hipDeviceAttributeMultiprocessorCount, dev);
    hipOccupancyMaxActiveBlocksPerMultiprocessor(&per_cu, fwd_kernel, NTHR, 0);
    if (per_cu < 1) per_cu = 1;
    grid_blocks = cus;
    if (grid_blocks % 8) grid_blocks -= grid_blocks % 8;
  }
  if (ws_size < WS_NEED || n_in < 28) { fprintf(stderr, "workspace too small\n"); return; }
  Params p{};
  for (int i = 0; i < 28; ++i) p.in[i] = (const float*)d_in[i];
  p.out = (float*)d_out;
  p.ws = (char*)d_ws;
  hipMemsetAsync(d_ws, 0, 4096, stream);
  void* args[] = {&p};
  hipError_t e = hipLaunchCooperativeKernel((void*)fwd_kernel, dim3(grid_blocks), dim3(NTHR), args, 0, stream);
  if (e != hipSuccess) fprintf(stderr, "cooperative launch failed: %s (grid %d)\n", hipGetErrorString(e), grid_blocks);
}
```
